# Optimizing an MI355X kernel written in HIP

```python
import jax, jax.numpy as jnp
from jax import lax
import numpy as np

D_MODEL = 2048
BATCH = 4
SEQ = 4096
DEPTH = 2

N_MIXERS = 2
N_HEADS = 16
HEAD_DIM = D_MODEL // N_HEADS
Q_BLOCK = 128
CONV_WIDTH = 3
D_FF = 4 * D_MODEL
N_MOD = 6
RMS_EPS = 1e-6
FORGET_BIAS_CENTER = 3.0

kernel_name = 'fox_shortconv_hybrid_adaln'


def rmsnorm(x, gain):
    xf = x.astype(jnp.float32)
    inv = lax.rsqrt(jnp.mean(xf * xf, axis=-1, keepdims=True) + RMS_EPS)
    return (xf * inv).astype(x.dtype) * gain


def modulate(h, shift, scale):
    return h * (1.0 + scale[:, None, :]) + shift[:, None, :]


def fox_attention(q, k, v, log_f):
    B, H, S, Dh = q.shape
    nb = S // Q_BLOCK
    F = jnp.cumsum(log_f.astype(jnp.float32), axis=-1)
    q_blocks = q.reshape(B, H, nb, Q_BLOCK, Dh).transpose(2, 0, 1, 3, 4)
    F_blocks = F.reshape(B, H, nb, Q_BLOCK).transpose(2, 0, 1, 3)
    k_pos = jnp.arange(S)
    scale = HEAD_DIM ** -0.5

    def one_block(args):
        blk, q_i, F_i = args
        s = jnp.einsum('bhqd,bhkd->bhqk', q_i, k).astype(jnp.float32) * scale
        s = s + F_i[..., :, None] - F[..., None, :]
        q_pos = blk * Q_BLOCK + jnp.arange(Q_BLOCK)
        causal = k_pos[None, :] <= q_pos[:, None]
        s = jnp.where(causal, s, -jnp.inf)
        p = jax.nn.softmax(s, axis=-1)
        return jnp.einsum('bhqk,bhkd->bhqd', p.astype(v.dtype), v)

    out = lax.map(one_block, (jnp.arange(nb), q_blocks, F_blocks))
    return out.transpose(1, 2, 0, 3, 4).reshape(B, H, S, Dh)


def fox_mixer(h, w_in, b_f, w_out):
    B, S, D = h.shape
    proj = h @ w_in
    q, k, v, f_logit = jnp.split(proj, [D, 2 * D, 3 * D], axis=-1)
    to_heads = lambda t: t.reshape(B, S, N_HEADS, HEAD_DIM).transpose(0, 2, 1, 3)
    log_f = jax.nn.log_sigmoid((f_logit + b_f).astype(jnp.float32)).transpose(0, 2, 1)
    o = fox_attention(to_heads(q), to_heads(k), to_heads(v), log_f)
    o = o.transpose(0, 2, 1, 3).reshape(B, S, D)
    return o @ w_out


def short_conv_mixer(h, w_in, conv_w, w_out):
    S = h.shape[1]
    proj = h @ w_in
    b_gate, c_gate, u = jnp.split(proj, 3, axis=-1)
    u = c_gate * u
    u_pad = jnp.pad(u, ((0, 0), (CONV_WIDTH - 1, 0), (0, 0)))
    y = sum(conv_w[tap] * u_pad[:, tap:tap + S, :] for tap in range(CONV_WIDTH))
    return (b_gate * y) @ w_out


def sq_relu_mlp(h, w_up, w_down):
    return jnp.square(jax.nn.relu(h @ w_up)) @ w_down


def setup_inputs(seed: int = 0) -> dict:
    key = jax.random.key(seed)
    ks = jax.random.split(key, 16)
    D = D_MODEL
    n_fox = (DEPTH + 1) // 2
    n_conv = DEPTH // 2
    nrm = lambda k, shape, fan_in, mult=1.0: jax.random.normal(k, shape, jnp.float32) * (mult * fan_in ** -0.5)
    return {
        'x': jax.random.normal(ks[0], (BATCH, SEQ, D), jnp.float32),
        'c': jax.random.normal(ks[1], (BATCH, D), jnp.float32),
        'ada_w': nrm(ks[2], (DEPTH, D, N_MOD * D), D, 0.5),
        'ada_b': 0.01 * jax.random.normal(ks[3], (DEPTH, N_MOD * D), jnp.float32),
        'norm_mix': 1.0 + 0.02 * jax.random.normal(ks[4], (DEPTH, D), jnp.float32),
        'norm_mlp': 1.0 + 0.02 * jax.random.normal(ks[5], (DEPTH, D), jnp.float32),
        'fox_w_in': nrm(ks[6], (n_fox, D, 3 * D + N_HEADS), D),
        'fox_b_f': FORGET_BIAS_CENTER + 0.1 * jax.random.normal(ks[7], (n_fox, N_HEADS), jnp.float32),
        'fox_w_out': nrm(ks[8], (n_fox, D, D), D),
        'conv_w_in': nrm(ks[9], (n_conv, D, 3 * D), D),
        'conv_w': nrm(ks[10], (n_conv, CONV_WIDTH, D), CONV_WIDTH),
        'conv_w_out': nrm(ks[11], (n_conv, D, D), D),
        'mlp_w_up': nrm(ks[12], (DEPTH, D, D_FF), D),
        'mlp_w_down': nrm(ks[13], (DEPTH, D_FF, D), D_FF),
        'final_norm': 1.0 + 0.02 * jax.random.normal(ks[14], (D,), jnp.float32),
    }


def reference(x, c, ada_w, ada_b, norm_mix, norm_mlp, fox_w_in, fox_b_f, fox_w_out,
              conv_w_in, conv_w, conv_w_out, mlp_w_up, mlp_w_down, final_norm):
    c_act = jax.nn.silu(c)
    for i in range(DEPTH):
        mod = c_act @ ada_w[i] + ada_b[i]
        sh_mix, sc_mix, g_mix, sh_mlp, sc_mlp, g_mlp = jnp.split(mod, N_MOD, axis=-1)
        h = modulate(rmsnorm(x, norm_mix[i]), sh_mix, sc_mix)
        j = i // N_MIXERS
        if i % N_MIXERS == 0:
            mix = fox_mixer(h, fox_w_in[j], fox_b_f[j], fox_w_out[j])
        else:
            mix = short_conv_mixer(h, conv_w_in[j], conv_w[j], conv_w_out[j])
        x = x + g_mix[:, None, :] * mix
        h = modulate(rmsnorm(x, norm_mlp[i]), sh_mlp, sc_mlp)
        x = x + g_mlp[:, None, :] * sq_relu_mlp(h, mlp_w_up[i], mlp_w_down[i])
    return rmsnorm(x, final_norm)
```

```cpp
#include <hip/hip_runtime.h>
#include <hip/hip_bf16.h>
#include <hip/hip_cooperative_groups.h>
#include <cstdio>
#include <cstdint>
#include <cmath>
namespace cg = cooperative_groups;
#ifndef MK_N_LAUNCHES
#define MK_N_LAUNCHES 1
#endif
__device__ __forceinline__ int tidx() { int t = threadIdx.x; asm volatile("" : "+v"(t)); return t; }
namespace pg8 {
#define PG8_LAS __attribute__((address_space(3)))
typedef unsigned short bf16_t;
typedef short bf16x8 __attribute__((ext_vector_type(8)));
typedef float f32x4 __attribute__((ext_vector_type(4)));
typedef unsigned u32x4 __attribute__((ext_vector_type(4)));
constexpr int BM = 256, BK = 64, HALF = 128, HTB = HALF * BK * 2  , STAGE_BYTES = 8 * HTB, NXCD = 8, WGM = 8;

__host__ __device__ __forceinline__ int lds_byte(int r, int c) { const int st = (r >> 4) * 2 + (c >> 5), rr = r & 15, cc = c & 31, ob = rr * 64 + cc * 2; return st * 1024 + (ob ^ (((ob >> 9) & 1) << 5)); }
__host__ __device__ __forceinline__ void stage_rc(int b, int& R, int& C) { const int st = b / 1024, sb = b % 1024, swz = sb ^ (((sb >> 9) & 1) << 5); R = (st >> 1) * 16 + swz / 64; C = (st & 1) * 32 + (swz % 64) / 2; }
__host__ __device__ __forceinline__ int perm32(int rho) { const int n = rho >> 4, i = rho & 15; return 8 * (i >> 2) + 4 * n + (i & 3); }

struct Unit { int pm, pn; };
struct Gemm { const bf16_t* A; const bf16_t* Bt; int M, N, K; };

struct StaticOrder {
    int nM, nN, nwg, G, c;
    __host__ __device__ void init(int M, int N, int G_, int c_) { nM = M / BM; nN = N / BM; nwg = nM * nN; G = G_; c = c_; }
    __host__ __device__ bool next(int i, Unit& u) const {
        const long L = (long)i * G + c; if (L >= nwg) return false;
        int wgid = (int)L; { const int q = nwg / NXCD, r = nwg % NXCD, xcd = wgid % NXCD, off = wgid / NXCD; wgid = (xcd < r ? xcd * (q + 1) : r * (q + 1) + (xcd - r) * q) + off; }
        const int nig = WGM * nN, gid = wgid / nig, fm = gid * WGM, gsz = (nM - fm) < WGM ? (nM - fm) : WGM;
        u.pm = fm + ((wgid % nig) % gsz); u.pn = (wgid % nig) / gsz; return true;
    }
    __device__ __forceinline__ void a_ready(const Unit&) const {}
    __device__ __forceinline__ void done(const Unit&) const {}
};

__device__ __forceinline__ unsigned cvt_pk_bf16(float lo, float hi) { unsigned r; asm volatile("v_cvt_pk_bf16_f32 %0, %1, %2" : "=v"(r) : "v"(lo), "v"(hi)); return r; }
template <int ACT> struct EpiBf16 {
    static constexpr bool PERM = true, AFTER_DRAIN = false;
    bf16_t* O; int ldc; int split_cols; size_t split_stride; float scale0;
    const float* ss; const float* sw; int sw_stride; int rows_per_batch;
    bf16_t* cu_out; int cu_from;
    float* nrm;
    __device__ __forceinline__ void operator()(const f32x4 (&acc)[2][2][4][2], const Unit& u, int wr, int wc, int fr, int fq) const {
        const int row0 = u.pm * BM + wr * 64 + fr; int colt = u.pn * BM; bf16_t* base = O;
        const bool do_nrm = nrm != nullptr && u.pn < 16;
        float sc = 1.f; if (split_cols) { const int t = colt / split_cols; base += (size_t)t * split_stride; colt -= t * split_cols; if (t == 0) sc = scale0; }
        const int col0 = colt + wc * 32 + 8 * fq;
        f32x4 swv[2][2];
        if (ss) { const float* swp = sw + (size_t)((u.pm * BM) / rows_per_batch) * sw_stride + u.pn * BM + wc * 32 + 8 * fq;
#pragma unroll
            for (int bj = 0; bj < 2; ++bj)
#pragma unroll
                for (int n = 0; n < 2; ++n) swv[bj][n] = *(const f32x4*)(swp + bj * HALF + 4 * n); }
#pragma unroll
        for (int ai = 0; ai < 2; ++ai)
#pragma unroll
            for (int m = 0; m < 4; ++m) { const int row = row0 + ai * HALF + m * 16; bf16_t* rowp = base + (size_t)row * ldc + col0;
                float inv = 1.f;
                if (ss) { const f32x4* sp = (const f32x4*)(ss + (size_t)row * 32 + fq * 8); const f32x4 p0 = sp[0], p1 = sp[1];
                    float s = ((p0[0] + p0[1]) + (p0[2] + p0[3])) + ((p1[0] + p1[1]) + (p1[2] + p1[3]));
                    s += __shfl_xor(s, 16); s += __shfl_xor(s, 32); inv = 1.0f / sqrtf(s * (1.f / 2048.f) + 1e-6f); }
                f32x4 va[2][2];
#pragma unroll
                for (int bj = 0; bj < 2; ++bj) { f32x4 v0 = acc[ai][bj][m][0], v1 = acc[ai][bj][m][1];
                    if (ss) { v0 = v0 * inv + swv[bj][0]; v1 = v1 * inv + swv[bj][1]; }
                    if (ACT == 2) { v0 = __builtin_elementwise_max(v0, (f32x4){0.f, 0.f, 0.f, 0.f}); v1 = __builtin_elementwise_max(v1, (f32x4){0.f, 0.f, 0.f, 0.f}); v0 = v0 * v0; v1 = v1 * v1; }
                    v0 = v0 * sc; v1 = v1 * sc;
                    if (do_nrm) { float s2 = ((v0[0] * v0[0] + v0[1] * v0[1]) + (v0[2] * v0[2] + v0[3] * v0[3])) + ((v1[0] * v1[0] + v1[1] * v1[1]) + (v1[2] * v1[2] + v1[3] * v1[3]));
                        s2 += __shfl_xor(s2, 16); s2 += __shfl_xor(s2, 32);
                        if (fq == 0) nrm[((size_t)(((u.pn >> 3) * 4 + (row >> 12)) * 16 + (u.pn & 7) * 2 + bj) * 4096 + (row & 4095)) * 4 + wc] = s2; }
                    va[bj][0] = v0; va[bj][1] = v1; }
                if (cu_out != nullptr && u.pn >= cu_from) {
                    const f32x4 p0 = va[0][0] * va[1][0], p1 = va[0][1] * va[1][1];
                    u32x4 w; w.x = cvt_pk_bf16(p0[0], p0[1]); w.y = cvt_pk_bf16(p0[2], p0[3]); w.z = cvt_pk_bf16(p1[0], p1[1]); w.w = cvt_pk_bf16(p1[2], p1[3]);
                    *(u32x4*)(cu_out + (size_t)row * ldc + (u.pn - cu_from) * HALF + wc * 32 + 8 * fq) = w;
                } else {
#pragma unroll
                    for (int bj = 0; bj < 2; ++bj) { const f32x4 v0 = va[bj][0], v1 = va[bj][1];
                        u32x4 w; w.x = cvt_pk_bf16(v0[0], v0[1]); w.y = cvt_pk_bf16(v0[2], v0[3]); w.z = cvt_pk_bf16(v1[0], v1[1]); w.w = cvt_pk_bf16(v1[2], v1[3]);
                        *(u32x4*)(rowp + bj * HALF) = w; } } }
    }
};
struct EpiRes {
    static constexpr bool PERM = true, AFTER_DRAIN = false;
    const float* base32; const bf16_t* base16; float* out32; bf16_t* out16; int ldc; const float* gate; int rows_per_batch; int gate_stride;
    bf16_t* An; const float* n_gain; const float* n_scale; float* ss;
    __device__ __forceinline__ void operator()(const f32x4 (&acc)[2][2][4][2], const Unit& u, int wr, int wc, int fr, int fq) const {
        const int bidx = (u.pm * BM) / rows_per_batch; const float* g = gate + (size_t)bidx * gate_stride;
        const int col0 = u.pn * BM + wc * 32 + 8 * fq;
        f32x4 gv[2][2], cav[2][2];
#pragma unroll
        for (int bj = 0; bj < 2; ++bj)
#pragma unroll
            for (int n = 0; n < 2; ++n) { gv[bj][n] = *(const f32x4*)(g + col0 + bj * HALF + 4 * n);
                if (An) cav[bj][n] = *(const f32x4*)(n_gain + col0 + bj * HALF + 4 * n) * (*(const f32x4*)(n_scale + (size_t)bidx * gate_stride + col0 + bj * HALF + 4 * n) + 1.f); }
#pragma unroll
        for (int h = 0; h < 4; ++h) { const int ai = h >> 1, m0 = (h & 1) * 2;
            f32x4 pre[2][2][2];
            if (base32) {
#pragma unroll
                for (int mm = 0; mm < 2; ++mm) { const size_t off = (size_t)(u.pm * BM + ai * HALF + wr * 64 + (m0 + mm) * 16 + fr) * ldc + col0;
#pragma unroll
                    for (int bj = 0; bj < 2; ++bj)
#pragma unroll
                        for (int n = 0; n < 2; ++n) pre[mm][bj][n] = __builtin_nontemporal_load((const f32x4*)(base32 + off + bj * HALF + 4 * n)); }
            } else { u32x4 raw[2][2];
#pragma unroll
                for (int mm = 0; mm < 2; ++mm) { const size_t off = (size_t)(u.pm * BM + ai * HALF + wr * 64 + (m0 + mm) * 16 + fr) * ldc + col0;
#pragma unroll
                    for (int bj = 0; bj < 2; ++bj) raw[mm][bj] = __builtin_nontemporal_load((const u32x4*)(base16 + off + bj * HALF)); }
#pragma unroll
                for (int mm = 0; mm < 2; ++mm)
#pragma unroll
                    for (int bj = 0; bj < 2; ++bj) { const u32x4 w = raw[mm][bj];
                        pre[mm][bj][0] = (f32x4){__uint_as_float(w.x << 16), __uint_as_float(w.x & 0xffff0000u), __uint_as_float(w.y << 16), __uint_as_float(w.y & 0xffff0000u)};
                        pre[mm][bj][1] = (f32x4){__uint_as_float(w.z << 16), __uint_as_float(w.z & 0xffff0000u), __uint_as_float(w.w << 16), __uint_as_float(w.w & 0xffff0000u)}; } }
#pragma unroll
            for (int mm = 0; mm < 2; ++mm) { const int m = m0 + mm; const int row = u.pm * BM + ai * HALF + wr * 64 + m * 16 + fr; const size_t off = (size_t)row * ldc + col0;
                float ssum = 0.f;
#pragma unroll
                for (int bj = 0; bj < 2; ++bj) { f32x4 o[2];
#pragma unroll
                    for (int n = 0; n < 2; ++n) { o[n] = pre[mm][bj][n] + gv[bj][n] * acc[ai][bj][m][n];
                        ssum += (o[n][0] * o[n][0] + o[n][1] * o[n][1]) + (o[n][2] * o[n][2] + o[n][3] * o[n][3]); }
                    if (out32) { *(f32x4*)(out32 + off + bj * HALF) = o[0]; *(f32x4*)(out32 + off + bj * HALF + 4) = o[1]; }
                    else { u32x4 w; w.x = cvt_pk_bf16(o[0][0], o[0][1]); w.y = cvt_pk_bf16(o[0][2], o[0][3]); w.z = cvt_pk_bf16(o[1][0], o[1][1]); w.w = cvt_pk_bf16(o[1][2], o[1][3]); *(u32x4*)(out16 + off + bj * HALF) = w; }
                    if (An) { const f32x4 a0 = o[0] * cav[bj][0], a1 = o[1] * cav[bj][1]; u32x4 w; w.x = cvt_pk_bf16(a0[0], a0[1]); w.y = cvt_pk_bf16(a0[2], a0[3]); w.z = cvt_pk_bf16(a1[0], a1[1]); w.w = cvt_pk_bf16(a1[2], a1[3]);
                        *(u32x4*)(An + off + bj * HALF) = w; } }
                if (An) { ssum += __shfl_xor(ssum, 16); ssum += __shfl_xor(ssum, 32); if (fq == 0) ss[(size_t)row * 32 + u.pn * 4 + wc] = ssum; } }
            asm volatile("" ::: "memory");
        }
    }
};
struct EpiNull {
    static constexpr bool PERM = true, AFTER_DRAIN = false; bf16_t* O;
    __device__ __forceinline__ void operator()(const f32x4 (&acc)[2][2][4][2], const Unit& u, int wr, int wc, int fr, int fq) const {
        float s = 0.f;
#pragma unroll
        for (int ai = 0; ai < 2; ++ai)
#pragma unroll
            for (int bj = 0; bj < 2; ++bj)
#pragma unroll
                for (int m = 0; m < 4; ++m)
#pragma unroll
                    for (int n = 0; n < 2; ++n) s += acc[ai][bj][m][n][0] + acc[ai][bj][m][n][1] + acc[ai][bj][m][n][2] + acc[ai][bj][m][n][3];
        if (s == 1.2345e-30f) O[0] = 1;
    }
};
struct EpiCoal {
    static constexpr bool PERM = true, AFTER_DRAIN = false; bf16_t* O;
    __device__ __forceinline__ void operator()(const f32x4 (&acc)[2][2][4][2], const Unit& u, int wr, int wc, int fr, int fq) const {
        bf16_t* base = O + ((size_t)((u.pm * 32 + u.pn) & 511) * 65536) + (size_t)(wr * 4 + wc) * 8192 + (size_t)(fq * 16 + fr) * 8;
#pragma unroll
        for (int ai = 0; ai < 2; ++ai)
#pragma unroll
            for (int m = 0; m < 4; ++m)
#pragma unroll
                for (int bj = 0; bj < 2; ++bj) { f32x4 v0 = acc[ai][bj][m][0], v1 = acc[ai][bj][m][1];
                    v0 = __builtin_elementwise_max(v0, (f32x4){0.f, 0.f, 0.f, 0.f}); v1 = __builtin_elementwise_max(v1, (f32x4){0.f, 0.f, 0.f, 0.f}); v0 = v0 * v0; v1 = v1 * v1;
                    u32x4 w; w.x = cvt_pk_bf16(v0[0], v0[1]); w.y = cvt_pk_bf16(v0[2], v0[3]); w.z = cvt_pk_bf16(v1[0], v1[1]); w.w = cvt_pk_bf16(v1[2], v1[3]);
                    *(u32x4*)(base + (size_t)((ai * 4 + m) * 2 + bj) * 512) = w; }
    }
};
template <class Epi, class Sched, bool ALIGN_EPI = false, bool SP2 = false>
__device__ __forceinline__ void gemm_phase(PG8_LAS unsigned char* lds, const Gemm g, const Sched& S, const Epi& E) {
    const int tid = tidx(), wid = __builtin_amdgcn_readfirstlane(tid >> 6), lane = tid & 63, wr = wid >> 2, wc = wid & 3, fr = lane & 15, fq = lane >> 4;
    const int K = g.K, nt = K / BK;
    unsigned voffA[2], voffB[2];
#pragma unroll
    for (int i = 0; i < 2; ++i) { int R, C; stage_rc(tid * 16 + i * 8192, R, C); const int Rb = Epi::PERM ? ((R & ~31) + perm32(R & 31)) : R;
        voffA[i] = (unsigned)(R * K + C) * 2u; voffB[i] = (unsigned)(Rb * K + C) * 2u; }
    const size_t kstep = (size_t)(BK * 2);
    const size_t hstep = (size_t)HALF * K * 2;
    const size_t tstep = 2 * hstep;
    const unsigned ldsw = (unsigned)wid * 1024u;
    const int aoff = lds_byte(wr * 64 + fr, fq * 8), boff = lds_byte(wc * 32 + fr, fq * 8);
#define PG8_SA(b, h) (((b) * 2 + (h)) * HTB)
#define PG8_SB(b, h) ((4 + (b) * 2 + (h)) * HTB)
#define PG8_STAGE(bufoff, gbase, voff) do { _Pragma("unroll") for (int _i = 0; _i < 2; ++_i) \
        __builtin_amdgcn_global_load_lds((const unsigned*)((const char*)(gbase) + (voff)[_i]), (PG8_LAS unsigned*)(lds + (bufoff) + ldsw + _i * 8192), 16, 0, 0); } while (0)
#define PG8_LDA(dst, b, h) do { _Pragma("unroll") for (int m = 0; m < 4; ++m) _Pragma("unroll") for (int k = 0; k < 2; ++k) dst[m][k] = *(const PG8_LAS bf16x8*)(lds + PG8_SA(b, h) + aoff + m * 2048 + k * 1024); } while (0)
#define PG8_LDB(dst, b, h) do { _Pragma("unroll") for (int n = 0; n < 2; ++n) _Pragma("unroll") for (int k = 0; k < 2; ++k) dst[n][k] = *(const PG8_LAS bf16x8*)(lds + PG8_SB(b, h) + boff + n * 2048 + k * 1024); } while (0)
#define PG8_MMA(ai, bj, At, Bt) do { __builtin_amdgcn_s_setprio(1); _Pragma("unroll") for (int m = 0; m < 4; ++m) _Pragma("unroll") for (int n = 0; n < 2; ++n) _Pragma("unroll") for (int k = 0; k < 2; ++k) \
        acc[ai][bj][m][n] = __builtin_amdgcn_mfma_f32_16x16x32_bf16(Bt[n][k], At[m][k], acc[ai][bj][m][n], 0, 0, 0); __builtin_amdgcn_s_setprio(0); } while (0)
#define PG8_WAIT_V(n) asm volatile("s_waitcnt vmcnt(" #n ")" ::: "memory")
#define PG8_WAIT_L(n) asm volatile("s_waitcnt lgkmcnt(" #n ")" ::: "memory")
#define PG8_BAR __builtin_amdgcn_s_barrier()
#define PG8_SCHED __builtin_amdgcn_sched_barrier(0)
    Unit cur, nxt; int ui = 0;
    if (!S.next(0, cur)) return;
    f32x4 acc[2][2][4][2];
#pragma unroll
    for (int a = 0; a < 2; ++a)
#pragma unroll
        for (int b = 0; b < 2; ++b)
#pragma unroll
            for (int m = 0; m < 4; ++m)
#pragma unroll
                for (int n = 0; n < 2; ++n) acc[a][b][m][n] = (f32x4){0.f, 0.f, 0.f, 0.f};
    bf16x8 At[4][2], B0[2][2], B1[2][2];
    const char* cA = (const char*)g.A + (size_t)cur.pm * tstep; const char* cB = (const char*)g.Bt + (size_t)cur.pn * tstep;
    S.a_ready(cur);
    if constexpr (SP2) {
        PG8_STAGE(PG8_SB(0, 0), cB, voffB); PG8_STAGE(PG8_SB(0, 1), cB + hstep, voffB); PG8_STAGE(PG8_SA(0, 0), cA, voffA); PG8_STAGE(PG8_SA(0, 1), cA + hstep, voffA);
        if (wr == 1) PG8_BAR;
        PG8_WAIT_V(2); PG8_BAR;
        PG8_STAGE(PG8_SB(1, 0), cB + kstep, voffB); PG8_STAGE(PG8_SA(1, 0), cA + kstep, voffA); PG8_STAGE(PG8_SB(1, 1), cB + hstep + kstep, voffB);
        PG8_WAIT_V(6); PG8_BAR;
    } else {
        PG8_STAGE(PG8_SB(0, 0), cB, voffB); PG8_STAGE(PG8_SA(0, 0), cA, voffA); PG8_STAGE(PG8_SB(0, 1), cB + hstep, voffB); PG8_STAGE(PG8_SA(0, 1), cA + hstep, voffA);
        if (wr == 1) PG8_BAR;
        PG8_WAIT_V(4); PG8_BAR;
        PG8_STAGE(PG8_SB(1, 0), cB + kstep, voffB); PG8_STAGE(PG8_SA(1, 0), cA + kstep, voffA); PG8_STAGE(PG8_SB(1, 1), cB + hstep + kstep, voffB);
        PG8_WAIT_V(6); PG8_BAR;
    }
    for (;;) {
        const bool has_next = S.next(ui + 1, nxt);
        const char* nA = has_next ? (const char*)g.A + (size_t)nxt.pm * tstep : cA; const char* nB = has_next ? (const char*)g.Bt + (size_t)nxt.pn * tstep : cB;
        for (int t = 0; t < nt; t += 2) {
            const bool last = (t == nt - 2);
            const char* a1 = cA + (size_t)(t + 1) * kstep;
            const char* a2 = last ? nA : cA + (size_t)(t + 2) * kstep; const char* b2 = last ? nB : cB + (size_t)(t + 2) * kstep;
            const char* a3 = a2 + kstep; const char* b3 = b2 + kstep;
            if (last && has_next) S.a_ready(nxt);
            if constexpr (SP2) {
            PG8_LDB(B0, 0, 0); PG8_LDB(B1, 0, 1); PG8_SCHED; PG8_LDA(At, 0, 0); PG8_STAGE(PG8_SA(1, 1), a1 + hstep, voffA);
            PG8_WAIT_V(8); PG8_WAIT_L(0); PG8_BAR; PG8_MMA(0, 0, At, B0); PG8_MMA(0, 1, At, B1); PG8_BAR; PG8_SCHED;
            PG8_LDA(At, 0, 1); PG8_STAGE(PG8_SB(0, 0), b2, voffB); PG8_STAGE(PG8_SB(0, 1), b2 + hstep, voffB); PG8_STAGE(PG8_SA(0, 0), a2, voffA);
            PG8_WAIT_V(8); PG8_WAIT_L(0); PG8_BAR; PG8_MMA(1, 0, At, B0); PG8_MMA(1, 1, At, B1); PG8_BAR; PG8_SCHED;
            PG8_LDB(B0, 1, 0); PG8_LDB(B1, 1, 1); PG8_SCHED; PG8_LDA(At, 1, 0); PG8_STAGE(PG8_SA(0, 1), a2 + hstep, voffA);
            PG8_WAIT_V(8); PG8_WAIT_L(0); PG8_BAR; PG8_MMA(0, 0, At, B0); PG8_MMA(0, 1, At, B1); PG8_BAR; PG8_SCHED;
            PG8_LDA(At, 1, 1); PG8_STAGE(PG8_SB(1, 0), b3, voffB); PG8_STAGE(PG8_SB(1, 1), b3 + hstep, voffB); PG8_STAGE(PG8_SA(1, 0), a3, voffA);
            PG8_WAIT_V(8); PG8_WAIT_L(0); PG8_BAR; PG8_MMA(1, 0, At, B0); PG8_MMA(1, 1, At, B1); PG8_BAR; PG8_SCHED;
            } else {
            PG8_LDB(B0, 0, 0); PG8_SCHED; PG8_LDA(At, 0, 0); PG8_STAGE(PG8_SA(1, 1), a1 + hstep, voffA);
            PG8_WAIT_L(8); PG8_BAR; PG8_WAIT_L(0); PG8_MMA(0, 0, At, B0); PG8_BAR; PG8_SCHED;
            PG8_LDB(B1, 0, 1); PG8_STAGE(PG8_SB(0, 0), b2, voffB);
            PG8_BAR; PG8_WAIT_L(0); PG8_MMA(0, 1, At, B1); PG8_BAR;
            PG8_LDA(At, 0, 1); PG8_STAGE(PG8_SA(0, 0), a2, voffA);
            PG8_BAR; PG8_WAIT_L(0); PG8_MMA(1, 0, At, B0); PG8_BAR; PG8_SCHED;
            PG8_STAGE(PG8_SB(0, 1), b2 + hstep, voffB);
            PG8_WAIT_V(6); PG8_BAR; PG8_MMA(1, 1, At, B1); PG8_BAR;
            PG8_LDB(B0, 1, 0); PG8_SCHED; PG8_LDA(At, 1, 0); PG8_STAGE(PG8_SA(0, 1), a2 + hstep, voffA);
            PG8_WAIT_L(8); PG8_BAR; PG8_WAIT_L(0); PG8_MMA(0, 0, At, B0); PG8_BAR; PG8_SCHED;
            PG8_LDB(B1, 1, 1); PG8_STAGE(PG8_SB(1, 0), b3, voffB);
            PG8_BAR; PG8_WAIT_L(0); PG8_MMA(0, 1, At, B1); PG8_BAR;
            PG8_LDA(At, 1, 1); PG8_STAGE(PG8_SA(1, 0), a3, voffA);
            PG8_BAR; PG8_WAIT_L(0); PG8_MMA(1, 0, At, B0); PG8_BAR; PG8_SCHED;
            PG8_STAGE(PG8_SB(1, 1), b3 + hstep, voffB);
            PG8_WAIT_V(6); PG8_BAR; PG8_MMA(1, 1, At, B1); PG8_BAR;
            }
        }
        if constexpr (ALIGN_EPI) { if (wr == 0) PG8_BAR; }
        if constexpr (!Epi::AFTER_DRAIN) { E(acc, cur, wr, wc, fr, fq); S.done(cur); }
        if (!has_next) break;
#pragma unroll
        for (int a = 0; a < 2; ++a)
#pragma unroll
            for (int b = 0; b < 2; ++b)
#pragma unroll
                for (int m = 0; m < 4; ++m)
#pragma unroll
                    for (int n = 0; n < 2; ++n) acc[a][b][m][n] = (f32x4){0.f, 0.f, 0.f, 0.f};
        cur = nxt; cA = nA; cB = nB; ++ui;
        if constexpr (ALIGN_EPI) { if (wr == 1) PG8_BAR; }
    }
    PG8_WAIT_V(0);
    if constexpr (!ALIGN_EPI) { if (wr == 0) PG8_BAR; }
    PG8_BAR;
    if constexpr (Epi::AFTER_DRAIN) { E.fused(acc, cur, wr, wc, fr, fq, lds, wid, lane); S.done(cur); }
#undef PG8_SA
#undef PG8_SB
#undef PG8_STAGE
#undef PG8_LDA
#undef PG8_LDB
#undef PG8_MMA
#undef PG8_WAIT_V
#undef PG8_WAIT_L
#undef PG8_BAR
#undef PG8_SCHED
}
}
namespace att {
enum { ORDER_NATURAL = 0, ORDER_REVERSED = 1, ORDER_PAIRED = 2, ORDER_XCD = 4 };
constexpr int D = 128, PITCH = 2048;
constexpr float THR = 8.f;
constexpr bool WSKIP = false;
constexpr int NW = 8, QBLK = 32, KVBLK = 64, QB = NW * QBLK;
constexpr int SHM_V = KVBLK * D * 2, SHM_K = KVBLK * D * 2;
constexpr int LDS_BYTES = 2 * SHM_V + 2 * SHM_K + NW * 64 * 4;


using bf16 = __hip_bfloat16;
typedef short bf16x8 __attribute__((ext_vector_type(8)));
typedef short s16x4 __attribute__((ext_vector_type(4)));
typedef float f32x16 __attribute__((ext_vector_type(16)));
typedef float f32x4 __attribute__((ext_vector_type(4)));
typedef unsigned u32x4 __attribute__((ext_vector_type(4)));
template <class A, class Bt> struct same_t { static constexpr bool v = false; };
template <class A> struct same_t<A, A> { static constexpr bool v = true; };

#define KSWZ(row, colB) ((row) * 256 + ((colB) ^ (((row) & 7) << 4)))
#define SBAR() __builtin_amdgcn_sched_barrier(0)
__device__ __forceinline__ int v_st(int k, int c) { const int kk = (k & ~0xC) | ((k & 4) << 1) | ((k & 8) >> 1); return ((kk >> 3) * 4 + (c >> 5)) * 512 + ((kk & 7) * 32 + (c & 31)) * 2; }
__device__ __forceinline__ int v_rd_base(int lane) { return ((lane & 3) << 3) | (((lane >> 2) & 3) << 6) | (((lane >> 4) & 1) << 5) | (((lane >> 5) & 1) << 8); }
constexpr int v_rd_off(int d0, int ks, int half) { return d0 * 512 + ks * 4096 + half * 2048; }
__device__ __forceinline__ int crow(int r, int hi) { return (r & 3) + 8 * (r >> 2) + 4 * hi; }
__device__ __forceinline__ unsigned cvtpk(float lo, float hi) {
    unsigned r; asm volatile("v_cvt_pk_bf16_f32 %0, %1, %2" : "=v"(r) : "v"(lo), "v"(hi)); return r;
}
__device__ __forceinline__ bf16x8 pack8(f32x4 a, f32x4 b) {
    u32x4 w = {cvtpk(a[0], a[1]), cvtpk(a[2], a[3]), cvtpk(b[0], b[1]), cvtpk(b[2], b[3])};
    return *reinterpret_cast<bf16x8*>(&w);
}
template <class T> __device__ __forceinline__ bf16x8 load8(const T* p) {
    if constexpr (same_t<T, float>::v) { return pack8(*(const f32x4*)p, *(const f32x4*)(p + 4)); }
    else { return *reinterpret_cast<const bf16x8*>(p); }
}
__device__ __forceinline__ void mask_tile(f32x16& p0, f32x16& p1, int dq, unsigned W) {
    const float NEG = -__builtin_inff();
#pragma unroll
    for (int r = 0; r < 16; ++r) {
        const int c = (r & 3) + 8 * (r >> 2);
        if ((unsigned)(dq - c) >= W) p0[r] = NEG;
        if ((unsigned)(dq - c - 32) >= W) p1[r] = NEG;
    }
}
__device__ __forceinline__ void partialSM(f32x16& p0, f32x16& p1, float& m_reg, float& mn, float& alpha) {
    float pmax = p0[0]; for (int r = 1; r < 16; ++r) pmax = fmaxf(pmax, p0[r]); for (int r = 0; r < 16; ++r) pmax = fmaxf(pmax, p1[r]);
    { auto rr = __builtin_amdgcn_permlane32_swap(__float_as_uint(pmax), __float_as_uint(pmax), false, false);
      pmax = fmaxf(__uint_as_float(rr[0]), __uint_as_float(rr[1])); }
    if (__builtin_expect(__all((pmax - m_reg) <= THR), 1)) { mn = m_reg; alpha = 1.f; }
    else { mn = fmaxf(m_reg, pmax); alpha = __builtin_amdgcn_exp2f(m_reg - mn); m_reg = mn; }
    for (int r = 0; r < 16; ++r) p0[r] = p0[r] - mn; for (int r = 0; r < 16; ++r) p1[r] = p1[r] - mn;
    for (int r = 0; r < 16; ++r) p0[r] = __builtin_amdgcn_exp2f(p0[r]);
}
__device__ __forceinline__ void finishSM(f32x16& p0, f32x16& p1, float alpha, float& l_reg, bf16x8& pa0, bf16x8& pa1, bf16x8& pa2, bf16x8& pa3) {
    for (int r = 0; r < 16; ++r) p1[r] = __builtin_amdgcn_exp2f(p1[r]);
    float ps = 0; for (int r = 0; r < 16; ++r) ps += p0[r]; for (int r = 0; r < 16; ++r) ps += p1[r];
    { auto rr = __builtin_amdgcn_permlane32_swap(__float_as_uint(ps), __float_as_uint(ps), false, false);
      ps = __uint_as_float(rr[0]) + __uint_as_float(rr[1]); }
    l_reg = l_reg * alpha + ps;
#define PK4(P, B_, OUT) do { unsigned a0 = cvtpk(P[B_+0], P[B_+1]), a1 = cvtpk(P[B_+2], P[B_+3]);                          \
        unsigned b0 = cvtpk(P[B_+4], P[B_+5]), b1 = cvtpk(P[B_+6], P[B_+7]);                                             \
        auto r0 = __builtin_amdgcn_permlane32_swap(a0, b0, false, false); auto r1 = __builtin_amdgcn_permlane32_swap(a1, b1, false, false); \
        u32x4 w = {r0[0], r1[0], r0[1], r1[1]}; OUT = *reinterpret_cast<bf16x8*>(&w); } while (0)
    PK4(p0, 0, pa0); PK4(p0, 8, pa1); PK4(p1, 0, pa2); PK4(p1, 8, pa3);
#undef PK4
}
template <int KB, bool SK>
__device__ __forceinline__ void qkt(f32x16& p0, f32x16& p1, const char* K_lds, int r32, int hi, const bf16x8* qr, bool act, const char* Ft) {
    if (SK && !act) { const float NEG = -__builtin_inff();
#pragma unroll
        for (int r = 0; r < 16; ++r) { p0[r] = NEG; p1[r] = NEG; } return; }
    { const f32x4* fp = (const f32x4*)Ft;
      const f32x4 a0 = fp[0], a1 = fp[2], a2 = fp[4], a3 = fp[6], b0_ = fp[8], b1_ = fp[10], b2_ = fp[12], b3_ = fp[14];
      p0 = (f32x16){a0[0], a0[1], a0[2], a0[3], a1[0], a1[1], a1[2], a1[3], a2[0], a2[1], a2[2], a2[3], a3[0], a3[1], a3[2], a3[3]};
      p1 = (f32x16){b0_[0], b0_[1], b0_[2], b0_[3], b1_[0], b1_[1], b1_[2], b1_[3], b2_[0], b2_[1], b2_[2], b2_[3], b3_[0], b3_[1], b3_[2], b3_[3]}; }
    const char* kb[4];
#pragma unroll
    for (int dd = 0; dd < 4; ++dd) kb[dd] = K_lds + KB * SHM_K + KSWZ(r32, (dd * 16 + hi * 8) * 2);
#pragma unroll
    for (int d0 = 0; d0 < 8; ++d0) { const char* a = kb[d0 & 3] + (d0 >> 2) * 128;
        bf16x8 b0 = *reinterpret_cast<const bf16x8*>(a);
        bf16x8 b1 = *reinterpret_cast<const bf16x8*>(a + 32 * 256);
        p0 = __builtin_amdgcn_mfma_f32_32x32x16_bf16(b0, qr[d0], p0, 0, 0, 0);
        p1 = __builtin_amdgcn_mfma_f32_32x32x16_bf16(b1, qr[d0], p1, 0, 0, 0); }
}
template <int VB, bool SK>
__device__ __forceinline__ void pv_tile(f32x16* o, int vb0, bf16x8 pa0, bf16x8 pa1, bf16x8 pa2, bf16x8 pa3, bool act) {
    if (SK && !act) return;
#define TRRD(dst, off) asm volatile("ds_read_b64_tr_b16 %0, %1 offset:%2" : "=&v"(dst) : "v"(vb0), "i"(off) : "memory")
#define PV_D0(d0) do { s16x4 l0, l1, l2, l3, h0, h1, h2, h3; constexpr int b_ = VB * SHM_V + v_rd_off(d0, 0, 0);     \
        TRRD(l0, b_); TRRD(h0, b_ + 2048); TRRD(l1, b_ + 4096); TRRD(h1, b_ + 6144); TRRD(l2, b_ + 8192); TRRD(h2, b_ + 10240); TRRD(l3, b_ + 12288); TRRD(h3, b_ + 14336); \
        asm volatile("s_waitcnt lgkmcnt(0)" ::: "memory"); SBAR();                 \
        o[d0] = __builtin_amdgcn_mfma_f32_32x32x16_bf16(pa0, (bf16x8){l0[0], l0[1], l0[2], l0[3], h0[0], h0[1], h0[2], h0[3]}, o[d0], 0, 0, 0);   \
        o[d0] = __builtin_amdgcn_mfma_f32_32x32x16_bf16(pa1, (bf16x8){l1[0], l1[1], l1[2], l1[3], h1[0], h1[1], h1[2], h1[3]}, o[d0], 0, 0, 0);   \
        o[d0] = __builtin_amdgcn_mfma_f32_32x32x16_bf16(pa2, (bf16x8){l2[0], l2[1], l2[2], l2[3], h2[0], h2[1], h2[2], h2[3]}, o[d0], 0, 0, 0);   \
        o[d0] = __builtin_amdgcn_mfma_f32_32x32x16_bf16(pa3, (bf16x8){l3[0], l3[1], l3[2], l3[3], h3[0], h3[1], h3[2], h3[3]}, o[d0], 0, 0, 0); } while (0)
    PV_D0(0); PV_D0(1); PV_D0(2); PV_D0(3);
#undef PV_D0
#undef TRRD
}

template <class TIn, class TOut> struct BlockRef { const TIn* Q; const TIn* K; const TIn* V; TOut* O; const float* F; int P0; int jlo; };
template <class TIn> struct Seam {
    bf16x8 qr[8];
    bf16x8 st_v0, st_v1, st_k0, st_k1; f32x4 sf0, sf1, sf2, sf3;
    f32x4 tq[16];
};
__device__ __forceinline__ int swa_jlo(int P0, int W) { const int lowk = P0 - W + 1; return lowk > 0 ? lowk / KVBLK : 0; }
#define ROW(p, k0, rr) ((p) + (size_t)((k0) + (rr)) * PITCH + sc)
#define VMW() asm volatile("s_waitcnt vmcnt(0)" ::: "memory")
#define VMWN(n) asm volatile("s_waitcnt vmcnt(%0)" :: "i"(n) : "memory")
#define GROW(p, k0, vo) ((const char*)((p) + (size_t)(k0) * PITCH) + (vo))
#define SLOAD_H(Kp, Vp, k0) do { S.st_v0 = *(const bf16x8*)GROW(Vp, k0, vo0); S.st_v1 = *(const bf16x8*)GROW(Vp, k0, vo1);              \
                         S.st_k0 = *(const bf16x8*)GROW(Kp, k0, vo0); S.st_k1 = *(const bf16x8*)GROW(Kp, k0, vo1); } while (0)
#define SWRITE_HK(bf) do { *(bf16x8*)(K_lds + (bf) * SHM_K + kws) = S.st_k0; *(bf16x8*)(K_lds + (bf) * SHM_K + kws + 32 * 256) = S.st_k1; } while (0)
#define SWRITE_HV(bf) do { *(bf16x8*)(V_lds + (bf) * SHM_V + vst0) = S.st_v0; *(bf16x8*)(V_lds + (bf) * SHM_V + vst1) = S.st_v1; } while (0)
#define SWRITE_H(bf) do { SWRITE_HV(bf); SWRITE_HK(bf); } while (0)
#define SLOAD_F(p, k0) do { S.sf0 = *(const f32x4*)ROW(p, k0, sr); S.sf1 = *(const f32x4*)(ROW(p, k0, sr) + 4);                \
                            S.sf2 = *(const f32x4*)ROW(p, k0, 32 + sr); S.sf3 = *(const f32x4*)(ROW(p, k0, 32 + sr) + 4); } while (0)
#define SWRITE_KF(bf) do { *(bf16x8*)(K_lds + (bf) * SHM_K + kws) = pack8(S.sf0, S.sf1); *(bf16x8*)(K_lds + (bf) * SHM_K + kws + 32 * 256) = pack8(S.sf2, S.sf3); } while (0)
#define SWRITE_VF(bf) do { *(bf16x8*)(V_lds + (bf) * SHM_V + vst0) = pack8(S.sf0, S.sf1); *(bf16x8*)(V_lds + (bf) * SHM_V + vst1) = pack8(S.sf2, S.sf3); } while (0)
template <class TIn, class TOut>
__device__ __forceinline__ void causal_swa_prime(const BlockRef<TIn, TOut>& cur, int W, char* lds, Seam<TIn>& S, char* Fdst) {
    constexpr bool F32 = same_t<TIn, float>::v;
    const int tid = tidx(), wid = __builtin_amdgcn_readfirstlane(tid >> 6), lane = tid & 63, r32 = lane & 31, hi = lane >> 5;
    const int sr = tid >> 4, sc = (tid & 15) * 8, kws = KSWZ(sr, sc * 2); char* K_lds = lds + 2 * SHM_V;
    const unsigned vo0 = (unsigned)(sr * PITCH + sc) * 2u, vo1 = vo0 + 32u * PITCH * 2u, qvo = (unsigned)(r32 * PITCH + hi * 8) * 2u;
    const int kb0 = cur.jlo * KVBLK;
    for (int d0 = 0; d0 < 8; ++d0) S.qr[d0] = *(const bf16x8*)((const char*)(cur.Q + (size_t)(wid * QBLK) * PITCH) + qvo + d0 * 32);
    if constexpr (F32) { SLOAD_F((const float*)cur.K, kb0); VMW(); SWRITE_KF(0); SBAR(); SLOAD_F((const float*)cur.V, kb0); }
    else { const f32x4 fa = *(const f32x4*)(cur.F + tid * 4), fb = *(const f32x4*)(cur.F + 2048 + tid * 4);
           SLOAD_H(cur.K, cur.V, kb0); VMW(); SWRITE_HK(0);
           *(f32x4*)(Fdst + tid * 16) = fa; *(f32x4*)(Fdst + 8192 + tid * 16) = fb; }
    __syncthreads();
}
template <class TIn, class TOut>
__device__ __forceinline__ void causal_swa_block(const BlockRef<TIn, TOut>& cur, const BlockRef<TIn, TOut>& nxt, int skv, int W, char* lds, Seam<TIn>& S, const char* Fcur, char* Fnext) {
    constexpr bool F32 = same_t<TIn, float>::v;
    const int tid = tidx(), wid = __builtin_amdgcn_readfirstlane(tid >> 6), lane = tid & 63, r32 = lane & 31, hi = lane >> 5;
    const int j_lo = cur.jlo;
    int j_hi = (cur.P0 + QB - 1) / KVBLK + 1; if (j_hi > skv / KVBLK) j_hi = skv / KVBLK;
    const int NT = j_hi - j_lo;
    const int kbn = nxt.jlo * KVBLK;
    const int qlo = cur.P0 + wid * QBLK, qm = qlo + r32 - 4 * hi;
    char* V_lds = lds; char* K_lds = lds + 2 * SHM_V;
    float* ws = (float*)(lds + 2 * SHM_V + 2 * SHM_K) + wid * 64; float* li_l = ws, * al_l = ws + 32;
    float m_reg = *(const float*)(Fcur + (size_t)(cur.P0 + wid * QBLK + r32) * 4), l_reg = 0; f32x16 o[4] = {};
    const unsigned vo0 = (unsigned)((tid >> 4) * PITCH + (tid & 15) * 8) * 2u, vo1 = vo0 + 32u * PITCH * 2u, qvo = (unsigned)(r32 * PITCH + hi * 8) * 2u;
    const int sr = tid >> 4, sc = (tid & 15) * 8, vst0 = v_st(sr, sc), vst1 = v_st(32 + sr, sc), kws = KSWZ(sr, sc * 2);
    const int vb0 = (int)(uintptr_t)V_lds + v_rd_base(lane);
    const TIn* Kh = cur.K; const TIn* Vh = cur.V;
#define RESC(a) do { if (__any((a) < 1.f)) { if (hi == 0) al_l[r32] = (a); asm volatile("s_waitcnt lgkmcnt(0)" ::: "memory");              \
                     for (int d_ = 0; d_ < 4; ++d_) for (int r = 0; r < 16; ++r) o[d_][r] *= al_l[crow(r, hi)]; } } while (0)
#define KBASE(t) ((j_lo + (t)) * KVBLK)
#define ACT(t) (KBASE(t) <= qlo + QBLK - 1 && KBASE(t) + KVBLK - 1 >= qlo - W + 1)
#define MASKT(P0_, P1_, t) do { const int kb_ = KBASE(t); if ((!SK || ACT(t)) && (kb_ + KVBLK - 1 > qlo || kb_ <= qlo + QBLK - 1 - W)) mask_tile(P0_, P1_, qm - kb_, (unsigned)W); } while (0)
    constexpr int NQL = F32 ? 16 : 8;
    constexpr bool SK = WSKIP && !F32;
#define SEAM_K0() do { VMWN(NQL); if constexpr (F32) { SWRITE_KF(0); SBAR(); SLOAD_F((const float*)nxt.V, kbn); } else { SWRITE_HK(0); } SBAR(); } while (0)
    f32x16 pA0, pA1, pB0, pB1; float mnA, mnB, alA, alB; bf16x8 pa0, pa1, pa2, pa3;
    if constexpr (F32) { VMW(); SWRITE_VF(0); SBAR(); } else { SWRITE_HV(0); SBAR(); }
    if (NT > 1) { if constexpr (F32) SLOAD_F((const float*)Kh, KBASE(1)); else SLOAD_H(Kh, Vh, KBASE(1)); }
    SBAR(); qkt<0, SK>(pA0, pA1, K_lds, r32, hi, S.qr, ACT(0), Fcur + KBASE(0) * 4 + hi * 16);
    if constexpr (F32) { if (NT > 1) { VMW(); SWRITE_KF(1); SBAR(); SLOAD_F((const float*)Vh, KBASE(1)); } }
    MASKT(pA0, pA1, 0); partialSM(pA0, pA1, m_reg, mnA, alA);
    if (NT > 1) { VMW(); if constexpr (F32) { SWRITE_VF(1); SBAR(); if (NT > 2) SLOAD_F((const float*)Kh, KBASE(2)); } else SWRITE_H(1); }
    __syncthreads();
#define HALF_STEP(PX0, PX1, mnX, alX, PY0, PY1, alY, t, KB, VB, SB) do {                                                      \
        SBAR(); qkt<KB, SK>(PX0, PX1, K_lds, r32, hi, S.qr, ACT(t), Fcur + KBASE(t) * 4 + hi * 16);                                             \
        finishSM(PY0, PY1, alY, l_reg, pa0, pa1, pa2, pa3); SBAR();                                                           \
        if ((t) + 1 < NT) { if constexpr (F32) { VMW(); SWRITE_KF(SB); SBAR(); SLOAD_F((const float*)Vh, KBASE((t) + 1)); }  \
                            else { SLOAD_H(Kh, Vh, KBASE((t) + 1)); } SBAR(); }                                               \
        pv_tile<VB, SK>(o, vb0, pa0, pa1, pa2, pa3, ACT((t) - 1)); MASKT(PX0, PX1, (t)); partialSM(PX0, PX1, m_reg, mnX, alX);                                        \
        __syncthreads();                                                                                                      \
        if ((t) + 1 < NT) { VMW(); if constexpr (F32) { SWRITE_VF(SB); SBAR(); if ((t) + 2 < NT) SLOAD_F((const float*)Kh, KBASE((t) + 2)); } \
                            else { SWRITE_H(SB); } }                                                                          \
        RESC(alX); __syncthreads(); } while (0)
    for (int t = 1; t + 1 < NT; t += 2) {
        HALF_STEP(pB0, pB1, mnB, alB, pA0, pA1, alA, t, 1, 0, 0);
        HALF_STEP(pA0, pA1, mnA, alA, pB0, pB1, alB, t + 1, 0, 1, 1);
    }
    const bool even = (NT & 1) == 0;
    if (even) { SBAR(); qkt<1, SK>(pB0, pB1, K_lds, r32, hi, S.qr, ACT(NT - 1), Fcur + KBASE(NT - 1) * 4 + hi * 16); SBAR(); }
#define QROW(e) (nxt.Q + (size_t)(wid * QBLK + r32) * PITCH + ((e) >> 1) * 16 + hi * 8 + ((e) & 1) * 4)
    if constexpr (F32) { SLOAD_F((const float*)nxt.K, kbn); SBAR();
#pragma unroll
        for (int e = 0; e < 8; ++e) S.tq[e] = *(const f32x4*)QROW(e); }
    if constexpr (!F32) { SLOAD_H(nxt.K, nxt.V, kbn); SBAR();
#pragma unroll
        for (int d0 = 0; d0 < 8; ++d0) S.qr[d0] = *(const bf16x8*)((const char*)(nxt.Q + (size_t)(wid * QBLK) * PITCH) + qvo + d0 * 32); }
    SBAR();
    finishSM(pA0, pA1, alA, l_reg, pa0, pa1, pa2, pa3); SBAR();
    if constexpr (F32) {
#pragma unroll
        for (int e = 8; e < 16; ++e) S.tq[e] = *(const f32x4*)QROW(e); SBAR(); }
#undef QROW
    pv_tile<0, SK>(o, vb0, pa0, pa1, pa2, pa3, ACT(even ? NT - 2 : NT - 1));
    if (even) { MASKT(pB0, pB1, NT - 1); partialSM(pB0, pB1, m_reg, mnB, alB); __syncthreads(); RESC(alB);
        finishSM(pB0, pB1, alB, l_reg, pa0, pa1, pa2, pa3); SBAR(); pv_tile<1, SK>(o, vb0, pa0, pa1, pa2, pa3, ACT(NT - 1)); }
    SBAR(); SEAM_K0();
    { const f32x4 nfa = *(const f32x4*)(nxt.F + tid * 4), nfb = *(const f32x4*)(nxt.F + 2048 + tid * 4); VMW();
      *(f32x4*)(Fnext + tid * 16) = nfa; *(f32x4*)(Fnext + 8192 + tid * 16) = nfb; SBAR(); }
    if (hi == 0) li_l[r32] = l_reg; asm volatile("s_waitcnt lgkmcnt(0)" ::: "memory");
    float rli[16];
#pragma unroll
    for (int r = 0; r < 16; ++r) rli[r] = __builtin_amdgcn_rcpf(li_l[crow(r, hi)]);
    TOut* Ow = cur.O + (size_t)(wid * QBLK) * PITCH; const unsigned ovo = (unsigned)(4 * hi * PITCH + r32) * 2u;
#pragma unroll
    for (int r = 0; r < 16; ++r) { const int orow = crow(r, hi);
#pragma unroll
        for (int d0 = 0; d0 < 4; ++d0) { const float v = o[d0][r] * rli[r];
            if constexpr (same_t<TOut, float>::v) { Ow[(size_t)orow * PITCH + d0 * 32 + r32] = v; }
            else { const float vn = __shfl_xor(v, 1);
                   if ((r32 & 1) == 0) *(unsigned*)((char*)(Ow + (size_t)((r & 3) + 8 * (r >> 2)) * PITCH + d0 * 32) + ovo) = cvtpk(v, vn); } } }
    if constexpr (F32) {
#pragma unroll
        for (int d0 = 0; d0 < 8; ++d0) S.qr[d0] = pack8(S.tq[2 * d0], S.tq[2 * d0 + 1]); }
    __syncthreads();
#undef RESC
#undef KBASE
#undef ACT
#undef MASKT
#undef SEAM_K0
#undef HALF_STEP
}
#undef ROW
#undef VMW
#undef VMWN
#undef SLOAD_H
#undef GROW
#undef SWRITE_HK
#undef SWRITE_HV
#undef SWRITE_H
#undef SLOAD_F
#undef SWRITE_KF
#undef SWRITE_VF

constexpr int ATT_F_OFF = LDS_BYTES;
constexpr int ATT_LDS_TOTAL = LDS_BYTES + 2 * 16384;
}
constexpr int BATCH = 4, SEQ = 4096, DM = 2048, NH = 16, HD = 128, FF = 8192, M = BATCH * SEQ;
constexpr int NIN = 3 * DM + NH;
constexpr int NMOD = 6 * DM;
constexpr float RMS_EPS = 1e-6f;
constexpr float LOG2E = 1.4426950408889634f;
constexpr float QSCALE = 0.08838834764831845f * LOG2E;
constexpr int NWAVES = 8, NTHREADS = 512;
constexpr int LDS_TOTAL = 147456;
constexpr int NPHASES = 13;
#ifndef PH_MASK
#define PH_MASK 0xff
#endif
#define KEN(k) ((PH_MASK >> (k)) & 1)
constexpr size_t MiB = 1u << 20;
constexpr size_t WS_MOD = 1 * MiB, WS_SW = 1 * MiB + 512 * 1024, WS_LF = 2 * MiB, WS_FK = 3 * MiB;
constexpr size_t WS_SS = 516 * MiB;
constexpr int SW_UP0 = 0, SW_CIN = 4 * 8192, SW_UP1 = 4 * 8192 + 4 * 6144;
constexpr size_t WS_WQKV = 4 * MiB, WS_WO = 28 * MiB, WS_WCIN = 36 * MiB, WS_WCOUT = 60 * MiB, WS_WUP0 = 68 * MiB, WS_WUP1 = 100 * MiB, WS_WDN0 = 132 * MiB, WS_WDN1 = 164 * MiB;
constexpr size_t WS_XN = 196 * MiB, WS_Q = 260 * MiB, WS_K = 324 * MiB, WS_V = 388 * MiB, WS_O = 452 * MiB, WS_U = 260 * MiB, WS_XRB = 518 * MiB, WS_NRM = 582 * MiB, WS_END = 590 * MiB;
static_assert(WS_U + (size_t)M * FF * 2 == WS_SS && WS_O + (size_t)M * DM * 2 == WS_SS && WS_SS + (size_t)M * 32 * 4 == WS_XRB && WS_XRB + (size_t)M * DM * 2 == WS_NRM && WS_NRM + (size_t)2 * M * 64 * 4 == WS_END && WS_XN + (size_t)M * DM * 2 == WS_Q, "d_ws map");

#define LAS __attribute__((address_space(3)))
typedef unsigned short bf16;
typedef unsigned v4u __attribute__((ext_vector_type(4)));
typedef unsigned v2u __attribute__((ext_vector_type(2)));
typedef float f32x4 __attribute__((ext_vector_type(4)));
typedef float f32x2 __attribute__((ext_vector_type(2)));
#define LDS_WAIT() asm volatile("s_waitcnt lgkmcnt(0)" ::: "memory")
__device__ __forceinline__ unsigned pk2(float lo, float hi) { unsigned r; asm volatile("v_cvt_pk_bf16_f32 %0, %1, %2" : "=v"(r) : "v"(lo), "v"(hi)); return r; }
__device__ __forceinline__ float bf_lo(unsigned w) { return __uint_as_float(w << 16); }
__device__ __forceinline__ float bf_hi(unsigned w) { return __uint_as_float(w & 0xffff0000u); }
__device__ __forceinline__ float wave_sum(float v) {
#pragma unroll
    for (int o = 1; o < 64; o <<= 1) v += __shfl_xor(v, o);
    return v;
}

__device__ __forceinline__ void p0_gemv(const float* c, const float* ada_w, const float* ada_b, float* mod, LAS unsigned char* lds, int tid, int wave, int lane) {
    LAS f32x4* cact = (LAS f32x4*)lds;
    LAS float* red = (LAS float*)(lds + 32768);
    for (int k = tid; k < DM; k += NTHREADS) { f32x4 v;
#pragma unroll
        for (int b = 0; b < 4; ++b) { const float cv = c[b * DM + k]; v[b] = cv / (1.f + expf(-cv)); }
        cact[k] = v; }
    __syncthreads();
    for (int it = blockIdx.x; it < 192; it += gridDim.x) {
        const int l = it / 96, n0 = (it % 96) * 128;
        const float* wp = ada_w + ((size_t)l * DM + 256 * wave) * NMOD + n0 + 2 * lane;
        f32x2 acc[4];
#pragma unroll
        for (int b = 0; b < 4; ++b) acc[b] = (f32x2){0.f, 0.f};
#pragma unroll 16
        for (int kk = 0; kk < 256; ++kk) { const f32x2 wv = __builtin_nontemporal_load((const f32x2*)(wp + (size_t)kk * NMOD));   const f32x4 cv = cact[256 * wave + kk];
#pragma unroll
            for (int b = 0; b < 4; ++b) acc[b] += wv * cv[b]; }
#pragma unroll
        for (int b = 0; b < 4; ++b) *(LAS f32x2*)(red + (wave * 4 + b) * 128 + 2 * lane) = acc[b];
        __syncthreads();
        { const int b = tid >> 7, col = tid & 127; float s = ada_b[l * NMOD + n0 + col];
#pragma unroll
          for (int w = 0; w < 8; ++w) s += red[(w * 4 + b) * 128 + col];
          mod[(size_t)(l * 4 + b) * NMOD + n0 + col] = s; }
        __syncthreads();
    }
}
__device__ __forceinline__ void p0_transpose_item(const float* W, int ld, int K, int nblk, bf16* WT, LAS float* scr, int item, int lane, bool cumap = false) {
    const int kb = item / nblk, nb = item % nblk, k0 = 64 * kb, n0 = 32 * nb;
    const int d0 = !cumap || n0 < DM ? n0 : (n0 < 2 * DM ? DM + 256 * ((n0 - DM) >> 7) + ((n0 - DM) & 127) : DM + 256 * ((n0 - 2 * DM) >> 7) + 128 + ((n0 - 2 * DM) & 127));
#pragma unroll 8
    for (int i = 0; i < 32; ++i) { const int kk = 2 * i + (lane >> 5); scr[kk * 33 + (lane & 31)] = __builtin_nontemporal_load(W + (size_t)(k0 + kk) * ld + n0 + (lane & 31)); }
    LDS_WAIT(); asm volatile("" ::: "memory");
    const int c = lane & 7;
#pragma unroll
    for (int j = 0; j < 4; ++j) { const int n = (lane >> 3) + 8 * j; const LAS float* s = scr + (8 * c) * 33 + n;
        v4u o; o.x = pk2(s[0 * 33], s[1 * 33]); o.y = pk2(s[2 * 33], s[3 * 33]); o.z = pk2(s[4 * 33], s[5 * 33]); o.w = pk2(s[6 * 33], s[7 * 33]);
        *(v4u*)(WT + (size_t)(d0 + n) * K + k0 + 8 * c) = o; }
    LDS_WAIT(); asm volatile("" ::: "memory");
}
struct Args { const float* in[15]; float* out; unsigned char* ws; int ph_lo, ph_hi; };
typedef const __attribute__((address_space(4))) unsigned char* kargp_t;
#define KARG_IN(kq, i) (*(const float* const __attribute__((address_space(4)))*)((kq) + 8 * (i)))
#define KARG_OUT(kq) (*(float* const __attribute__((address_space(4)))*)((kq) + 120))
#define KARG_WS(kq) (*(unsigned char* const __attribute__((address_space(4)))*)((kq) + 128))
static_assert(sizeof(Args) == 144, "Args layout");
__device__ __forceinline__ void p0_transposes(kargp_t kq, LAS unsigned char* lds, int wave, int lane, int gw, int ngw) {
    LAS float* scr = (LAS float*)(lds + wave * 16384);
    unsigned char* ws = KARG_WS(kq);
    constexpr int I_IN = 32 * 192, I_SQ = 32 * 64, I_UP = 32 * 256, I_DN = 128 * 64;
    constexpr int NITEMS = 2 * I_IN + 2 * I_SQ + 2 * I_UP + 2 * I_DN;
    const bool deal = (ngw == 2048); static_assert(NITEMS == 1536 * 22 + 512 * 30, "prologue item deal");
    const int lo_wave = gw < 1536, first = deal ? (lo_wave ? gw : 33792 + (gw - 1536)) : gw, step = deal ? (lo_wave ? 1536 : 512) : ngw, stop = deal ? (lo_wave ? 33792 : NITEMS) : NITEMS;
    for (int it = first; it < stop; it += step) {
        int r = it;
        if (r < I_IN) { p0_transpose_item(KARG_IN(kq, 6), NIN, DM, 192, (bf16*)(ws + WS_WQKV), scr, r, lane); continue; } r -= I_IN;
        if (r < I_SQ) { p0_transpose_item(KARG_IN(kq, 8), DM, DM, 64, (bf16*)(ws + WS_WO), scr, r, lane); continue; } r -= I_SQ;
        if (r < I_IN) { p0_transpose_item(KARG_IN(kq, 9), 3 * DM, DM, 192, (bf16*)(ws + WS_WCIN), scr, r, lane, true); continue; } r -= I_IN;
        if (r < I_SQ) { p0_transpose_item(KARG_IN(kq, 11), DM, DM, 64, (bf16*)(ws + WS_WCOUT), scr, r, lane); continue; } r -= I_SQ;
        if (r < I_UP) { p0_transpose_item(KARG_IN(kq, 12), FF, DM, 256, (bf16*)(ws + WS_WUP0), scr, r, lane); continue; } r -= I_UP;
        if (r < I_UP) { p0_transpose_item(KARG_IN(kq, 12) + (size_t)DM * FF, FF, DM, 256, (bf16*)(ws + WS_WUP1), scr, r, lane); continue; } r -= I_UP;
        if (r < I_DN) { p0_transpose_item(KARG_IN(kq, 13), DM, FF, 64, (bf16*)(ws + WS_WDN0), scr, r, lane); continue; } r -= I_DN;
        p0_transpose_item(KARG_IN(kq, 13) + (size_t)FF * DM, DM, FF, 64, (bf16*)(ws + WS_WDN1), scr, r, lane);
    }
}
__device__ __forceinline__ void ld8nt(const bf16* p, float (&f)[8]) { const v4u w = __builtin_nontemporal_load((const v4u*)p); f[0] = bf_lo(w.x); f[1] = bf_hi(w.x); f[2] = bf_lo(w.y); f[3] = bf_hi(w.y); f[4] = bf_lo(w.z); f[5] = bf_hi(w.z); f[6] = bf_lo(w.w); f[7] = bf_hi(w.w); }
__device__ __forceinline__ void ld8(const bf16* p, float (&f)[8]) { const v4u w = *(const v4u*)p; f[0] = bf_lo(w.x); f[1] = bf_hi(w.x); f[2] = bf_lo(w.y); f[3] = bf_hi(w.y); f[4] = bf_lo(w.z); f[5] = bf_hi(w.z); f[6] = bf_lo(w.w); f[7] = bf_hi(w.w); }
__device__ __forceinline__ void shiftw_mfma(const float* mod, unsigned char* ws, float* SW, LAS unsigned char* lds, int tid, int lane, int gw, int ngw) {
    LAS bf16* S = (LAS bf16*)lds;
#pragma unroll
    for (int it = 0; it < 3 * 4 * DM / 4 / NTHREADS; ++it) { const int idx = tid + it * NTHREADS, mat = idx / DM, b = (idx / (DM / 4)) & 3, k = (idx & (DM / 4 - 1)) * 4;
        const float* shp = mat == 0 ? mod + 3 * DM : (mat == 1 ? mod + (size_t)4 * NMOD : mod + (size_t)4 * NMOD + 3 * DM);
        const f32x4 v = *(const f32x4*)(shp + (size_t)b * NMOD + k); unsigned hb[4], lb[4];
#pragma unroll
        for (int i = 0; i < 4; ++i) { hb[i] = pk2(v[i], 0.f) & 0xffffu; lb[i] = pk2(v[i] - __uint_as_float(hb[i] << 16), 0.f) & 0xffffu; }
        v2u h2, l2; h2.x = hb[0] | (hb[1] << 16); h2.y = hb[2] | (hb[3] << 16); l2.x = lb[0] | (lb[1] << 16); l2.y = lb[2] | (lb[3] << 16);
        *(LAS v2u*)(S + (mat * 8 + b) * DM + k) = h2; *(LAS v2u*)(S + (mat * 8 + 4 + b) * DM + k) = l2; }
    __syncthreads();
    const int fr = lane & 15, fq = lane >> 4;
    for (int g = gw; g < 1408; g += ngw) {
        const int mat = g < 512 ? 0 : (g < 896 ? 1 : 2), g0 = g - (mat == 0 ? 0 : (mat == 1 ? 512 : 896)), N = mat == 1 ? 3 * DM : FF;
        const bf16* Wt = (const bf16*)(ws + (mat == 0 ? WS_WUP0 : (mat == 1 ? WS_WCIN : WS_WUP1)));
        float* sw = SW + (mat == 0 ? SW_UP0 : (mat == 1 ? SW_CIN : SW_UP1));
        const bf16* wp = Wt + (size_t)(g0 * 16 + fr) * DM + 8 * fq;
        const LAS bf16* sp = S + (mat * 8 + (fr & 7)) * DM + 8 * fq;
        pg8::f32x4 acc = {0.f, 0.f, 0.f, 0.f};
#pragma unroll 8
        for (int kk = 0; kk < DM / 32; ++kk) { const pg8::bf16x8 wf = *(const pg8::bf16x8*)(wp + 32 * kk); pg8::bf16x8 sf = *(const LAS pg8::bf16x8*)(sp + 32 * kk);
            if (fr >= 8) sf = (pg8::bf16x8){0, 0, 0, 0, 0, 0, 0, 0};
            acc = __builtin_amdgcn_mfma_f32_16x16x32_bf16(wf, sf, acc, 0, 0, 0); }
        pg8::f32x4 r;
#pragma unroll
        for (int i = 0; i < 4; ++i) r[i] = acc[i] + __shfl_xor(acc[i], 4);
        if (fr < 4) *(pg8::f32x4*)(sw + (size_t)fr * N + g0 * 16 + 4 * fq) = r;
    }
}
constexpr int WFT_LD = DM + 8;
__device__ __forceinline__ void norm_phase(const float* src, const float* gain, const float* shp, const float* scp, bf16* XN,
                                           const float* w_in, const float* b_f, float* LF, LAS unsigned char* lds, int tid, int lane, int wave, int gw, int ngw) {
    LAS bf16* WFT = (LAS bf16*)lds;
#pragma unroll
    for (int idx = tid; idx < 8192; idx += NTHREADS) { const int k = idx >> 2, n4 = idx & 3;
        const f32x4 v = *(const f32x4*)(w_in + (size_t)k * NIN + 3 * DM + 4 * n4);
#pragma unroll
        for (int i = 0; i < 4; ++i) { const unsigned hb = pk2(v[i], 0.f) & 0xffffu; const unsigned lb = pk2(v[i] - __uint_as_float(hb << 16), 0.f) & 0xffffu;
            WFT[(4 * n4 + i) * WFT_LD + k] = (bf16)hb; WFT[(16 + 4 * n4 + i) * WFT_LD + k] = (bf16)lb; } }
    for (int grp = gw; grp < M / 8; grp += ngw) {
        const int row0 = grp * 8, b = row0 / SEQ;
        for (int rq = 0; rq < 2; ++rq) {
            asm volatile("" ::: "memory");
            f32x4 v[4][8]; float inv[4];
#pragma unroll
            for (int r = 0; r < 4; ++r)
#pragma unroll
                for (int j = 0; j < 8; ++j) v[r][j] = __builtin_nontemporal_load((const f32x4*)(src + (size_t)(row0 + 4 * rq + r) * DM) + lane + 64 * j);
#pragma unroll
            for (int r = 0; r < 4; ++r) { float ss = 0.f;
#pragma unroll
                for (int j = 0; j < 8; ++j) ss += (v[r][j].x * v[r][j].x + v[r][j].y * v[r][j].y) + (v[r][j].z * v[r][j].z + v[r][j].w * v[r][j].w);
                inv[r] = 1.0f / sqrtf(wave_sum(ss) * (1.f / DM) + RMS_EPS); }
#pragma unroll
            for (int j = 0; j < 8; ++j) { const f32x4 g = ((const f32x4*)gain)[lane + 64 * j], sc = ((const f32x4*)(scp + (size_t)b * NMOD))[lane + 64 * j], sh = ((const f32x4*)(shp + (size_t)b * NMOD))[lane + 64 * j];
                const f32x4 ca = g * (sc + 1.f);
#pragma unroll
                for (int r = 0; r < 4; ++r) { const f32x4 h = (v[r][j] * inv[r]) * ca + sh; v2u w; w.x = pk2(h.x, h.y); w.y = pk2(h.z, h.w);
                    ((v2u*)(XN + (size_t)(row0 + 4 * rq + r) * DM))[lane + 64 * j] = w; } }
        }
    }
    __syncthreads();
    if ((wave & 1) == 0) {
        const int fr = lane & 15, fq = lane >> 4;
        for (int grp = gw; grp < M / 8; grp += ngw) {
            const int row0 = grp * 8, b = row0 / SEQ;
            const bf16* xp = XN + (size_t)(row0 + fr) * DM + 8 * fq;
            const LAS bf16* yh = WFT + fr * WFT_LD + 8 * fq; const LAS bf16* yl = yh + 16 * WFT_LD;
            pg8::f32x4 ah = {0.f, 0.f, 0.f, 0.f}, al = {0.f, 0.f, 0.f, 0.f};
#pragma unroll 8
            for (int kk = 0; kk < DM / 32; ++kk) { const pg8::bf16x8 xf = *(const pg8::bf16x8*)(xp + 32 * kk);
                ah = __builtin_amdgcn_mfma_f32_16x16x32_bf16(xf, *(const LAS pg8::bf16x8*)(yh + 32 * kk), ah, 0, 0, 0);
                al = __builtin_amdgcn_mfma_f32_16x16x32_bf16(xf, *(const LAS pg8::bf16x8*)(yl + 32 * kk), al, 0, 0, 0); }
            const float bias = b_f[fr]; pg8::f32x4 lf;
#pragma unroll
            for (int i = 0; i < 4; ++i) { const float z = ah[i] + al[i] + bias; lf[i] = fminf(z, 0.f) - log1pf(expf(-fabsf(z))); }
            *(pg8::f32x4*)(LF + (size_t)(b * NH + fr) * SEQ + (row0 % SEQ) + 4 * fq) = lf;
        }
    }
}
__device__ __forceinline__ void cumsum_block(const float* LF, float* FK, int bh, LAS unsigned char* lds, int tid, int wave, int lane) {
    const f32x4 a = *(const f32x4*)(LF + (size_t)bh * SEQ + 8 * tid), b = *(const f32x4*)(LF + (size_t)bh * SEQ + 8 * tid + 4);
    float p[8]; p[0] = a.x; p[1] = p[0] + a.y; p[2] = p[1] + a.z; p[3] = p[2] + a.w; p[4] = p[3] + b.x; p[5] = p[4] + b.y; p[6] = p[5] + b.z; p[7] = p[6] + b.w;
    float incl = p[7];
#pragma unroll
    for (int o = 1; o < 64; o <<= 1) { const float t = __shfl_up(incl, o); if (lane >= o) incl += t; }
    LAS float* wt = (LAS float*)lds;
    if (lane == 63) wt[wave] = incl;
    __syncthreads();
    float off = incl - p[7];
    for (int w = 0; w < wave; ++w) off += wt[w];
    f32x4 o0, o1; o0.x = -(off + p[0]) * LOG2E; o0.y = -(off + p[1]) * LOG2E; o0.z = -(off + p[2]) * LOG2E; o0.w = -(off + p[3]) * LOG2E;
    o1.x = -(off + p[4]) * LOG2E; o1.y = -(off + p[5]) * LOG2E; o1.z = -(off + p[6]) * LOG2E; o1.w = -(off + p[7]) * LOG2E;
    *(f32x4*)(FK + (size_t)bh * SEQ + 8 * tid) = o0; *(f32x4*)(FK + (size_t)bh * SEQ + 8 * tid + 4) = o1;
    __syncthreads();
}
typedef __hip_bfloat16 hbf;
__device__ __forceinline__ void att_item(int L, int pass, int& bh, int& qb) {
    const int xcd = L & 7, k = L >> 3; bh = (k >> 3) * 8 + xcd; const int x0 = k & 7, x = (L >= 256) ? 7 - x0 : x0; qb = pass ? 15 - x : x;
}
__device__ __forceinline__ att::BlockRef<hbf, hbf> att_ref(int L, int pass, int jlo, const hbf* Q, const hbf* K, const hbf* V, hbf* O, const float* FK) {
    int bh, qb; att_item(L, pass, bh, qb);
    const int b = bh >> 4, h = bh & 15; const size_t rowbase = (size_t)b * SEQ;
    att::BlockRef<hbf, hbf> r;
    r.Q = Q + (rowbase + (size_t)qb * 256) * DM + h * HD; r.O = O + (rowbase + (size_t)qb * 256) * DM + h * HD;
    r.K = K + rowbase * DM + h * HD; r.V = V + rowbase * DM + h * HD; r.F = FK + (size_t)bh * SEQ; r.P0 = qb * 256; r.jlo = jlo;
    return r;
}
__device__ __forceinline__ int att_jlo(int L, int pass, const float* NRM, const float* FK, LAS unsigned char* lds, int tid, int lane, int wave) {
    int bh, qb; att_item(L, pass, bh, qb);
    const int b = bh >> 4, h = bh & 15, P0 = qb * 256; const size_t rowbase = (size_t)b * SEQ;
    const float* NQ = NRM + (size_t)bh * SEQ * 4; const float* NK = NRM + ((size_t)(BATCH * NH) + bh) * SEQ * 4;
    float kq = 0.f, kk = 0.f;
    if (tid < 256) { const f32x4 v = *(const f32x4*)(NQ + (size_t)(P0 + tid) * 4); kq = (v[0] + v[1]) + (v[2] + v[3]); }
    for (int s = tid; s < P0 + 256; s += NTHREADS) { const f32x4 v = *(const f32x4*)(NK + (size_t)s * 4); kk = fmaxf(kk, (v[0] + v[1]) + (v[2] + v[3])); }
#pragma unroll
    for (int o = 1; o < 64; o <<= 1) { kq = fmaxf(kq, __shfl_xor(kq, o)); kk = fmaxf(kk, __shfl_xor(kk, o)); }
    LAS float* red = (LAS float*)(lds + 122880);
    if (lane == 0) { red[wave] = kq; red[8 + wave] = kk; }
    __syncthreads();
    float mq = 0.f, mk = 0.f;
#pragma unroll
    for (int w = 0; w < 8; ++w) { mq = fmaxf(mq, red[w]); mk = fmaxf(mk, red[8 + w]); }
    const float B = 1.02f * sqrtf(mq * mk);
    const float* F = FK + (size_t)bh * SEQ;
    const float fend = F[64 * lane + 63], f0 = F[P0];
    const bool skip = (64 * lane + 63 < P0) && (2.f * B + fend - f0 < -60.f);
    const int jlo = __popcll(__ballot(skip));
    __syncthreads();
    return __builtin_amdgcn_readfirstlane(jlo);
}
__device__ __forceinline__ void attn_phase(const hbf* Q, const hbf* K, const hbf* V, hbf* O, const float* FK, const float* NRM, char* lds) {
    constexpr int total = 8 * BATCH * NH, W = 1 << 30;
    const int stride = gridDim.x; int L = blockIdx.x; if (L >= total) return;
    const int L0 = L;
    int jl0, jl1, jl2 = 0, jl3 = 0;
    { const int tid = tidx(), lane = tid & 63, wave = __builtin_amdgcn_readfirstlane(tid >> 6);
      jl0 = att_jlo(L0, 0, NRM, FK, (LAS unsigned char*)lds, tid, lane, wave); jl1 = att_jlo(L0, 1, NRM, FK, (LAS unsigned char*)lds, tid, lane, wave);
      if (L0 + stride < total) { jl2 = att_jlo(L0 + stride, 0, NRM, FK, (LAS unsigned char*)lds, tid, lane, wave); jl3 = att_jlo(L0 + stride, 1, NRM, FK, (LAS unsigned char*)lds, tid, lane, wave); } }
    int pass = 0, fsel = 0;
    att::BlockRef<hbf, hbf> cur = att_ref(L, 0, jl0, Q, K, V, O, FK);
    att::Seam<hbf> S;
    att::causal_swa_prime<hbf, hbf>(cur, W, lds, S, lds + att::ATT_F_OFF);
    for (;;) {
        const bool more_pass = pass == 0, more_item = (L == L0) && (L + stride < total), last = !more_pass && !more_item;
        int passn = pass + 1, Ln = L;
        if (!more_pass) { passn = 0; Ln = more_item ? L + stride : L; }
        const int jn = (Ln == L0) ? (passn ? jl1 : jl0) : (passn ? jl3 : jl2);
        const att::BlockRef<hbf, hbf> nxt = last ? cur : att_ref(Ln, passn, jn, Q, K, V, O, FK);
        att::causal_swa_block<hbf, hbf>(cur, nxt, SEQ, W, lds, S, lds + att::ATT_F_OFF + fsel * 16384, lds + att::ATT_F_OFF + (fsel ^ 1) * 16384);
        if (last) break;
        cur = nxt; pass = passn; L = Ln; fsel ^= 1;
    }
}
__device__ __forceinline__ void conv_phase(const bf16* BG, const bf16* P, const float* cw, bf16* Y, int lane, int gw, int ngw) {
    for (int grp = gw; grp < M / 8; grp += ngw) {
        const int row0 = grp * 8, t0 = row0 % SEQ;
        for (int j = 0; j < 4; ++j) {
            const int ch = (lane + 64 * j) * 8;
            float w0[8], w1[8], w2[8], pm2[8], pm1[8];
#pragma unroll
            for (int i = 0; i < 8; ++i) { w0[i] = cw[ch + i]; w1[i] = cw[DM + ch + i]; w2[i] = cw[2 * DM + ch + i]; pm2[i] = 0.f; pm1[i] = 0.f; }
            if (t0 > 0) { ld8(P + (size_t)(row0 - 2) * DM + ch, pm2); ld8(P + (size_t)(row0 - 1) * DM + ch, pm1); }
#pragma unroll
            for (int r = 0; r < 8; ++r) { float p8[8], b8[8], y[8];
                ld8nt(P + (size_t)(row0 + r) * DM + ch, p8); ld8nt(BG + (size_t)(row0 + r) * DM + ch, b8);
#pragma unroll
                for (int i = 0; i < 8; ++i) { y[i] = b8[i] * (w0[i] * pm2[i] + w1[i] * pm1[i] + w2[i] * p8[i]); pm2[i] = pm1[i]; pm1[i] = p8[i]; }
                v4u o; o.x = pk2(y[0], y[1]); o.y = pk2(y[2], y[3]); o.z = pk2(y[4], y[5]); o.w = pk2(y[6], y[7]);
                *(v4u*)(Y + (size_t)(row0 + r) * DM + ch) = o; }
        }
    }
}
__device__ __forceinline__ void final_norm_phase(const bf16* xr, float* out, const float* gain, int lane, int gw, int ngw) {
    for (int r0 = gw * 4; r0 < M; r0 += ngw * 4) {
        v4u raw[4][4];
#pragma unroll
        for (int r = 0; r < 4; ++r)
#pragma unroll
            for (int j = 0; j < 4; ++j) raw[r][j] = __builtin_nontemporal_load((const v4u*)(xr + (size_t)(r0 + r) * DM + (lane + 64 * j) * 8));
        float inv[4];
#pragma unroll
        for (int r = 0; r < 4; ++r) { float ss = 0.f;
#pragma unroll
            for (int j = 0; j < 4; ++j) { const unsigned w[4] = {raw[r][j].x, raw[r][j].y, raw[r][j].z, raw[r][j].w};
#pragma unroll
                for (int i = 0; i < 4; ++i) { const float a = bf_lo(w[i]), b = bf_hi(w[i]); ss += a * a + b * b; } }
            inv[r] = 1.0f / sqrtf(wave_sum(ss) * (1.f / DM) + RMS_EPS); }
#pragma unroll
        for (int j = 0; j < 4; ++j) { const f32x4 g0 = *(const f32x4*)(gain + (lane + 64 * j) * 8), g1 = *(const f32x4*)(gain + (lane + 64 * j) * 8 + 4);
#pragma unroll
            for (int r = 0; r < 4; ++r) { const v4u w = raw[r][j]; f32x4 o0, o1;
                o0[0] = bf_lo(w.x); o0[1] = bf_hi(w.x); o0[2] = bf_lo(w.y); o0[3] = bf_hi(w.y); o1[0] = bf_lo(w.z); o1[1] = bf_hi(w.z); o1[2] = bf_lo(w.w); o1[3] = bf_hi(w.w);
                o0 = (o0 * inv[r]) * g0; o1 = (o1 * inv[r]) * g1;
                __builtin_nontemporal_store(o0, (f32x4*)(out + (size_t)(r0 + r) * DM + (lane + 64 * j) * 8)); __builtin_nontemporal_store(o1, (f32x4*)(out + (size_t)(r0 + r) * DM + (lane + 64 * j) * 8 + 4)); } }
    }
}

#define XB_TMO      128
#define XB_XCNT(j)  (256  + 64 * (j))
#define XB_XSUB(j)  (1280 + 64 * (j))
#define XB_XGEN(j)  (2304 + 64 * (j))
#define XB_TOP      3328
#define XB_TOPGEN   3392
#define XCD_BAR_WORDS 3456
#define XB_SPIN_CAP (1u << 18)

__device__ __forceinline__ unsigned xb_ld(unsigned* p)              { return __hip_atomic_load(p, __ATOMIC_RELAXED, __HIP_MEMORY_SCOPE_AGENT); }
__device__ __forceinline__ unsigned xb_add(unsigned* p, unsigned v) { return __hip_atomic_fetch_add(p, v, __ATOMIC_RELAXED, __HIP_MEMORY_SCOPE_AGENT); }
__device__ __forceinline__ unsigned xb_xcc_id() { return (unsigned)__builtin_amdgcn_s_getreg((3 << 11) | 20) & 0xFu; }
#define XB_SPIN(cond, bar) do { unsigned _sp = 0; while (cond) { __builtin_amdgcn_s_sleep(1); \
    if ((++_sp & 255u) == 0u) { if (xb_ld(&(bar)[XB_TMO])) break; if (_sp > XB_SPIN_CAP) { atomicAdd(&(bar)[XB_TMO], 1u); break; } } } } while (0)

struct XcdBarrier {
    unsigned* bar; unsigned x;
    volatile LAS unsigned* st;
};

__device__ __forceinline__ XcdBarrier xcd_barrier_post(unsigned* bar, volatile LAS unsigned* st) {
    XcdBarrier b; b.bar = bar; b.x = xb_xcc_id(); b.st = st;
    if (threadIdx.x == 0) (void)xb_add(&bar[XB_XCNT(b.x)], 1u);
    return b;
}
__device__ __forceinline__ void xcd_barrier_complete(unsigned* bar, unsigned x, unsigned& nloc, unsigned& nx) {
    const unsigned G = gridDim.x * gridDim.y * gridDim.z;
    unsigned sum, cnt, mine, sp = 0u;
    for (;;) {
        sum = 0u; cnt = 0u; mine = 0u;
#pragma unroll
        for (unsigned j = 0; j < 16; ++j) { const unsigned c = xb_ld(&bar[XB_XCNT(j)]); sum += c; cnt += (c > 0u) ? 1u : 0u; mine = (j == x) ? c : mine; }
        if (sum == G) break;
        __builtin_amdgcn_s_sleep(1);
        if ((++sp & 255u) == 0u) { if (xb_ld(&bar[XB_TMO])) break; if (sp > XB_SPIN_CAP) { atomicAdd(&bar[XB_TMO], 1u); break; } }
    }
    nloc = mine > 0u ? mine : 1u; nx = cnt > 0u ? cnt : 1u;
}

__device__ __forceinline__ void xcd_barrier(const XcdBarrier& b) {
    asm volatile("s_waitcnt vmcnt(0)" ::: "memory");
    __syncthreads();
    if (threadIdx.x == 0) {
        unsigned* bar = b.bar;
        __builtin_amdgcn_s_waitcnt(0);
        unsigned nloc = b.st[0], nx = b.st[1];
        if (nloc == 0u) { xcd_barrier_complete(bar, b.x, nloc, nx); b.st[0] = nloc; b.st[1] = nx; }
        const unsigned old = xb_add(&bar[XB_XSUB(b.x)], 1u);
        const unsigned gen = old / nloc;
        if (old + 1u == (gen + 1u) * nloc) {
            __builtin_amdgcn_fence(__ATOMIC_RELEASE, "agent");
            asm volatile("s_waitcnt vmcnt(0)" ::: "memory");
            const unsigned og = xb_add(&bar[XB_TOP], 1u);
            const unsigned tg = og / nx;
            if (og + 1u == (tg + 1u) * nx) xb_add(&bar[XB_TOPGEN], 1u);
            else XB_SPIN(xb_ld(&bar[XB_TOPGEN]) == tg, bar);
            __builtin_amdgcn_fence(__ATOMIC_ACQUIRE, "agent");
            xb_add(&bar[XB_XGEN(b.x)], 1u);
            asm volatile("s_waitcnt vmcnt(0)" ::: "memory");
        } else {
            XB_SPIN(xb_ld(&bar[XB_XGEN(b.x)]) == gen, bar);
            __builtin_amdgcn_fence(__ATOMIC_ACQUIRE, "agent");
            asm volatile("s_waitcnt vmcnt(0)" ::: "memory");
        }
    }
    __syncthreads();
}

enum { K_PRO = 0, K_NORM, K_GEMM_BF16, K_ATTN, K_GEMM_RES, K_GEMM_SQ, K_CONV, K_FINAL };
__global__ void __launch_bounds__(NTHREADS, 2) fwd_mega(Args a) {
    extern __shared__ __attribute__((aligned(16))) unsigned char lds[];
    LAS unsigned char* L = (LAS unsigned char*)lds;
    const int G = gridDim.x, ngw = G * NWAVES;
    const kargp_t kp = (kargp_t)__builtin_amdgcn_kernarg_segment_ptr();
    const int ph_lo = a.ph_lo, ph_hi = a.ph_hi;
    volatile LAS unsigned* MISC = (volatile LAS unsigned*)(L + LDS_TOTAL - 256);
    if (tidx() < 32) MISC[tidx()] = 0u;
    __syncthreads();
    XcdBarrier xbar; xbar.bar = (unsigned*)a.ws; xbar.x = 0; xbar.st = nullptr;
    if (ph_hi - ph_lo > 1) xbar = xcd_barrier_post((unsigned*)a.ws, MISC + 8);
#if defined(PROBE_REP_KIND)
    int rep_left = PROBE_REP_N;
#endif
    for (int ph = ph_lo; ph < ph_hi; ++ph) {
        kargp_t kq = kp; asm volatile("" : "+s"(kq));
        unsigned char* ws = KARG_WS(kq);
        const float* x = KARG_IN(kq, 0);
        float* mod = (float*)(ws + WS_MOD); float* LF = (float*)(ws + WS_LF); float* FK = (float*)(ws + WS_FK);
        bf16* XN = (bf16*)(ws + WS_XN); bf16* Qb = (bf16*)(ws + WS_Q); bf16* Kb = (bf16*)(ws + WS_K); bf16* Vb = (bf16*)(ws + WS_V); bf16* Ob = (bf16*)(ws + WS_O); bf16* Ub = (bf16*)(ws + WS_U);
        float* XR = KARG_OUT(kq);
        const int layer = ph >= 7 ? 1 : 0;
        int kind;
        switch (ph) {
            case 0: kind = K_PRO; break;
            case 1: kind = K_NORM; break;
            case 2: case 7: kind = K_GEMM_BF16; break;
            case 3: kind = K_ATTN; break;
            case 4: case 6: case 9: case 11: kind = K_GEMM_RES; break;
            case 5: case 10: kind = K_GEMM_SQ; break;
            case 8: kind = K_CONV; break;
            default: kind = K_FINAL; break;
        }
        const bool mlp_half = (ph == 5 || ph == 6 || ph == 10 || ph == 11);
        const float* modl = mod + (size_t)layer * 4 * NMOD;
        float* SS = (float*)(ws + WS_SS); float* SW = (float*)(ws + WS_SW);
        if (KEN(K_PRO) && kind == K_PRO) {
            const int tid = tidx(), lane = tid & 63, wave = __builtin_amdgcn_readfirstlane(tid >> 6), gw = blockIdx.x * NWAVES + wave; (void)tid; (void)lane; (void)wave; (void)gw;
            p0_gemv(KARG_IN(kq, 1), KARG_IN(kq, 2), KARG_IN(kq, 3), mod, L, tid, wave, lane);
            p0_transposes(kq, L, wave, lane, gw, ngw);
            __syncthreads();
        } else if (KEN(K_NORM) && kind == K_NORM) {
            const int tid = tidx(), lane = tid & 63, wave = __builtin_amdgcn_readfirstlane(tid >> 6), gw = blockIdx.x * NWAVES + wave; (void)tid; (void)lane; (void)wave; (void)gw;
            norm_phase(x, KARG_IN(kq, 4), modl, modl + DM, XN, KARG_IN(kq, 6), KARG_IN(kq, 7), LF, L, tid, lane, wave, gw, ngw);
            __syncthreads();
            shiftw_mfma(mod, ws, SW, L, tid, lane, gw, ngw);
            __syncthreads();
        } else if (KEN(K_GEMM_BF16) && kind == K_GEMM_BF16) {
            const int tid = tidx(), lane = tid & 63, wave = __builtin_amdgcn_readfirstlane(tid >> 6), gw = blockIdx.x * NWAVES + wave; (void)tid; (void)lane; (void)wave; (void)gw;
            if (ph == 2) { for (int bh = blockIdx.x; bh < BATCH * NH; bh += G) cumsum_block(LF, FK, bh, L, tid, wave, lane); }
            pg8::Gemm g{XN, (const bf16*)(ws + (ph == 2 ? WS_WQKV : WS_WCIN)), M, 3 * DM, DM}; pg8::StaticOrder S; S.init(M, 3 * DM, G, (int)blockIdx.x);
            pg8::EpiBf16<0> E{Qb, DM, DM, (size_t)(WS_K - WS_Q) / 2, ph == 2 ? QSCALE : 1.0f, ph == 2 ? (const float*)nullptr : (const float*)SS, SW + SW_CIN, 3 * DM, SEQ, ph == 2 ? (bf16*)nullptr : Kb, 8, ph == 2 ? (float*)(ws + WS_NRM) : (float*)nullptr};
            pg8::gemm_phase<pg8::EpiBf16<0>, pg8::StaticOrder, true, true>(L, g, S, E);
        } else if (KEN(K_ATTN) && kind == K_ATTN) {
            attn_phase((const hbf*)Qb, (const hbf*)Kb, (const hbf*)Vb, (hbf*)Ob, FK, (const float*)(ws + WS_NRM), (char*)lds);
        } else if (KEN(K_GEMM_RES) && kind == K_GEMM_RES) {
            const bf16* A = mlp_half ? Ub : Ob; const int Kd = mlp_half ? FF : DM;
            const size_t wo = mlp_half ? (layer ? WS_WDN1 : WS_WDN0) : (layer ? WS_WCOUT : WS_WO);
            pg8::Gemm g{A, (const bf16*)(ws + wo), M, DM, Kd}; pg8::StaticOrder S; S.init(M, DM, G, (int)blockIdx.x);
            const float* n_gain = mlp_half ? KARG_IN(kq, 4) + DM : KARG_IN(kq, 5) + (size_t)layer * DM;
            const float* n_scale = mlp_half ? mod + (size_t)4 * NMOD + DM : modl + 4 * DM;
            bf16* XRB = (bf16*)(ws + WS_XRB);
            pg8::EpiRes E{ph == 4 ? x : (const float*)nullptr, ph == 4 ? (const bf16*)nullptr : (const bf16*)XRB, (float*)nullptr, XRB, DM, modl + (mlp_half ? 5 * DM : 2 * DM), SEQ, NMOD, ph == 11 ? (bf16*)nullptr : XN, n_gain, n_scale, SS};
            pg8::gemm_phase<pg8::EpiRes, pg8::StaticOrder, true, true>(L, g, S, E);
        } else if (KEN(K_GEMM_SQ) && kind == K_GEMM_SQ) {
            pg8::Gemm g{XN, (const bf16*)(ws + (layer ? WS_WUP1 : WS_WUP0)), M, FF, DM}; pg8::StaticOrder S; S.init(M, FF, G, (int)blockIdx.x);
#if defined(PROBE_NULL_EPI)
            if (rep_left < PROBE_REP_N) { pg8::EpiNull E0{Ub}; pg8::gemm_phase<pg8::EpiNull, pg8::StaticOrder, true, true>(L, g, S, E0); } else
#endif
            { pg8::EpiBf16<2> E{Ub, FF, 0, 0, 1.0f, SS, SW + (layer ? SW_UP1 : SW_UP0), FF, SEQ, (bf16*)nullptr, 0, (float*)nullptr};
            pg8::gemm_phase<pg8::EpiBf16<2>, pg8::StaticOrder, true, true>(L, g, S, E); }
        } else if (KEN(K_CONV) && kind == K_CONV) {
            const int tid = tidx(), lane = tid & 63, wave = __builtin_amdgcn_readfirstlane(tid >> 6), gw = blockIdx.x * NWAVES + wave; (void)tid; (void)lane; (void)wave; (void)gw;
            conv_phase(Qb, Kb, KARG_IN(kq, 10), Ob, lane, gw, ngw);
        } else if (KEN(K_FINAL) && kind == K_FINAL) {
            const int tid = tidx(), lane = tid & 63, wave = __builtin_amdgcn_readfirstlane(tid >> 6), gw = blockIdx.x * NWAVES + wave; (void)tid; (void)lane; (void)wave; (void)gw;
            final_norm_phase((const bf16*)(ws + WS_XRB), XR, KARG_IN(kq, 14), lane, gw, ngw);
        }
#if defined(PROBE_REP_KIND)
        if (kind == PROBE_REP_KIND && !(kind == K_GEMM_RES && ph != 4) && rep_left > 0) { --rep_left; xcd_barrier(xbar); --ph; continue; }
        rep_left = PROBE_REP_N;
#endif
#if defined(PROBE_EXTRA_SYNC)
        for (int es = 0; es < PROBE_EXTRA_SYNC; ++es) xcd_barrier(xbar);
#endif
        if (ph + 1 < ph_hi) { if (ph_hi > NPHASES) cg::this_grid().sync(); else xcd_barrier(xbar); }
    }
}

extern "C" void kernel_launch(void* const* d_in, const int* in_sizes, int n_in, void* d_out, int out_size, void* d_ws, size_t ws_size, hipStream_t stream) {
    static int grid = 0;
    if (grid == 0) {
        if (n_in != 15 || in_sizes[0] != M * DM || out_size != M * DM || ws_size < WS_END) { fprintf(stderr, "kernel_launch: shape/workspace mismatch (n_in %d, in0 %d, out %d, ws %zu)\n", n_in, n_in > 0 ? in_sizes[0] : -1, out_size, ws_size); grid = -1; return; }
        int dev = 0, cus = 0, per_cu = 0;
        (void)hipGetDevice(&dev); (void)hipDeviceGetAttribute(&cus, hipDeviceAttributeMultiprocessorCount, dev);
        if (hipFuncSetAttribute((const void*)fwd_mega, hipFuncAttributeMaxDynamicSharedMemorySize, LDS_TOTAL) != hipSuccess) { fprintf(stderr, "kernel_launch: hipFuncSetAttribute failed\n"); grid = -1; return; }
        if (hipOccupancyMaxActiveBlocksPerMultiprocessor(&per_cu, (const void*)fwd_mega, NTHREADS, LDS_TOTAL) != hipSuccess || per_cu < 1) { fprintf(stderr, "kernel_launch: occupancy query says %d blocks per CU\n", per_cu); per_cu = 1; }
        (void)hipGetLastError();
        grid = cus > 0 ? cus : 256;
    }
    if (grid < 0) return;
    Args a{};
    for (int i = 0; i < 15; ++i) a.in[i] = (const float*)d_in[i];
    a.out = (float*)d_out; a.ws = (unsigned char*)d_ws;
#if MK_N_LAUNCHES == 1
    a.ph_lo = 0; a.ph_hi = NPHASES;
    (void)hipMemsetAsync(d_ws, 0, 16384, stream);
    void* args[] = {&a};
    hipError_t e = hipLaunchCooperativeKernel((const void*)fwd_mega, dim3(grid), dim3(NTHREADS), args, LDS_TOTAL, stream);
    if (e != hipSuccess) fprintf(stderr, "kernel_launch: cooperative launch failed: %s (grid %d)\n", hipGetErrorString(e), grid);
#else
    for (int ph = 0; ph < NPHASES; ++ph) { a.ph_lo = ph; a.ph_hi = ph + 1; hipLaunchKernelGGL(fwd_mega, dim3(grid), dim3(NTHREADS), LDS_TOTAL, stream, a); }
#endif
}
```

```cpp
#include <hip/hip_runtime.h>
#include <hip/hip_bf16.h>
#include <hip/hip_cooperative_groups.h>
#include <cstdio>
#include <cstdint>
#include <cmath>
namespace cg = cooperative_groups;
#ifndef MK_N_LAUNCHES
#define MK_N_LAUNCHES 1
#endif
__device__ __forceinline__ int tidx() { int t = threadIdx.x; asm volatile("" : "+v"(t)); return t; }
namespace pg8 {
#define PG8_LAS __attribute__((address_space(3)))
typedef unsigned short bf16_t;
typedef short bf16x8 __attribute__((ext_vector_type(8)));
typedef float f32x4 __attribute__((ext_vector_type(4)));
typedef unsigned u32x4 __attribute__((ext_vector_type(4)));
constexpr int BM = 256, BK = 64, HALF = 128, HTB = HALF * BK * 2  , STAGE_BYTES = 8 * HTB, NXCD = 8, WGM = 8;

__host__ __device__ __forceinline__ int lds_byte(int r, int c) { const int st = (r >> 4) * 2 + (c >> 5), rr = r & 15, cc = c & 31, ob = rr * 64 + cc * 2; return st * 1024 + (ob ^ (((ob >> 9) & 1) << 5)); }
__host__ __device__ __forceinline__ void stage_rc(int b, int& R, int& C) { const int st = b / 1024, sb = b % 1024, swz = sb ^ (((sb >> 9) & 1) << 5); R = (st >> 1) * 16 + swz / 64; C = (st & 1) * 32 + (swz % 64) / 2; }
__host__ __device__ __forceinline__ int perm32(int rho) { const int n = rho >> 4, i = rho & 15; return 8 * (i >> 2) + 4 * n + (i & 3); }

struct Unit { int pm, pn; };
struct Gemm { const bf16_t* A; const bf16_t* Bt; int M, N, K; };

struct StaticOrder {
    int nM, nN, nwg, G, c;
    __host__ __device__ void init(int M, int N, int G_, int c_) { nM = M / BM; nN = N / BM; nwg = nM * nN; G = G_; c = c_; }
    __host__ __device__ bool next(int i, Unit& u) const {
        const long L = (long)i * G + c; if (L >= nwg) return false;
        int wgid = (int)L; { const int q = nwg / NXCD, r = nwg % NXCD, xcd = wgid % NXCD, off = wgid / NXCD; wgid = (xcd < r ? xcd * (q + 1) : r * (q + 1) + (xcd - r) * q) + off; }
        const int nig = WGM * nN, gid = wgid / nig, fm = gid * WGM, gsz = (nM - fm) < WGM ? (nM - fm) : WGM;
        u.pm = fm + ((wgid % nig) % gsz); u.pn = (wgid % nig) / gsz; return true;
    }
    __device__ __forceinline__ void a_ready(const Unit&) const {}
    __device__ __forceinline__ void done(const Unit&) const {}
};

__device__ __forceinline__ unsigned cvt_pk_bf16(float lo, float hi) { unsigned r; asm volatile("v_cvt_pk_bf16_f32 %0, %1, %2" : "=v"(r) : "v"(lo), "v"(hi)); return r; }
template <int ACT> struct EpiBf16 {
    static constexpr bool PERM = true, AFTER_DRAIN = false;
    bf16_t* O; int ldc; int split_cols; size_t split_stride; float scale0;
    const float* ss; const float* sw; int sw_stride; int rows_per_batch;
    bf16_t* cu_out; int cu_from;
    float* nrm;
    __device__ __forceinline__ void operator()(const f32x4 (&acc)[2][2][4][2], const Unit& u, int wr, int wc, int fr, int fq) const {
        const int row0 = u.pm * BM + wr * 64 + fr; int colt = u.pn * BM; bf16_t* base = O;
        const bool do_nrm = nrm != nullptr && u.pn < 16;
        float sc = 1.f; if (split_cols) { const int t = colt / split_cols; base += (size_t)t * split_stride; colt -= t * split_cols; if (t == 0) sc = scale0; }
        const int col0 = colt + wc * 32 + 8 * fq;
        f32x4 swv[2][2];
        if (ss) { const float* swp = sw + (size_t)((u.pm * BM) / rows_per_batch) * sw_stride + u.pn * BM + wc * 32 + 8 * fq;
#pragma unroll
            for (int bj = 0; bj < 2; ++bj)
#pragma unroll
                for (int n = 0; n < 2; ++n) swv[bj][n] = *(const f32x4*)(swp + bj * HALF + 4 * n); }
#pragma unroll
        for (int ai = 0; ai < 2; ++ai)
#pragma unroll
            for (int m = 0; m < 4; ++m) { const int row = row0 + ai * HALF + m * 16; bf16_t* rowp = base + (size_t)row * ldc + col0;
                float inv = 1.f;
                if (ss) { const f32x4* sp = (const f32x4*)(ss + (size_t)row * 32 + fq * 8); const f32x4 p0 = sp[0], p1 = sp[1];
                    float s = ((p0[0] + p0[1]) + (p0[2] + p0[3])) + ((p1[0] + p1[1]) + (p1[2] + p1[3]));
                    s += __shfl_xor(s, 16); s += __shfl_xor(s, 32); inv = 1.0f / sqrtf(s * (1.f / 2048.f) + 1e-6f); }
                f32x4 va[2][2];
#pragma unroll
                for (int bj = 0; bj < 2; ++bj) { f32x4 v0 = acc[ai][bj][m][0], v1 = acc[ai][bj][m][1];
                    if (ss) { v0 = v0 * inv + swv[bj][0]; v1 = v1 * inv + swv[bj][1]; }
                    if (ACT == 2) { v0 = __builtin_elementwise_max(v0, (f32x4){0.f, 0.f, 0.f, 0.f}); v1 = __builtin_elementwise_max(v1, (f32x4){0.f, 0.f, 0.f, 0.f}); v0 = v0 * v0; v1 = v1 * v1; }
                    v0 = v0 * sc; v1 = v1 * sc;
                    if (do_nrm) { float s2 = ((v0[0] * v0[0] + v0[1] * v0[1]) + (v0[2] * v0[2] + v0[3] * v0[3])) + ((v1[0] * v1[0] + v1[1] * v1[1]) + (v1[2] * v1[2] + v1[3] * v1[3]));
                        s2 += __shfl_xor(s2, 16); s2 += __shfl_xor(s2, 32);
                        if (fq == 0) nrm[((size_t)(((u.pn >> 3) * 4 + (row >> 12)) * 16 + (u.pn & 7) * 2 + bj) * 4096 + (row & 4095)) * 4 + wc] = s2; }
                    va[bj][0] = v0; va[bj][1] = v1; }
                if (cu_out != nullptr && u.pn >= cu_from) {
                    const f32x4 p0 = va[0][0] * va[1][0], p1 = va[0][1] * va[1][1];
                    u32x4 w; w.x = cvt_pk_bf16(p0[0], p0[1]); w.y = cvt_pk_bf16(p0[2], p0[3]); w.z = cvt_pk_bf16(p1[0], p1[1]); w.w = cvt_pk_bf16(p1[2], p1[3]);
                    *(u32x4*)(cu_out + (size_t)row * ldc + (u.pn - cu_from) * HALF + wc * 32 + 8 * fq) = w;
                } else {
#pragma unroll
                    for (int bj = 0; bj < 2; ++bj) { const f32x4 v0 = va[bj][0], v1 = va[bj][1];
                        u32x4 w; w.x = cvt_pk_bf16(v0[0], v0[1]); w.y = cvt_pk_bf16(v0[2], v0[3]); w.z = cvt_pk_bf16(v1[0], v1[1]); w.w = cvt_pk_bf16(v1[2], v1[3]);
                        *(u32x4*)(rowp + bj * HALF) = w; } } }
    }
};
struct EpiRes {
    static constexpr bool PERM = true, AFTER_DRAIN = false;
    const float* base32; const bf16_t* base16; float* out32; bf16_t* out16; int ldc; const float* gate; int rows_per_batch; int gate_stride;
    bf16_t* An; const float* n_gain; const float* n_scale; float* ss;
    __device__ __forceinline__ void operator()(const f32x4 (&acc)[2][2][4][2], const Unit& u, int wr, int wc, int fr, int fq) const {
        const int bidx = (u.pm * BM) / rows_per_batch; const float* g = gate + (size_t)bidx * gate_stride;
        const int col0 = u.pn * BM + wc * 32 + 8 * fq;
        f32x4 gv[2][2], cav[2][2];
#pragma unroll
        for (int bj = 0; bj < 2; ++bj)
#pragma unroll
            for (int n = 0; n < 2; ++n) { gv[bj][n] = *(const f32x4*)(g + col0 + bj * HALF + 4 * n);
                if (An) cav[bj][n] = *(const f32x4*)(n_gain + col0 + bj * HALF + 4 * n) * (*(const f32x4*)(n_scale + (size_t)bidx * gate_stride + col0 + bj * HALF + 4 * n) + 1.f); }
#pragma unroll
        for (int h = 0; h < 4; ++h) { const int ai = h >> 1, m0 = (h & 1) * 2;
            f32x4 pre[2][2][2];
            if (base32) {
#pragma unroll
                for (int mm = 0; mm < 2; ++mm) { const size_t off = (size_t)(u.pm * BM + ai * HALF + wr * 64 + (m0 + mm) * 16 + fr) * ldc + col0;
#pragma unroll
                    for (int bj = 0; bj < 2; ++bj)
#pragma unroll
                        for (int n = 0; n < 2; ++n) pre[mm][bj][n] = __builtin_nontemporal_load((const f32x4*)(base32 + off + bj * HALF + 4 * n)); }
            } else { u32x4 raw[2][2];
#pragma unroll
                for (int mm = 0; mm < 2; ++mm) { const size_t off = (size_t)(u.pm * BM + ai * HALF + wr * 64 + (m0 + mm) * 16 + fr) * ldc + col0;
#pragma unroll
                    for (int bj = 0; bj < 2; ++bj) raw[mm][bj] = __builtin_nontemporal_load((const u32x4*)(base16 + off + bj * HALF)); }
#pragma unroll
                for (int mm = 0; mm < 2; ++mm)
#pragma unroll
                    for (int bj = 0; bj < 2; ++bj) { const u32x4 w = raw[mm][bj];
                        pre[mm][bj][0] = (f32x4){__uint_as_float(w.x << 16), __uint_as_float(w.x & 0xffff0000u), __uint_as_float(w.y << 16), __uint_as_float(w.y & 0xffff0000u)};
                        pre[mm][bj][1] = (f32x4){__uint_as_float(w.z << 16), __uint_as_float(w.z & 0xffff0000u), __uint_as_float(w.w << 16), __uint_as_float(w.w & 0xffff0000u)}; } }
#pragma unroll
            for (int mm = 0; mm < 2; ++mm) { const int m = m0 + mm; const int row = u.pm * BM + ai * HALF + wr * 64 + m * 16 + fr; const size_t off = (size_t)row * ldc + col0;
                float ssum = 0.f;
#pragma unroll
                for (int bj = 0; bj < 2; ++bj) { f32x4 o[2];
#pragma unroll
                    for (int n = 0; n < 2; ++n) { o[n] = pre[mm][bj][n] + gv[bj][n] * acc[ai][bj][m][n];
                        ssum += (o[n][0] * o[n][0] + o[n][1] * o[n][1]) + (o[n][2] * o[n][2] + o[n][3] * o[n][3]); }
                    if (out32) { *(f32x4*)(out32 + off + bj * HALF) = o[0]; *(f32x4*)(out32 + off + bj * HALF + 4) = o[1]; }
                    else { u32x4 w; w.x = cvt_pk_bf16(o[0][0], o[0][1]); w.y = cvt_pk_bf16(o[0][2], o[0][3]); w.z = cvt_pk_bf16(o[1][0], o[1][1]); w.w = cvt_pk_bf16(o[1][2], o[1][3]); *(u32x4*)(out16 + off + bj * HALF) = w; }
                    if (An) { const f32x4 a0 = o[0] * cav[bj][0], a1 = o[1] * cav[bj][1]; u32x4 w; w.x = cvt_pk_bf16(a0[0], a0[1]); w.y = cvt_pk_bf16(a0[2], a0[3]); w.z = cvt_pk_bf16(a1[0], a1[1]); w.w = cvt_pk_bf16(a1[2], a1[3]);
                        *(u32x4*)(An + off + bj * HALF) = w; } }
                if (An) { ssum += __shfl_xor(ssum, 16); ssum += __shfl_xor(ssum, 32); if (fq == 0) ss[(size_t)row * 32 + u.pn * 4 + wc] = ssum; } }
            asm volatile("" ::: "memory");
        }
    }
};
struct EpiNull {
    static constexpr bool PERM = true, AFTER_DRAIN = false; bf16_t* O;
    __device__ __forceinline__ void operator()(const f32x4 (&acc)[2][2][4][2], const Unit& u, int wr, int wc, int fr, int fq) const {
        float s = 0.f;
#pragma unroll
        for (int ai = 0; ai < 2; ++ai)
#pragma unroll
            for (int bj = 0; bj < 2; ++bj)
#pragma unroll
                for (int m = 0; m < 4; ++m)
#pragma unroll
                    for (int n = 0; n < 2; ++n) s += acc[ai][bj][m][n][0] + acc[ai][bj][m][n][1] + acc[ai][bj][m][n][2] + acc[ai][bj][m][n][3];
        if (s == 1.2345e-30f) O[0] = 1;
    }
};
struct EpiCoal {
    static constexpr bool PERM = true, AFTER_DRAIN = false; bf16_t* O;
    __device__ __forceinline__ void operator()(const f32x4 (&acc)[2][2][4][2], const Unit& u, int wr, int wc, int fr, int fq) const {
        bf16_t* base = O + ((size_t)((u.pm * 32 + u.pn) & 511) * 65536) + (size_t)(wr * 4 + wc) * 8192 + (size_t)(fq * 16 + fr) * 8;
#pragma unroll
        for (int ai = 0; ai < 2; ++ai)
#pragma unroll
            for (int m = 0; m < 4; ++m)
#pragma unroll
                for (int bj = 0; bj < 2; ++bj) { f32x4 v0 = acc[ai][bj][m][0], v1 = acc[ai][bj][m][1];
                    v0 = __builtin_elementwise_max(v0, (f32x4){0.f, 0.f, 0.f, 0.f}); v1 = __builtin_elementwise_max(v1, (f32x4){0.f, 0.f, 0.f, 0.f}); v0 = v0 * v0; v1 = v1 * v1;
                    u32x4 w; w.x = cvt_pk_bf16(v0[0], v0[1]); w.y = cvt_pk_bf16(v0[2], v0[3]); w.z = cvt_pk_bf16(v1[0], v1[1]); w.w = cvt_pk_bf16(v1[2], v1[3]);
                    *(u32x4*)(base + (size_t)((ai * 4 + m) * 2 + bj) * 512) = w; }
    }
};
template <class Epi, class Sched, bool ALIGN_EPI = false, bool SP2 = false>
__device__ __forceinline__ void gemm_phase(PG8_LAS unsigned char* lds, const Gemm g, const Sched& S, const Epi& E) {
    const int tid = tidx(), wid = __builtin_amdgcn_readfirstlane(tid >> 6), lane = tid & 63, wr = wid >> 2, wc = wid & 3, fr = lane & 15, fq = lane >> 4;
    const int K = g.K, nt = K / BK;
    unsigned voffA[2], voffB[2];
#pragma unroll
    for (int i = 0; i < 2; ++i) { int R, C; stage_rc(tid * 16 + i * 8192, R, C); const int Rb = Epi::PERM ? ((R & ~31) + perm32(R & 31)) : R;
        voffA[i] = (unsigned)(R * K + C) * 2u; voffB[i] = (unsigned)(Rb * K + C) * 2u; }
    const size_t kstep = (size_t)(BK * 2);
    const size_t hstep = (size_t)HALF * K * 2;
    const size_t tstep = 2 * hstep;
    const unsigned ldsw = (unsigned)wid * 1024u;
    const int aoff = lds_byte(wr * 64 + fr, fq * 8), boff = lds_byte(wc * 32 + fr, fq * 8);
#define PG8_SA(b, h) (((b) * 2 + (h)) * HTB)
#define PG8_SB(b, h) ((4 + (b) * 2 + (h)) * HTB)
#define PG8_STAGE(bufoff, gbase, voff) do { _Pragma("unroll") for (int _i = 0; _i < 2; ++_i) \
        __builtin_amdgcn_global_load_lds((const unsigned*)((const char*)(gbase) + (voff)[_i]), (PG8_LAS unsigned*)(lds + (bufoff) + ldsw + _i * 8192), 16, 0, 0); } while (0)
#define PG8_LDA(dst, b, h) do { _Pragma("unroll") for (int m = 0; m < 4; ++m) _Pragma("unroll") for (int k = 0; k < 2; ++k) dst[m][k] = *(const PG8_LAS bf16x8*)(lds + PG8_SA(b, h) + aoff + m * 2048 + k * 1024); } while (0)
#define PG8_LDB(dst, b, h) do { _Pragma("unroll") for (int n = 0; n < 2; ++n) _Pragma("unroll") for (int k = 0; k < 2; ++k) dst[n][k] = *(const PG8_LAS bf16x8*)(lds + PG8_SB(b, h) + boff + n * 2048 + k * 1024); } while (0)
#define PG8_MMA(ai, bj, At, Bt) do { __builtin_amdgcn_s_setprio(1); _Pragma("unroll") for (int m = 0; m < 4; ++m) _Pragma("unroll") for (int n = 0; n < 2; ++n) _Pragma("unroll") for (int k = 0; k < 2; ++k) \
        acc[ai][bj][m][n] = __builtin_amdgcn_mfma_f32_16x16x32_bf16(Bt[n][k], At[m][k], acc[ai][bj][m][n], 0, 0, 0); __builtin_amdgcn_s_setprio(0); } while (0)
#define PG8_WAIT_V(n) asm volatile("s_waitcnt vmcnt(" #n ")" ::: "memory")
#define PG8_WAIT_L(n) asm volatile("s_waitcnt lgkmcnt(" #n ")" ::: "memory")
#define PG8_BAR __builtin_amdgcn_s_barrier()
#define PG8_SCHED __builtin_amdgcn_sched_barrier(0)
    Unit cur, nxt; int ui = 0;
    if (!S.next(0, cur)) return;
    f32x4 acc[2][2][4][2];
#pragma unroll
    for (int a = 0; a < 2; ++a)
#pragma unroll
        for (int b = 0; b < 2; ++b)
#pragma unroll
            for (int m = 0; m < 4; ++m)
#pragma unroll
                for (int n = 0; n < 2; ++n) acc[a][b][m][n] = (f32x4){0.f, 0.f, 0.f, 0.f};
    bf16x8 At[4][2], B0[2][2], B1[2][2];
    const char* cA = (const char*)g.A + (size_t)cur.pm * tstep; const char* cB = (const char*)g.Bt + (size_t)cur.pn * tstep;
    S.a_ready(cur);
    if constexpr (SP2) {
        PG8_STAGE(PG8_SB(0, 0), cB, voffB); PG8_STAGE(PG8_SB(0, 1), cB + hstep, voffB); PG8_STAGE(PG8_SA(0, 0), cA, voffA); PG8_STAGE(PG8_SA(0, 1), cA + hstep, voffA);
        if (wr == 1) PG8_BAR;
        PG8_WAIT_V(2); PG8_BAR;
        PG8_STAGE(PG8_SB(1, 0), cB + kstep, voffB); PG8_STAGE(PG8_SA(1, 0), cA + kstep, voffA); PG8_STAGE(PG8_SB(1, 1), cB + hstep + kstep, voffB);
        PG8_WAIT_V(6); PG8_BAR;
    } else {
        PG8_STAGE(PG8_SB(0, 0), cB, voffB); PG8_STAGE(PG8_SA(0, 0), cA, voffA); PG8_STAGE(PG8_SB(0, 1), cB + hstep, voffB); PG8_STAGE(PG8_SA(0, 1), cA + hstep, voffA);
        if (wr == 1) PG8_BAR;
        PG8_WAIT_V(4); PG8_BAR;
        PG8_STAGE(PG8_SB(1, 0), cB + kstep, voffB); PG8_STAGE(PG8_SA(1, 0), cA + kstep, voffA); PG8_STAGE(PG8_SB(1, 1), cB + hstep + kstep, voffB);
        PG8_WAIT_V(6); PG8_BAR;
    }
    for (;;) {
        const bool has_next = S.next(ui + 1, nxt);
        const char* nA = has_next ? (const char*)g.A + (size_t)nxt.pm * tstep : cA; const char* nB = has_next ? (const char*)g.Bt + (size_t)nxt.pn * tstep : cB;
        for (int t = 0; t < nt; t += 2) {
            const bool last = (t == nt - 2);
            const char* a1 = cA + (size_t)(t + 1) * kstep;
            const char* a2 = last ? nA : cA + (size_t)(t + 2) * kstep; const char* b2 = last ? nB : cB + (size_t)(t + 2) * kstep;
            const char* a3 = a2 + kstep; const char* b3 = b2 + kstep;
            if (last && has_next) S.a_ready(nxt);
            if constexpr (SP2) {
            PG8_LDB(B0, 0, 0); PG8_LDB(B1, 0, 1); PG8_SCHED; PG8_LDA(At, 0, 0); PG8_STAGE(PG8_SA(1, 1), a1 + hstep, voffA);
            PG8_WAIT_V(8); PG8_WAIT_L(0); PG8_BAR; PG8_MMA(0, 0, At, B0); PG8_MMA(0, 1, At, B1); PG8_BAR; PG8_SCHED;
            PG8_LDA(At, 0, 1); PG8_STAGE(PG8_SB(0, 0), b2, voffB); PG8_STAGE(PG8_SB(0, 1), b2 + hstep, voffB); PG8_STAGE(PG8_SA(0, 0), a2, voffA);
            PG8_WAIT_V(8); PG8_WAIT_L(0); PG8_BAR; PG8_MMA(1, 0, At, B0); PG8_MMA(1, 1, At, B1); PG8_BAR; PG8_SCHED;
            PG8_LDB(B0, 1, 0); PG8_LDB(B1, 1, 1); PG8_SCHED; PG8_LDA(At, 1, 0); PG8_STAGE(PG8_SA(0, 1), a2 + hstep, voffA);
            PG8_WAIT_V(8); PG8_WAIT_L(0); PG8_BAR; PG8_MMA(0, 0, At, B0); PG8_MMA(0, 1, At, B1); PG8_BAR; PG8_SCHED;
            PG8_LDA(At, 1, 1); PG8_STAGE(PG8_SB(1, 0), b3, voffB); PG8_STAGE(PG8_SB(1, 1), b3 + hstep, voffB); PG8_STAGE(PG8_SA(1, 0), a3, voffA);
            PG8_WAIT_V(8); PG8_WAIT_L(0); PG8_BAR; PG8_MMA(1, 0, At, B0); PG8_MMA(1, 1, At, B1); PG8_BAR; PG8_SCHED;
            } else {
            PG8_LDB(B0, 0, 0); PG8_SCHED; PG8_LDA(At, 0, 0); PG8_STAGE(PG8_SA(1, 1), a1 + hstep, voffA);
            PG8_WAIT_L(8); PG8_BAR; PG8_WAIT_L(0); PG8_MMA(0, 0, At, B0); PG8_BAR; PG8_SCHED;
            PG8_LDB(B1, 0, 1); PG8_STAGE(PG8_SB(0, 0), b2, voffB);
            PG8_BAR; PG8_WAIT_L(0); PG8_MMA(0, 1, At, B1); PG8_BAR;
            PG8_LDA(At, 0, 1); PG8_STAGE(PG8_SA(0, 0), a2, voffA);
            PG8_BAR; PG8_WAIT_L(0); PG8_MMA(1, 0, At, B0); PG8_BAR; PG8_SCHED;
            PG8_STAGE(PG8_SB(0, 1), b2 + hstep, voffB);
            PG8_WAIT_V(6); PG8_BAR; PG8_MMA(1, 1, At, B1); PG8_BAR;
            PG8_LDB(B0, 1, 0); PG8_SCHED; PG8_LDA(At, 1, 0); PG8_STAGE(PG8_SA(0, 1), a2 + hstep, voffA);
            PG8_WAIT_L(8); PG8_BAR; PG8_WAIT_L(0); PG8_MMA(0, 0, At, B0); PG8_BAR; PG8_SCHED;
            PG8_LDB(B1, 1, 1); PG8_STAGE(PG8_SB(1, 0), b3, voffB);
            PG8_BAR; PG8_WAIT_L(0); PG8_MMA(0, 1, At, B1); PG8_BAR;
            PG8_LDA(At, 1, 1); PG8_STAGE(PG8_SA(1, 0), a3, voffA);
            PG8_BAR; PG8_WAIT_L(0); PG8_MMA(1, 0, At, B0); PG8_BAR; PG8_SCHED;
            PG8_STAGE(PG8_SB(1, 1), b3 + hstep, voffB);
            PG8_WAIT_V(6); PG8_BAR; PG8_MMA(1, 1, At, B1); PG8_BAR;
            }
        }
        if constexpr (ALIGN_EPI) { if (wr == 0) PG8_BAR; }
        if constexpr (!Epi::AFTER_DRAIN) { E(acc, cur, wr, wc, fr, fq); S.done(cur); }
        if (!has_next) break;
#pragma unroll
        for (int a = 0; a < 2; ++a)
#pragma unroll
            for (int b = 0; b < 2; ++b)
#pragma unroll
                for (int m = 0; m < 4; ++m)
#pragma unroll
                    for (int n = 0; n < 2; ++n) acc[a][b][m][n] = (f32x4){0.f, 0.f, 0.f, 0.f};
        cur = nxt; cA = nA; cB = nB; ++ui;
        if constexpr (ALIGN_EPI) { if (wr == 1) PG8_BAR; }
    }
    PG8_WAIT_V(0);
    if constexpr (!ALIGN_EPI) { if (wr == 0) PG8_BAR; }
    PG8_BAR;
    if constexpr (Epi::AFTER_DRAIN) { E.fused(acc, cur, wr, wc, fr, fq, lds, wid, lane); S.done(cur); }
#undef PG8_SA
#undef PG8_SB
#undef PG8_STAGE
#undef PG8_LDA
#undef PG8_LDB
#undef PG8_MMA
#undef PG8_WAIT_V
#undef PG8_WAIT_L
#undef PG8_BAR
#undef PG8_SCHED
}
}
namespace att {
enum { ORDER_NATURAL = 0, ORDER_REVERSED = 1, ORDER_PAIRED = 2, ORDER_XCD = 4 };
constexpr int D = 128, PITCH = 2048;
constexpr float THR = 8.f;
constexpr bool WSKIP = false;
constexpr int NW = 8, QBLK = 32, KVBLK = 64, QB = NW * QBLK;
constexpr int SHM_V = KVBLK * D * 2, SHM_K = KVBLK * D * 2;
constexpr int LDS_BYTES = 2 * SHM_V + 2 * SHM_K + NW * 64 * 4;


using bf16 = __hip_bfloat16;
typedef short bf16x8 __attribute__((ext_vector_type(8)));
typedef short s16x4 __attribute__((ext_vector_type(4)));
typedef float f32x16 __attribute__((ext_vector_type(16)));
typedef float f32x4 __attribute__((ext_vector_type(4)));
typedef unsigned u32x4 __attribute__((ext_vector_type(4)));
template <class A, class Bt> struct same_t { static constexpr bool v = false; };
template <class A> struct same_t<A, A> { static constexpr bool v = true; };

#define KSWZ(row, colB) ((row) * 256 + ((colB) ^ (((row) & 7) << 4)))
#define SBAR() __builtin_amdgcn_sched_barrier(0)
__device__ __forceinline__ int v_st(int k, int c) { const int kk = (k & ~0xC) | ((k & 4) << 1) | ((k & 8) >> 1); return ((kk >> 3) * 4 + (c >> 5)) * 512 + ((kk & 7) * 32 + (c & 31)) * 2; }
__device__ __forceinline__ int v_rd_base(int lane) { return ((lane & 3) << 3) | (((lane >> 2) & 3) << 6) | (((lane >> 4) & 1) << 5) | (((lane >> 5) & 1) << 8); }
constexpr int v_rd_off(int d0, int ks, int half) { return d0 * 512 + ks * 4096 + half * 2048; }
__device__ __forceinline__ int crow(int r, int hi) { return (r & 3) + 8 * (r >> 2) + 4 * hi; }
__device__ __forceinline__ unsigned cvtpk(float lo, float hi) {
    unsigned r; asm volatile("v_cvt_pk_bf16_f32 %0, %1, %2" : "=v"(r) : "v"(lo), "v"(hi)); return r;
}
__device__ __forceinline__ bf16x8 pack8(f32x4 a, f32x4 b) {
    u32x4 w = {cvtpk(a[0], a[1]), cvtpk(a[2], a[3]), cvtpk(b[0], b[1]), cvtpk(b[2], b[3])};
    return *reinterpret_cast<bf16x8*>(&w);
}
template <class T> __device__ __forceinline__ bf16x8 load8(const T* p) {
    if constexpr (same_t<T, float>::v) { return pack8(*(const f32x4*)p, *(const f32x4*)(p + 4)); }
    else { return *reinterpret_cast<const bf16x8*>(p); }
}
__device__ __forceinline__ void mask_tile(f32x16& p0, f32x16& p1, int dq, unsigned W) {
    const float NEG = -__builtin_inff();
#pragma unroll
    for (int r = 0; r < 16; ++r) {
        const int c = (r & 3) + 8 * (r >> 2);
        if ((unsigned)(dq - c) >= W) p0[r] = NEG;
        if ((unsigned)(dq - c - 32) >= W) p1[r] = NEG;
    }
}
__device__ __forceinline__ void partialSM(f32x16& p0, f32x16& p1, float& m_reg, float& mn, float& alpha) {
    float pmax = p0[0]; for (int r = 1; r < 16; ++r) pmax = fmaxf(pmax, p0[r]); for (int r = 0; r < 16; ++r) pmax = fmaxf(pmax, p1[r]);
    { auto rr = __builtin_amdgcn_permlane32_swap(__float_as_uint(pmax), __float_as_uint(pmax), false, false);
      pmax = fmaxf(__uint_as_float(rr[0]), __uint_as_float(rr[1])); }
    if (__builtin_expect(__all((pmax - m_reg) <= THR), 1)) { mn = m_reg; alpha = 1.f; }
    else { mn = fmaxf(m_reg, pmax); alpha = __builtin_amdgcn_exp2f(m_reg - mn); m_reg = mn; }
    for (int r = 0; r < 16; ++r) p0[r] = p0[r] - mn; for (int r = 0; r < 16; ++r) p1[r] = p1[r] - mn;
    for (int r = 0; r < 16; ++r) p0[r] = __builtin_amdgcn_exp2f(p0[r]);
}
__device__ __forceinline__ void finishSM(f32x16& p0, f32x16& p1, float alpha, float& l_reg, bf16x8& pa0, bf16x8& pa1, bf16x8& pa2, bf16x8& pa3) {
    for (int r = 0; r < 16; ++r) p1[r] = __builtin_amdgcn_exp2f(p1[r]);
    float ps = 0; for (int r = 0; r < 16; ++r) ps += p0[r]; for (int r = 0; r < 16; ++r) ps += p1[r];
    { auto rr = __builtin_amdgcn_permlane32_swap(__float_as_uint(ps), __float_as_uint(ps), false, false);
      ps = __uint_as_float(rr[0]) + __uint_as_float(rr[1]); }
    l_reg = l_reg * alpha + ps;
#define PK4(P, B_, OUT) do { unsigned a0 = cvtpk(P[B_+0], P[B_+1]), a1 = cvtpk(P[B_+2], P[B_+3]);                          \
        unsigned b0 = cvtpk(P[B_+4], P[B_+5]), b1 = cvtpk(P[B_+6], P[B_+7]);                                             \
        auto r0 = __builtin_amdgcn_permlane32_swap(a0, b0, false, false); auto r1 = __builtin_amdgcn_permlane32_swap(a1, b1, false, false); \
        u32x4 w = {r0[0], r1[0], r0[1], r1[1]}; OUT = *reinterpret_cast<bf16x8*>(&w); } while (0)
    PK4(p0, 0, pa0); PK4(p0, 8, pa1); PK4(p1, 0, pa2); PK4(p1, 8, pa3);
#undef PK4
}
template <int KB, bool SK>
__device__ __forceinline__ void qkt(f32x16& p0, f32x16& p1, const char* K_lds, int r32, int hi, const bf16x8* qr, bool act, const char* Ft) {
    if (SK && !act) { const float NEG = -__builtin_inff();
#pragma unroll
        for (int r = 0; r < 16; ++r) { p0[r] = NEG; p1[r] = NEG; } return; }
    { const f32x4* fp = (const f32x4*)Ft;
      const f32x4 a0 = fp[0], a1 = fp[2], a2 = fp[4], a3 = fp[6], b0_ = fp[8], b1_ = fp[10], b2_ = fp[12], b3_ = fp[14];
      p0 = (f32x16){a0[0], a0[1], a0[2], a0[3], a1[0], a1[1], a1[2], a1[3], a2[0], a2[1], a2[2], a2[3], a3[0], a3[1], a3[2], a3[3]};
      p1 = (f32x16){b0_[0], b0_[1], b0_[2], b0_[3], b1_[0], b1_[1], b1_[2], b1_[3], b2_[0], b2_[1], b2_[2], b2_[3], b3_[0], b3_[1], b3_[2], b3_[3]}; }
    const char* kb[4];
#pragma unroll
    for (int dd = 0; dd < 4; ++dd) kb[dd] = K_lds + KB * SHM_K + KSWZ(r32, (dd * 16 + hi * 8) * 2);
#pragma unroll
    for (int d0 = 0; d0 < 8; ++d0) { const char* a = kb[d0 & 3] + (d0 >> 2) * 128;
        bf16x8 b0 = *reinterpret_cast<const bf16x8*>(a);
        bf16x8 b1 = *reinterpret_cast<const bf16x8*>(a + 32 * 256);
        p0 = __builtin_amdgcn_mfma_f32_32x32x16_bf16(b0, qr[d0], p0, 0, 0, 0);
        p1 = __builtin_amdgcn_mfma_f32_32x32x16_bf16(b1, qr[d0], p1, 0, 0, 0); }
}
template <int VB, bool SK>
__device__ __forceinline__ void pv_tile(f32x16* o, int vb0, bf16x8 pa0, bf16x8 pa1, bf16x8 pa2, bf16x8 pa3, bool act) {
    if (SK && !act) return;
#define TRRD(dst, off) asm volatile("ds_read_b64_tr_b16 %0, %1 offset:%2" : "=&v"(dst) : "v"(vb0), "i"(off) : "memory")
#define PV_D0(d0) do { s16x4 l0, l1, l2, l3, h0, h1, h2, h3; constexpr int b_ = VB * SHM_V + v_rd_off(d0, 0, 0);     \
        TRRD(l0, b_); TRRD(h0, b_ + 2048); TRRD(l1, b_ + 4096); TRRD(h1, b_ + 6144); TRRD(l2, b_ + 8192); TRRD(h2, b_ + 10240); TRRD(l3, b_ + 12288); TRRD(h3, b_ + 14336); \
        asm volatile("s_waitcnt lgkmcnt(0)" ::: "memory"); SBAR();                 \
        o[d0] = __builtin_amdgcn_mfma_f32_32x32x16_bf16(pa0, (bf16x8){l0[0], l0[1], l0[2], l0[3], h0[0], h0[1], h0[2], h0[3]}, o[d0], 0, 0, 0);   \
        o[d0] = __builtin_amdgcn_mfma_f32_32x32x16_bf16(pa1, (bf16x8){l1[0], l1[1], l1[2], l1[3], h1[0], h1[1], h1[2], h1[3]}, o[d0], 0, 0, 0);   \
        o[d0] = __builtin_amdgcn_mfma_f32_32x32x16_bf16(pa2, (bf16x8){l2[0], l2[1], l2[2], l2[3], h2[0], h2[1], h2[2], h2[3]}, o[d0], 0, 0, 0);   \
        o[d0] = __builtin_amdgcn_mfma_f32_32x32x16_bf16(pa3, (bf16x8){l3[0], l3[1], l3[2], l3[3], h3[0], h3[1], h3[2], h3[3]}, o[d0], 0, 0, 0); } while (0)
    PV_D0(0); PV_D0(1); PV_D0(2); PV_D0(3);
#undef PV_D0
#undef TRRD
}

template <class TIn, class TOut> struct BlockRef { const TIn* Q; const TIn* K; const TIn* V; TOut* O; const float* F; int P0; int jlo; };
template <class TIn> struct Seam {
    bf16x8 qr[8];
    bf16x8 st_v0, st_v1, st_k0, st_k1; f32x4 sf0, sf1, sf2, sf3;
    f32x4 tq[16];
};
__device__ __forceinline__ int swa_jlo(int P0, int W) { const int lowk = P0 - W + 1; return lowk > 0 ? lowk / KVBLK : 0; }
#define ROW(p, k0, rr) ((p) + (size_t)((k0) + (rr)) * PITCH + sc)
#define VMW() asm volatile("s_waitcnt vmcnt(0)" ::: "memory")
#define VMWN(n) asm volatile("s_waitcnt vmcnt(%0)" :: "i"(n) : "memory")
#define GROW(p, k0, vo) ((const char*)((p) + (size_t)(k0) * PITCH) + (vo))
#define SLOAD_H(Kp, Vp, k0) do { S.st_v0 = *(const bf16x8*)GROW(Vp, k0, vo0); S.st_v1 = *(const bf16x8*)GROW(Vp, k0, vo1);              \
                         S.st_k0 = *(const bf16x8*)GROW(Kp, k0, vo0); S.st_k1 = *(const bf16x8*)GROW(Kp, k0, vo1); } while (0)
#define SWRITE_HK(bf) do { *(bf16x8*)(K_lds + (bf) * SHM_K + kws) = S.st_k0; *(bf16x8*)(K_lds + (bf) * SHM_K + kws + 32 * 256) = S.st_k1; } while (0)
#define SWRITE_HV(bf) do { *(bf16x8*)(V_lds + (bf) * SHM_V + vst0) = S.st_v0; *(bf16x8*)(V_lds + (bf) * SHM_V + vst1) = S.st_v1; } while (0)
#define SWRITE_H(bf) do { SWRITE_HV(bf); SWRITE_HK(bf); } while (0)
#define SLOAD_F(p, k0) do { S.sf0 = *(const f32x4*)ROW(p, k0, sr); S.sf1 = *(const f32x4*)(ROW(p, k0, sr) + 4);                \
                            S.sf2 = *(const f32x4*)ROW(p, k0, 32 + sr); S.sf3 = *(const f32x4*)(ROW(p, k0, 32 + sr) + 4); } while (0)
#define SWRITE_KF(bf) do { *(bf16x8*)(K_lds + (bf) * SHM_K + kws) = pack8(S.sf0, S.sf1); *(bf16x8*)(K_lds + (bf) * SHM_K + kws + 32 * 256) = pack8(S.sf2, S.sf3); } while (0)
#define SWRITE_VF(bf) do { *(bf16x8*)(V_lds + (bf) * SHM_V + vst0) = pack8(S.sf0, S.sf1); *(bf16x8*)(V_lds + (bf) * SHM_V + vst1) = pack8(S.sf2, S.sf3); } while (0)
template <class TIn, class TOut>
__device__ __forceinline__ void causal_swa_prime(const BlockRef<TIn, TOut>& cur, int W, char* lds, Seam<TIn>& S, char* Fdst) {
    constexpr bool F32 = same_t<TIn, float>::v;
    const int tid = tidx(), wid = __builtin_amdgcn_readfirstlane(tid >> 6), lane = tid & 63, r32 = lane & 31, hi = lane >> 5;
    const int sr = tid >> 4, sc = (tid & 15) * 8, kws = KSWZ(sr, sc * 2); char* K_lds = lds + 2 * SHM_V;
    const unsigned vo0 = (unsigned)(sr * PITCH + sc) * 2u, vo1 = vo0 + 32u * PITCH * 2u, qvo = (unsigned)(r32 * PITCH + hi * 8) * 2u;
    const int kb0 = cur.jlo * KVBLK;
    for (int d0 = 0; d0 < 8; ++d0) S.qr[d0] = *(const bf16x8*)((const char*)(cur.Q + (size_t)(wid * QBLK) * PITCH) + qvo + d0 * 32);
    if constexpr (F32) { SLOAD_F((const float*)cur.K, kb0); VMW(); SWRITE_KF(0); SBAR(); SLOAD_F((const float*)cur.V, kb0); }
    else { const f32x4 fa = *(const f32x4*)(cur.F + tid * 4), fb = *(const f32x4*)(cur.F + 2048 + tid * 4);
           SLOAD_H(cur.K, cur.V, kb0); VMW(); SWRITE_HK(0);
           *(f32x4*)(Fdst + tid * 16) = fa; *(f32x4*)(Fdst + 8192 + tid * 16) = fb; }
    __syncthreads();
}
template <class TIn, class TOut>
__device__ __forceinline__ void causal_swa_block(const BlockRef<TIn, TOut>& cur, const BlockRef<TIn, TOut>& nxt, int skv, int W, char* lds, Seam<TIn>& S, const char* Fcur, char* Fnext) {
    constexpr bool F32 = same_t<TIn, float>::v;
    const int tid = tidx(), wid = __builtin_amdgcn_readfirstlane(tid >> 6), lane = tid & 63, r32 = lane & 31, hi = lane >> 5;
    const int j_lo = cur.jlo;
    int j_hi = (cur.P0 + QB - 1) / KVBLK + 1; if (j_hi > skv / KVBLK) j_hi = skv / KVBLK;
    const int NT = j_hi - j_lo;
    const int kbn = nxt.jlo * KVBLK;
    const int qlo = cur.P0 + wid * QBLK, qm = qlo + r32 - 4 * hi;
    char* V_lds = lds; char* K_lds = lds + 2 * SHM_V;
    float* ws = (float*)(lds + 2 * SHM_V + 2 * SHM_K) + wid * 64; float* li_l = ws, * al_l = ws + 32;
    float m_reg = *(const float*)(Fcur + (size_t)(cur.P0 + wid * QBLK + r32) * 4), l_reg = 0; f32x16 o[4] = {};
    const unsigned vo0 = (unsigned)((tid >> 4) * PITCH + (tid & 15) * 8) * 2u, vo1 = vo0 + 32u * PITCH * 2u, qvo = (unsigned)(r32 * PITCH + hi * 8) * 2u;
    const int sr = tid >> 4, sc = (tid & 15) * 8, vst0 = v_st(sr, sc), vst1 = v_st(32 + sr, sc), kws = KSWZ(sr, sc * 2);
    const int vb0 = (int)(uintptr_t)V_lds + v_rd_base(lane);
    const TIn* Kh = cur.K; const TIn* Vh = cur.V;
#define RESC(a) do { if (__any((a) < 1.f)) { if (hi == 0) al_l[r32] = (a); asm volatile("s_waitcnt lgkmcnt(0)" ::: "memory");              \
                     for (int d_ = 0; d_ < 4; ++d_) for (int r = 0; r < 16; ++r) o[d_][r] *= al_l[crow(r, hi)]; } } while (0)
#define KBASE(t) ((j_lo + (t)) * KVBLK)
#define ACT(t) (KBASE(t) <= qlo + QBLK - 1 && KBASE(t) + KVBLK - 1 >= qlo - W + 1)
#define MASKT(P0_, P1_, t) do { const int kb_ = KBASE(t); if ((!SK || ACT(t)) && (kb_ + KVBLK - 1 > qlo || kb_ <= qlo + QBLK - 1 - W)) mask_tile(P0_, P1_, qm - kb_, (unsigned)W); } while (0)
    constexpr int NQL = F32 ? 16 : 8;
    constexpr bool SK = WSKIP && !F32;
#define SEAM_K0() do { VMWN(NQL); if constexpr (F32) { SWRITE_KF(0); SBAR(); SLOAD_F((const float*)nxt.V, kbn); } else { SWRITE_HK(0); } SBAR(); } while (0)
    f32x16 pA0, pA1, pB0, pB1; float mnA, mnB, alA, alB; bf16x8 pa0, pa1, pa2, pa3;
    if constexpr (F32) { VMW(); SWRITE_VF(0); SBAR(); } else { SWRITE_HV(0); SBAR(); }
    if (NT > 1) { if constexpr (F32) SLOAD_F((const float*)Kh, KBASE(1)); else SLOAD_H(Kh, Vh, KBASE(1)); }
    SBAR(); qkt<0, SK>(pA0, pA1, K_lds, r32, hi, S.qr, ACT(0), Fcur + KBASE(0) * 4 + hi * 16);
    if constexpr (F32) { if (NT > 1) { VMW(); SWRITE_KF(1); SBAR(); SLOAD_F((const float*)Vh, KBASE(1)); } }
    MASKT(pA0, pA1, 0); partialSM(pA0, pA1, m_reg, mnA, alA);
    if (NT > 1) { VMW(); if constexpr (F32) { SWRITE_VF(1); SBAR(); if (NT > 2) SLOAD_F((const float*)Kh, KBASE(2)); } else SWRITE_H(1); }
    __syncthreads();
#define HALF_STEP(PX0, PX1, mnX, alX, PY0, PY1, alY, t, KB, VB, SB) do {                                                      \
        SBAR(); qkt<KB, SK>(PX0, PX1, K_lds, r32, hi, S.qr, ACT(t), Fcur + KBASE(t) * 4 + hi * 16);                                             \
        finishSM(PY0, PY1, alY, l_reg, pa0, pa1, pa2, pa3); SBAR();                                                           \
        if ((t) + 1 < NT) { if constexpr (F32) { VMW(); SWRITE_KF(SB); SBAR(); SLOAD_F((const float*)Vh, KBASE((t) + 1)); }  \
                            else { SLOAD_H(Kh, Vh, KBASE((t) + 1)); } SBAR(); }                                               \
        pv_tile<VB, SK>(o, vb0, pa0, pa1, pa2, pa3, ACT((t) - 1)); MASKT(PX0, PX1, (t)); partialSM(PX0, PX1, m_reg, mnX, alX);                                        \
        __syncthreads();                                                                                                      \
        if ((t) + 1 < NT) { VMW(); if constexpr (F32) { SWRITE_VF(SB); SBAR(); if ((t) + 2 < NT) SLOAD_F((const float*)Kh, KBASE((t) + 2)); } \
                            else { SWRITE_H(SB); } }                                                                          \
        RESC(alX); __syncthreads(); } while (0)
    for (int t = 1; t + 1 < NT; t += 2) {
        HALF_STEP(pB0, pB1, mnB, alB, pA0, pA1, alA, t, 1, 0, 0);
        HALF_STEP(pA0, pA1, mnA, alA, pB0, pB1, alB, t + 1, 0, 1, 1);
    }
    const bool even = (NT & 1) == 0;
    if (even) { SBAR(); qkt<1, SK>(pB0, pB1, K_lds, r32, hi, S.qr, ACT(NT - 1), Fcur + KBASE(NT - 1) * 4 + hi * 16); SBAR(); }
#define QROW(e) (nxt.Q + (size_t)(wid * QBLK + r32) * PITCH + ((e) >> 1) * 16 + hi * 8 + ((e) & 1) * 4)
    if constexpr (F32) { SLOAD_F((const float*)nxt.K, kbn); SBAR();
#pragma unroll
        for (int e = 0; e < 8; ++e) S.tq[e] = *(const f32x4*)QROW(e); }
    if constexpr (!F32) { SLOAD_H(nxt.K, nxt.V, kbn); SBAR();
#pragma unroll
        for (int d0 = 0; d0 < 8; ++d0) S.qr[d0] = *(const bf16x8*)((const char*)(nxt.Q + (size_t)(wid * QBLK) * PITCH) + qvo + d0 * 32); }
    SBAR();
    finishSM(pA0, pA1, alA, l_reg, pa0, pa1, pa2, pa3); SBAR();
    if constexpr (F32) {
#pragma unroll
        for (int e = 8; e < 16; ++e) S.tq[e] = *(const f32x4*)QROW(e); SBAR(); }
#undef QROW
    pv_tile<0, SK>(o, vb0, pa0, pa1, pa2, pa3, ACT(even ? NT - 2 : NT - 1));
    if (even) { MASKT(pB0, pB1, NT - 1); partialSM(pB0, pB1, m_reg, mnB, alB); __syncthreads(); RESC(alB);
        finishSM(pB0, pB1, alB, l_reg, pa0, pa1, pa2, pa3); SBAR(); pv_tile<1, SK>(o, vb0, pa0, pa1, pa2, pa3, ACT(NT - 1)); }
    SBAR(); SEAM_K0();
    { const f32x4 nfa = *(const f32x4*)(nxt.F + tid * 4), nfb = *(const f32x4*)(nxt.F + 2048 + tid * 4); VMW();
      *(f32x4*)(Fnext + tid * 16) = nfa; *(f32x4*)(Fnext + 8192 + tid * 16) = nfb; SBAR(); }
    if (hi == 0) li_l[r32] = l_reg; asm volatile("s_waitcnt lgkmcnt(0)" ::: "memory");
    float rli[16];
#pragma unroll
    for (int r = 0; r < 16; ++r) rli[r] = __builtin_amdgcn_rcpf(li_l[crow(r, hi)]);
    TOut* Ow = cur.O + (size_t)(wid * QBLK) * PITCH; const unsigned ovo = (unsigned)(4 * hi * PITCH + r32) * 2u;
#pragma unroll
    for (int r = 0; r < 16; ++r) { const int orow = crow(r, hi);
#pragma unroll
        for (int d0 = 0; d0 < 4; ++d0) { const float v = o[d0][r] * rli[r];
            if constexpr (same_t<TOut, float>::v) { Ow[(size_t)orow * PITCH + d0 * 32 + r32] = v; }
            else { const float vn = __shfl_xor(v, 1);
                   if ((r32 & 1) == 0) *(unsigned*)((char*)(Ow + (size_t)((r & 3) + 8 * (r >> 2)) * PITCH + d0 * 32) + ovo) = cvtpk(v, vn); } } }
    if constexpr (F32) {
#pragma unroll
        for (int d0 = 0; d0 < 8; ++d0) S.qr[d0] = pack8(S.tq[2 * d0], S.tq[2 * d0 + 1]); }
    __syncthreads();
#undef RESC
#undef KBASE
#undef ACT
#undef MASKT
#undef SEAM_K0
#undef HALF_STEP
}
#undef ROW
#undef VMW
#undef VMWN
#undef SLOAD_H
#undef GROW
#undef SWRITE_HK
#undef SWRITE_HV
#undef SWRITE_H
#undef SLOAD_F
#undef SWRITE_KF
#undef SWRITE_VF

constexpr int ATT_F_OFF = LDS_BYTES;
constexpr int ATT_LDS_TOTAL = LDS_BYTES + 2 * 16384;
}
constexpr int BATCH = 4, SEQ = 4096, DM = 2048, NH = 16, HD = 128, FF = 8192, M = BATCH * SEQ;
constexpr int NIN = 3 * DM + NH;
constexpr int NMOD = 6 * DM;
constexpr float RMS_EPS = 1e-6f;
constexpr float LOG2E = 1.4426950408889634f;
constexpr float QSCALE = 0.08838834764831845f * LOG2E;
constexpr int NWAVES = 8, NTHREADS = 512;
constexpr int LDS_TOTAL = 147456;
constexpr int NPHASES = 13;
#ifndef PH_MASK
#define PH_MASK 0xff
#endif
#define KEN(k) ((PH_MASK >> (k)) & 1)
constexpr size_t MiB = 1u << 20;
constexpr size_t WS_MOD = 1 * MiB, WS_SW = 1 * MiB + 512 * 1024, WS_LF = 2 * MiB, WS_FK = 3 * MiB;
constexpr size_t WS_SS = 516 * MiB;
constexpr int SW_UP0 = 0, SW_CIN = 4 * 8192, SW_UP1 = 4 * 8192 + 4 * 6144;
constexpr size_t WS_WQKV = 4 * MiB, WS_WO = 28 * MiB, WS_WCIN = 36 * MiB, WS_WCOUT = 60 * MiB, WS_WUP0 = 68 * MiB, WS_WUP1 = 100 * MiB, WS_WDN0 = 132 * MiB, WS_WDN1 = 164 * MiB;
constexpr size_t WS_XN = 196 * MiB, WS_Q = 260 * MiB, WS_K = 324 * MiB, WS_V = 388 * MiB, WS_O = 452 * MiB, WS_U = 260 * MiB, WS_XRB = 518 * MiB, WS_NRM = 582 * MiB, WS_END = 590 * MiB;
static_assert(WS_U + (size_t)M * FF * 2 == WS_SS && WS_O + (size_t)M * DM * 2 == WS_SS && WS_SS + (size_t)M * 32 * 4 == WS_XRB && WS_XRB + (size_t)M * DM * 2 == WS_NRM && WS_NRM + (size_t)2 * M * 64 * 4 == WS_END && WS_XN + (size_t)M * DM * 2 == WS_Q, "d_ws map");

#define LAS __attribute__((address_space(3)))
typedef unsigned short bf16;
typedef unsigned v4u __attribute__((ext_vector_type(4)));
typedef unsigned v2u __attribute__((ext_vector_type(2)));
typedef float f32x4 __attribute__((ext_vector_type(4)));
typedef float f32x2 __attribute__((ext_vector_type(2)));
#define LDS_WAIT() asm volatile("s_waitcnt lgkmcnt(0)" ::: "memory")
__device__ __forceinline__ unsigned pk2(float lo, float hi) { unsigned r; asm volatile("v_cvt_pk_bf16_f32 %0, %1, %2" : "=v"(r) : "v"(lo), "v"(hi)); return r; }
__device__ __forceinline__ float bf_lo(unsigned w) { return __uint_as_float(w << 16); }
__device__ __forceinline__ float bf_hi(unsigned w) { return __uint_as_float(w & 0xffff0000u); }
__device__ __forceinline__ float wave_sum(float v) {
#pragma unroll
    for (int o = 1; o < 64; o <<= 1) v += __shfl_xor(v, o);
    return v;
}

__device__ __forceinline__ void p0_gemv(const float* c, const float* ada_w, const float* ada_b, float* mod, LAS unsigned char* lds, int tid, int wave, int lane) {
    LAS f32x4* cact = (LAS f32x4*)lds;
    LAS float* red = (LAS float*)(lds + 32768);
    for (int k = tid; k < DM; k += NTHREADS) { f32x4 v;
#pragma unroll
        for (int b = 0; b < 4; ++b) { const float cv = c[b * DM + k]; v[b] = cv / (1.f + expf(-cv)); }
        cact[k] = v; }
    __syncthreads();
    for (int it = blockIdx.x; it < 192; it += gridDim.x) {
        const int l = it / 96, n0 = (it % 96) * 128;
        const float* wp = ada_w + ((size_t)l * DM + 256 * wave) * NMOD + n0 + 2 * lane;
        f32x2 acc[4];
#pragma unroll
        for (int b = 0; b < 4; ++b) acc[b] = (f32x2){0.f, 0.f};
#pragma unroll 16
        for (int kk = 0; kk < 256; ++kk) { const f32x2 wv = __builtin_nontemporal_load((const f32x2*)(wp + (size_t)kk * NMOD));   const f32x4 cv = cact[256 * wave + kk];
#pragma unroll
            for (int b = 0; b < 4; ++b) acc[b] += wv * cv[b]; }
#pragma unroll
        for (int b = 0; b < 4; ++b) *(LAS f32x2*)(red + (wave * 4 + b) * 128 + 2 * lane) = acc[b];
        __syncthreads();
        { const int b = tid >> 7, col = tid & 127; float s = ada_b[l * NMOD + n0 + col];
#pragma unroll
          for (int w = 0; w < 8; ++w) s += red[(w * 4 + b) * 128 + col];
          mod[(size_t)(l * 4 + b) * NMOD + n0 + col] = s; }
        __syncthreads();
    }
}
__device__ __forceinline__ void p0_transpose_item(const float* W, int ld, int K, int nblk, bf16* WT, LAS float* scr, int item, int lane, bool cumap = false) {
    const int kb = item / nblk, nb = item % nblk, k0 = 64 * kb, n0 = 32 * nb;
    const int d0 = !cumap || n0 < DM ? n0 : (n0 < 2 * DM ? DM + 256 * ((n0 - DM) >> 7) + ((n0 - DM) & 127) : DM + 256 * ((n0 - 2 * DM) >> 7) + 128 + ((n0 - 2 * DM) & 127));
#pragma unroll 8
    for (int i = 0; i < 32; ++i) { const int kk = 2 * i + (lane >> 5); scr[kk * 33 + (lane & 31)] = __builtin_nontemporal_load(W + (size_t)(k0 + kk) * ld + n0 + (lane & 31)); }
    LDS_WAIT(); asm volatile("" ::: "memory");
    const int c = lane & 7;
#pragma unroll
    for (int j = 0; j < 4; ++j) { const int n = (lane >> 3) + 8 * j; const LAS float* s = scr + (8 * c) * 33 + n;
        v4u o; o.x = pk2(s[0 * 33], s[1 * 33]); o.y = pk2(s[2 * 33], s[3 * 33]); o.z = pk2(s[4 * 33], s[5 * 33]); o.w = pk2(s[6 * 33], s[7 * 33]);
        *(v4u*)(WT + (size_t)(d0 + n) * K + k0 + 8 * c) = o; }
    LDS_WAIT(); asm volatile("" ::: "memory");
}
struct Args { const float* in[15]; float* out; unsigned char* ws; int ph_lo, ph_hi; };
typedef const __attribute__((address_space(4))) unsigned char* kargp_t;
#define KARG_IN(kq, i) (*(const float* const __attribute__((address_space(4)))*)((kq) + 8 * (i)))
#define KARG_OUT(kq) (*(float* const __attribute__((address_space(4)))*)((kq) + 120))
#define KARG_WS(kq) (*(unsigned char* const __attribute__((address_space(4)))*)((kq) + 128))
static_assert(sizeof(Args) == 144, "Args layout");
__device__ __forceinline__ void p0_transposes(kargp_t kq, LAS unsigned char* lds, int wave, int lane, int gw, int ngw) {
    LAS float* scr = (LAS float*)(lds + wave * 16384);
    unsigned char* ws = KARG_WS(kq);
    constexpr int I_IN = 32 * 192, I_SQ = 32 * 64, I_UP = 32 * 256, I_DN = 128 * 64;
    constexpr int NITEMS = 2 * I_IN + 2 * I_SQ + 2 * I_UP + 2 * I_DN;
    const bool deal = (ngw == 2048); static_assert(NITEMS == 1536 * 22 + 512 * 30, "prologue item deal");
    const int lo_wave = gw < 1536, first = deal ? (lo_wave ? gw : 33792 + (gw - 1536)) : gw, step = deal ? (lo_wave ? 1536 : 512) : ngw, stop = deal ? (lo_wave ? 33792 : NITEMS) : NITEMS;
    for (int it = first; it < stop; it += step) {
        int r = it;
        if (r < I_IN) { p0_transpose_item(KARG_IN(kq, 6), NIN, DM, 192, (bf16*)(ws + WS_WQKV), scr, r, lane); continue; } r -= I_IN;
        if (r < I_SQ) { p0_transpose_item(KARG_IN(kq, 8), DM, DM, 64, (bf16*)(ws + WS_WO), scr, r, lane); continue; } r -= I_SQ;
        if (r < I_IN) { p0_transpose_item(KARG_IN(kq, 9), 3 * DM, DM, 192, (bf16*)(ws + WS_WCIN), scr, r, lane, true); continue; } r -= I_IN;
        if (r < I_SQ) { p0_transpose_item(KARG_IN(kq, 11), DM, DM, 64, (bf16*)(ws + WS_WCOUT), scr, r, lane); continue; } r -= I_SQ;
        if (r < I_UP) { p0_transpose_item(KARG_IN(kq, 12), FF, DM, 256, (bf16*)(ws + WS_WUP0), scr, r, lane); continue; } r -= I_UP;
        if (r < I_UP) { p0_transpose_item(KARG_IN(kq, 12) + (size_t)DM * FF, FF, DM, 256, (bf16*)(ws + WS_WUP1), scr, r, lane); continue; } r -= I_UP;
        if (r < I_DN) { p0_transpose_item(KARG_IN(kq, 13), DM, FF, 64, (bf16*)(ws + WS_WDN0), scr, r, lane); continue; } r -= I_DN;
        p0_transpose_item(KARG_IN(kq, 13) + (size_t)FF * DM, DM, FF, 64, (bf16*)(ws + WS_WDN1), scr, r, lane);
    }
}
__device__ __forceinline__ void ld8nt(const bf16* p, float (&f)[8]) { const v4u w = __builtin_nontemporal_load((const v4u*)p); f[0] = bf_lo(w.x); f[1] = bf_hi(w.x); f[2] = bf_lo(w.y); f[3] = bf_hi(w.y); f[4] = bf_lo(w.z); f[5] = bf_hi(w.z); f[6] = bf_lo(w.w); f[7] = bf_hi(w.w); }
__device__ __forceinline__ void ld8(const bf16* p, float (&f)[8]) { const v4u w = *(const v4u*)p; f[0] = bf_lo(w.x); f[1] = bf_hi(w.x); f[2] = bf_lo(w.y); f[3] = bf_hi(w.y); f[4] = bf_lo(w.z); f[5] = bf_hi(w.z); f[6] = bf_lo(w.w); f[7] = bf_hi(w.w); }
__device__ __forceinline__ void shiftw_mfma(const float* mod, unsigned char* ws, float* SW, LAS unsigned char* lds, int tid, int lane, int gw, int ngw) {
    LAS bf16* S = (LAS bf16*)lds;
#pragma unroll
    for (int it = 0; it < 3 * 4 * DM / 4 / NTHREADS; ++it) { const int idx = tid + it * NTHREADS, mat = idx / DM, b = (idx / (DM / 4)) & 3, k = (idx & (DM / 4 - 1)) * 4;
        const float* shp = mat == 0 ? mod + 3 * DM : (mat == 1 ? mod + (size_t)4 * NMOD : mod + (size_t)4 * NMOD + 3 * DM);
        const f32x4 v = *(const f32x4*)(shp + (size_t)b * NMOD + k); unsigned hb[4], lb[4];
#pragma unroll
        for (int i = 0; i < 4; ++i) { hb[i] = pk2(v[i], 0.f) & 0xffffu; lb[i] = pk2(v[i] - __uint_as_float(hb[i] << 16), 0.f) & 0xffffu; }
        v2u h2, l2; h2.x = hb[0] | (hb[1] << 16); h2.y = hb[2] | (hb[3] << 16); l2.x = lb[0] | (lb[1] << 16); l2.y = lb[2] | (lb[3] << 16);
        *(LAS v2u*)(S + (mat * 8 + b) * DM + k) = h2; *(LAS v2u*)(S + (mat * 8 + 4 + b) * DM + k) = l2; }
    __syncthreads();
    const int fr = lane & 15, fq = lane >> 4;
    for (int g = gw; g < 1408; g += ngw) {
        const int mat = g < 512 ? 0 : (g < 896 ? 1 : 2), g0 = g - (mat == 0 ? 0 : (mat == 1 ? 512 : 896)), N = mat == 1 ? 3 * DM : FF;
        const bf16* Wt = (const bf16*)(ws + (mat == 0 ? WS_WUP0 : (mat == 1 ? WS_WCIN : WS_WUP1)));
        float* sw = SW + (mat == 0 ? SW_UP0 : (mat == 1 ? SW_CIN : SW_UP1));
        const bf16* wp = Wt + (size_t)(g0 * 16 + fr) * DM + 8 * fq;
        const LAS bf16* sp = S + (mat * 8 + (fr & 7)) * DM + 8 * fq;
        pg8::f32x4 acc = {0.f, 0.f, 0.f, 0.f};
#pragma unroll 8
        for (int kk = 0; kk < DM / 32; ++kk) { const pg8::bf16x8 wf = *(const pg8::bf16x8*)(wp + 32 * kk); pg8::bf16x8 sf = *(const LAS pg8::bf16x8*)(sp + 32 * kk);
            if (fr >= 8) sf = (pg8::bf16x8){0, 0, 0, 0, 0, 0, 0, 0};
            acc = __builtin_amdgcn_mfma_f32_16x16x32_bf16(wf, sf, acc, 0, 0, 0); }
        pg8::f32x4 r;
#pragma unroll
        for (int i = 0; i < 4; ++i) r[i] = acc[i] + __shfl_xor(acc[i], 4);
        if (fr < 4) *(pg8::f32x4*)(sw + (size_t)fr * N + g0 * 16 + 4 * fq) = r;
    }
}
constexpr int WFT_LD = DM + 8;
__device__ __forceinline__ void norm_phase(const float* src, const float* gain, const float* shp, const float* scp, bf16* XN,
                                           const float* w_in, const float* b_f, float* LF, LAS unsigned char* lds, int tid, int lane, int wave, int gw, int ngw) {
    LAS bf16* WFT = (LAS bf16*)lds;
#pragma unroll
    for (int idx = tid; idx < 8192; idx += NTHREADS) { const int k = idx >> 2, n4 = idx & 3;
        const f32x4 v = *(const f32x4*)(w_in + (size_t)k * NIN + 3 * DM + 4 * n4);
#pragma unroll
        for (int i = 0; i < 4; ++i) { const unsigned hb = pk2(v[i], 0.f) & 0xffffu; const unsigned lb = pk2(v[i] - __uint_as_float(hb << 16), 0.f) & 0xffffu;
            WFT[(4 * n4 + i) * WFT_LD + k] = (bf16)hb; WFT[(16 + 4 * n4 + i) * WFT_LD + k] = (bf16)lb; } }
    for (int grp = gw; grp < M / 8; grp += ngw) {
        const int row0 = grp * 8, b = row0 / SEQ;
        for (int rq = 0; rq < 2; ++rq) {
            asm volatile("" ::: "memory");
            f32x4 v[4][8]; float inv[4];
#pragma unroll
            for (int r = 0; r < 4; ++r)
#pragma unroll
                for (int j = 0; j < 8; ++j) v[r][j] = __builtin_nontemporal_load((const f32x4*)(src + (size_t)(row0 + 4 * rq + r) * DM) + lane + 64 * j);
#pragma unroll
            for (int r = 0; r < 4; ++r) { float ss = 0.f;
#pragma unroll
                for (int j = 0; j < 8; ++j) ss += (v[r][j].x * v[r][j].x + v[r][j].y * v[r][j].y) + (v[r][j].z * v[r][j].z + v[r][j].w * v[r][j].w);
                inv[r] = 1.0f / sqrtf(wave_sum(ss) * (1.f / DM) + RMS_EPS); }
#pragma unroll
            for (int j = 0; j < 8; ++j) { const f32x4 g = ((const f32x4*)gain)[lane + 64 * j], sc = ((const f32x4*)(scp + (size_t)b * NMOD))[lane + 64 * j], sh = ((const f32x4*)(shp + (size_t)b * NMOD))[lane + 64 * j];
                const f32x4 ca = g * (sc + 1.f);
#pragma unroll
                for (int r = 0; r < 4; ++r) { const f32x4 h = (v[r][j] * inv[r]) * ca + sh; v2u w; w.x = pk2(h.x, h.y); w.y = pk2(h.z, h.w);
                    ((v2u*)(XN + (size_t)(row0 + 4 * rq + r) * DM))[lane + 64 * j] = w; } }
        }
    }
    __syncthreads();
    if ((wave & 1) == 0) {
        const int fr = lane & 15, fq = lane >> 4;
        for (int grp = gw; grp < M / 8; grp += ngw) {
            const int row0 = grp * 8, b = row0 / SEQ;
            const bf16* xp = XN + (size_t)(row0 + fr) * DM + 8 * fq;
            const LAS bf16* yh = WFT + fr * WFT_LD + 8 * fq; const LAS bf16* yl = yh + 16 * WFT_LD;
            pg8::f32x4 ah = {0.f, 0.f, 0.f, 0.f}, al = {0.f, 0.f, 0.f, 0.f};
#pragma unroll 8
            for (int kk = 0; kk < DM / 32; ++kk) { const pg8::bf16x8 xf = *(const pg8::bf16x8*)(xp + 32 * kk);
                ah = __builtin_amdgcn_mfma_f32_16x16x32_bf16(xf, *(const LAS pg8::bf16x8*)(yh + 32 * kk), ah, 0, 0, 0);
                al = __builtin_amdgcn_mfma_f32_16x16x32_bf16(xf, *(const LAS pg8::bf16x8*)(yl + 32 * kk), al, 0, 0, 0); }
            const float bias = b_f[fr]; pg8::f32x4 lf;
#pragma unroll
            for (int i = 0; i < 4; ++i) { const float z = ah[i] + al[i] + bias; lf[i] = fminf(z, 0.f) - log1pf(expf(-fabsf(z))); }
            *(pg8::f32x4*)(LF + (size_t)(b * NH + fr) * SEQ + (row0 % SEQ) + 4 * fq) = lf;
        }
    }
}
__device__ __forceinline__ void cumsum_block(const float* LF, float* FK, int bh, LAS unsigned char* lds, int tid, int wave, int lane) {
    const f32x4 a = *(const f32x4*)(LF + (size_t)bh * SEQ + 8 * tid), b = *(const f32x4*)(LF + (size_t)bh * SEQ + 8 * tid + 4);
    float p[8]; p[0] = a.x; p[1] = p[0] + a.y; p[2] = p[1] + a.z; p[3] = p[2] + a.w; p[4] = p[3] + b.x; p[5] = p[4] + b.y; p[6] = p[5] + b.z; p[7] = p[6] + b.w;
    float incl = p[7];
#pragma unroll
    for (int o = 1; o < 64; o <<= 1) { const float t = __shfl_up(incl, o); if (lane >= o) incl += t; }
    LAS float* wt = (LAS float*)lds;
    if (lane == 63) wt[wave] = incl;
    __syncthreads();
    float off = incl - p[7];
    for (int w = 0; w < wave; ++w) off += wt[w];
    f32x4 o0, o1; o0.x = -(off + p[0]) * LOG2E; o0.y = -(off + p[1]) * LOG2E; o0.z = -(off + p[2]) * LOG2E; o0.w = -(off + p[3]) * LOG2E;
    o1.x = -(off + p[4]) * LOG2E; o1.y = -(off + p[5]) * LOG2E; o1.z = -(off + p[6]) * LOG2E; o1.w = -(off + p[7]) * LOG2E;
    *(f32x4*)(FK + (size_t)bh * SEQ + 8 * tid) = o0; *(f32x4*)(FK + (size_t)bh * SEQ + 8 * tid + 4) = o1;
    __syncthreads();
}
typedef __hip_bfloat16 hbf;
__device__ __forceinline__ void att_item(int L, int pass, int& bh, int& qb) {
    const int xcd = L & 7, k = L >> 3; bh = (k >> 3) * 8 + xcd; const int x0 = k & 7, x = (L >= 256) ? 7 - x0 : x0; qb = pass ? 15 - x : x;
}
__device__ __forceinline__ att::BlockRef<hbf, hbf> att_ref(int L, int pass, int jlo, const hbf* Q, const hbf* K, const hbf* V, hbf* O, const float* FK) {
    int bh, qb; att_item(L, pass, bh, qb);
    const int b = bh >> 4, h = bh & 15; const size_t rowbase = (size_t)b * SEQ;
    att::BlockRef<hbf, hbf> r;
    r.Q = Q + (rowbase + (size_t)qb * 256) * DM + h * HD; r.O = O + (rowbase + (size_t)qb * 256) * DM + h * HD;
    r.K = K + rowbase * DM + h * HD; r.V = V + rowbase * DM + h * HD; r.F = FK + (size_t)bh * SEQ; r.P0 = qb * 256; r.jlo = jlo;
    return r;
}
__device__ __forceinline__ int att_jlo(int L, int pass, const float* NRM, const float* FK, LAS unsigned char* lds, int tid, int lane, int wave) {
    int bh, qb; att_item(L, pass, bh, qb);
    const int b = bh >> 4, h = bh & 15, P0 = qb * 256; const size_t rowbase = (size_t)b * SEQ;
    const float* NQ = NRM + (size_t)bh * SEQ * 4; const float* NK = NRM + ((size_t)(BATCH * NH) + bh) * SEQ * 4;
    float kq = 0.f, kk = 0.f;
    if (tid < 256) { const f32x4 v = *(const f32x4*)(NQ + (size_t)(P0 + tid) * 4); kq = (v[0] + v[1]) + (v[2] + v[3]); }
    for (int s = tid; s < P0 + 256; s += NTHREADS) { const f32x4 v = *(const f32x4*)(NK + (size_t)s * 4); kk = fmaxf(kk, (v[0] + v[1]) + (v[2] + v[3])); }
#pragma unroll
    for (int o = 1; o < 64; o <<= 1) { kq = fmaxf(kq, __shfl_xor(kq, o)); kk = fmaxf(kk, __shfl_xor(kk, o)); }
    LAS float* red = (LAS float*)(lds + 122880);
    if (lane == 0) { red[wave] = kq; red[8 + wave] = kk; }
    __syncthreads();
    float mq = 0.f, mk = 0.f;
#pragma unroll
    for (int w = 0; w < 8; ++w) { mq = fmaxf(mq, red[w]); mk = fmaxf(mk, red[8 + w]); }
    const float B = 1.02f * sqrtf(mq * mk);
    const float* F = FK + (size_t)bh * SEQ;
    const float fend = F[64 * lane + 63], f0 = F[P0];
    const bool skip = (64 * lane + 63 < P0) && (2.f * B + fend - f0 < -60.f);
    const int jlo = __popcll(__ballot(skip));
    __syncthreads();
    return __builtin_amdgcn_readfirstlane(jlo);
}
__device__ __forceinline__ void attn_phase(const hbf* Q, const hbf* K, const hbf* V, hbf* O, const float* FK, const float* NRM, char* lds) {
    constexpr int total = 8 * BATCH * NH, W = 1 << 30;
    const int stride = gridDim.x; int L = blockIdx.x; if (L >= total) return;
    const int L0 = L;
    int jl0, jl1, jl2 = 0, jl3 = 0;
    { const int tid = tidx(), lane = tid & 63, wave = __builtin_amdgcn_readfirstlane(tid >> 6);
      jl0 = att_jlo(L0, 0, NRM, FK, (LAS unsigned char*)lds, tid, lane, wave); jl1 = att_jlo(L0, 1, NRM, FK, (LAS unsigned char*)lds, tid, lane, wave);
      if (L0 + stride < total) { jl2 = att_jlo(L0 + stride, 0, NRM, FK, (LAS unsigned char*)lds, tid, lane, wave); jl3 = att_jlo(L0 + stride, 1, NRM, FK, (LAS unsigned char*)lds, tid, lane, wave); } }
    int pass = 0, fsel = 0;
    att::BlockRef<hbf, hbf> cur = att_ref(L, 0, jl0, Q, K, V, O, FK);
    att::Seam<hbf> S;
    att::causal_swa_prime<hbf, hbf>(cur, W, lds, S, lds + att::ATT_F_OFF);
    for (;;) {
        const bool more_pass = pass == 0, more_item = (L == L0) && (L + stride < total), last = !more_pass && !more_item;
        int passn = pass + 1, Ln = L;
        if (!more_pass) { passn = 0; Ln = more_item ? L + stride : L; }
        const int jn = (Ln == L0) ? (passn ? jl1 : jl0) : (passn ? jl3 : jl2);
        const att::BlockRef<hbf, hbf> nxt = last ? cur : att_ref(Ln, passn, jn, Q, K, V, O, FK);
        att::causal_swa_block<hbf, hbf>(cur, nxt, SEQ, W, lds, S, lds + att::ATT_F_OFF + fsel * 16384, lds + att::ATT_F_OFF + (fsel ^ 1) * 16384);
        if (last) break;
        cur = nxt; pass = passn; L = Ln; fsel ^= 1;
    }
}
__device__ __forceinline__ void conv_phase(const bf16* BG, const bf16* P, const float* cw, bf16* Y, int lane, int gw, int ngw) {
    for (int grp = gw; grp < M / 8; grp += ngw) {
        const int row0 = grp * 8, t0 = row0 % SEQ;
        for (int j = 0; j < 4; ++j) {
            const int ch = (lane + 64 * j) * 8;
            float w0[8], w1[8], w2[8], pm2[8], pm1[8];
#pragma unroll
            for (int i = 0; i < 8; ++i) { w0[i] = cw[ch + i]; w1[i] = cw[DM + ch + i]; w2[i] = cw[2 * DM + ch + i]; pm2[i] = 0.f; pm1[i] = 0.f; }
            if (t0 > 0) { ld8(P + (size_t)(row0 - 2) * DM + ch, pm2); ld8(P + (size_t)(row0 - 1) * DM + ch, pm1); }
#pragma unroll
            for (int r = 0; r < 8; ++r) { float p8[8], b8[8], y[8];
                ld8nt(P + (size_t)(row0 + r) * DM + ch, p8); ld8nt(BG + (size_t)(row0 + r) * DM + ch, b8);
#pragma unroll
                for (int i = 0; i < 8; ++i) { y[i] = b8[i] * (w0[i] * pm2[i] + w1[i] * pm1[i] + w2[i] * p8[i]); pm2[i] = pm1[i]; pm1[i] = p8[i]; }
                v4u o; o.x = pk2(y[0], y[1]); o.y = pk2(y[2], y[3]); o.z = pk2(y[4], y[5]); o.w = pk2(y[6], y[7]);
                *(v4u*)(Y + (size_t)(row0 + r) * DM + ch) = o; }
        }
    }
}
__device__ __forceinline__ void final_norm_phase(const bf16* xr, float* out, const float* gain, int lane, int gw, int ngw) {
    for (int r0 = gw * 4; r0 < M; r0 += ngw * 4) {
        v4u raw[4][4];
#pragma unroll
        for (int r = 0; r < 4; ++r)
#pragma unroll
            for (int j = 0; j < 4; ++j) raw[r][j] = __builtin_nontemporal_load((const v4u*)(xr + (size_t)(r0 + r) * DM + (lane + 64 * j) * 8));
        float inv[4];
#pragma unroll
        for (int r = 0; r < 4; ++r) { float ss = 0.f;
#pragma unroll
            for (int j = 0; j < 4; ++j) { const unsigned w[4] = {raw[r][j].x, raw[r][j].y, raw[r][j].z, raw[r][j].w};
#pragma unroll
                for (int i = 0; i < 4; ++i) { const float a = bf_lo(w[i]), b = bf_hi(w[i]); ss += a * a + b * b; } }
            inv[r] = 1.0f / sqrtf(wave_sum(ss) * (1.f / DM) + RMS_EPS); }
#pragma unroll
        for (int j = 0; j < 4; ++j) { const f32x4 g0 = *(const f32x4*)(gain + (lane + 64 * j) * 8), g1 = *(const f32x4*)(gain + (lane + 64 * j) * 8 + 4);
#pragma unroll
            for (int r = 0; r < 4; ++r) { const v4u w = raw[r][j]; f32x4 o0, o1;
                o0[0] = bf_lo(w.x); o0[1] = bf_hi(w.x); o0[2] = bf_lo(w.y); o0[3] = bf_hi(w.y); o1[0] = bf_lo(w.z); o1[1] = bf_hi(w.z); o1[2] = bf_lo(w.w); o1[3] = bf_hi(w.w);
                o0 = (o0 * inv[r]) * g0; o1 = (o1 * inv[r]) * g1;
                *(f32x4*)(out + (size_t)(r0 + r) * DM + (lane + 64 * j) * 8) = o0; *(f32x4*)(out + (size_t)(r0 + r) * DM + (lane + 64 * j) * 8 + 4) = o1; } }
    }
}

#define XB_TMO      128
#define XB_XCNT(j)  (256  + 64 * (j))
#define XB_XSUB(j)  (1280 + 64 * (j))
#define XB_XGEN(j)  (2304 + 64 * (j))
#define XB_TOP      3328
#define XB_TOPGEN   3392
#define XCD_BAR_WORDS 3456
#define XB_SPIN_CAP (1u << 18)

__device__ __forceinline__ unsigned xb_ld(unsigned* p)              { return __hip_atomic_load(p, __ATOMIC_RELAXED, __HIP_MEMORY_SCOPE_AGENT); }
__device__ __forceinline__ unsigned xb_add(unsigned* p, unsigned v) { return __hip_atomic_fetch_add(p, v, __ATOMIC_RELAXED, __HIP_MEMORY_SCOPE_AGENT); }
__device__ __forceinline__ unsigned xb_xcc_id() { return (unsigned)__builtin_amdgcn_s_getreg((3 << 11) | 20) & 0xFu; }
#define XB_SPIN(cond, bar) do { unsigned _sp = 0; while (cond) { __builtin_amdgcn_s_sleep(1); \
    if ((++_sp & 255u) == 0u) { if (xb_ld(&(bar)[XB_TMO])) break; if (_sp > XB_SPIN_CAP) { atomicAdd(&(bar)[XB_TMO], 1u); break; } } } } while (0)

struct XcdBarrier {
    unsigned* bar; unsigned x;
    volatile LAS unsigned* st;
};

__device__ __forceinline__ XcdBarrier xcd_barrier_post(unsigned* bar, volatile LAS unsigned* st) {
    XcdBarrier b; b.bar = bar; b.x = xb_xcc_id(); b.st = st;
    if (threadIdx.x == 0) (void)xb_add(&bar[XB_XCNT(b.x)], 1u);
    return b;
}
__device__ __forceinline__ void xcd_barrier_complete(unsigned* bar, unsigned x, unsigned& nloc, unsigned& nx) {
    const unsigned G = gridDim.x * gridDim.y * gridDim.z;
    unsigned sum, cnt, mine, sp = 0u;
    for (;;) {
        sum = 0u; cnt = 0u; mine = 0u;
#pragma unroll
        for (unsigned j = 0; j < 16; ++j) { const unsigned c = xb_ld(&bar[XB_XCNT(j)]); sum += c; cnt += (c > 0u) ? 1u : 0u; mine = (j == x) ? c : mine; }
        if (sum == G) break;
        __builtin_amdgcn_s_sleep(1);
        if ((++sp & 255u) == 0u) { if (xb_ld(&bar[XB_TMO])) break; if (sp > XB_SPIN_CAP) { atomicAdd(&bar[XB_TMO], 1u); break; } }
    }
    nloc = mine > 0u ? mine : 1u; nx = cnt > 0u ? cnt : 1u;
}

__device__ __forceinline__ void xcd_barrier(const XcdBarrier& b) {
    asm volatile("s_waitcnt vmcnt(0)" ::: "memory");
    __syncthreads();
    if (threadIdx.x == 0) {
        unsigned* bar = b.bar;
        __builtin_amdgcn_s_waitcnt(0);
        unsigned nloc = b.st[0], nx = b.st[1];
        if (nloc == 0u) { xcd_barrier_complete(bar, b.x, nloc, nx); b.st[0] = nloc; b.st[1] = nx; }
        const unsigned old = xb_add(&bar[XB_XSUB(b.x)], 1u);
        const unsigned gen = old / nloc;
        if (old + 1u == (gen + 1u) * nloc) {
            __builtin_amdgcn_fence(__ATOMIC_RELEASE, "agent");
            asm volatile("s_waitcnt vmcnt(0)" ::: "memory");
            const unsigned og = xb_add(&bar[XB_TOP], 1u);
            const unsigned tg = og / nx;
            if (og + 1u == (tg + 1u) * nx) xb_add(&bar[XB_TOPGEN], 1u);
            else XB_SPIN(xb_ld(&bar[XB_TOPGEN]) == tg, bar);
            __builtin_amdgcn_fence(__ATOMIC_ACQUIRE, "agent");
            xb_add(&bar[XB_XGEN(b.x)], 1u);
            asm volatile("s_waitcnt vmcnt(0)" ::: "memory");
        } else {
            XB_SPIN(xb_ld(&bar[XB_XGEN(b.x)]) == gen, bar);
            __builtin_amdgcn_fence(__ATOMIC_ACQUIRE, "agent");
            asm volatile("s_waitcnt vmcnt(0)" ::: "memory");
        }
    }
    __syncthreads();
}

enum { K_PRO = 0, K_NORM, K_GEMM_BF16, K_ATTN, K_GEMM_RES, K_GEMM_SQ, K_CONV, K_FINAL };
__global__ void __launch_bounds__(NTHREADS, 2) fwd_mega(Args a) {
    extern __shared__ __attribute__((aligned(16))) unsigned char lds[];
    LAS unsigned char* L = (LAS unsigned char*)lds;
    const int G = gridDim.x, ngw = G * NWAVES;
    const kargp_t kp = (kargp_t)__builtin_amdgcn_kernarg_segment_ptr();
    const int ph_lo = a.ph_lo, ph_hi = a.ph_hi;
    volatile LAS unsigned* MISC = (volatile LAS unsigned*)(L + LDS_TOTAL - 256);
    if (tidx() < 32) MISC[tidx()] = 0u;
    __syncthreads();
    XcdBarrier xbar; xbar.bar = (unsigned*)a.ws; xbar.x = 0; xbar.st = nullptr;
    if (ph_hi - ph_lo > 1) xbar = xcd_barrier_post((unsigned*)a.ws, MISC + 8);
#if defined(PROBE_REP_KIND)
    int rep_left = PROBE_REP_N;
#endif
    for (int ph = ph_lo; ph < ph_hi; ++ph) {
        kargp_t kq = kp; asm volatile("" : "+s"(kq));
        unsigned char* ws = KARG_WS(kq);
        const float* x = KARG_IN(kq, 0);
        float* mod = (float*)(ws + WS_MOD); float* LF = (float*)(ws + WS_LF); float* FK = (float*)(ws + WS_FK);
        bf16* XN = (bf16*)(ws + WS_XN); bf16* Qb = (bf16*)(ws + WS_Q); bf16* Kb = (bf16*)(ws + WS_K); bf16* Vb = (bf16*)(ws + WS_V); bf16* Ob = (bf16*)(ws + WS_O); bf16* Ub = (bf16*)(ws + WS_U);
        float* XR = KARG_OUT(kq);
        const int layer = ph >= 7 ? 1 : 0;
        int kind;
        switch (ph) {
            case 0: kind = K_PRO; break;
            case 1: kind = K_NORM; break;
            case 2: case 7: kind = K_GEMM_BF16; break;
            case 3: kind = K_ATTN; break;
            case 4: case 6: case 9: case 11: kind = K_GEMM_RES; break;
            case 5: case 10: kind = K_GEMM_SQ; break;
            case 8: kind = K_CONV; break;
            default: kind = K_FINAL; break;
        }
        const bool mlp_half = (ph == 5 || ph == 6 || ph == 10 || ph == 11);
        const float* modl = mod + (size_t)layer * 4 * NMOD;
        float* SS = (float*)(ws + WS_SS); float* SW = (float*)(ws + WS_SW);
        if (KEN(K_PRO) && kind == K_PRO) {
            const int tid = tidx(), lane = tid & 63, wave = __builtin_amdgcn_readfirstlane(tid >> 6), gw = blockIdx.x * NWAVES + wave; (void)tid; (void)lane; (void)wave; (void)gw;
            p0_gemv(KARG_IN(kq, 1), KARG_IN(kq, 2), KARG_IN(kq, 3), mod, L, tid, wave, lane);
            p0_transposes(kq, L, wave, lane, gw, ngw);
            __syncthreads();
        } else if (KEN(K_NORM) && kind == K_NORM) {
            const int tid = tidx(), lane = tid & 63, wave = __builtin_amdgcn_readfirstlane(tid >> 6), gw = blockIdx.x * NWAVES + wave; (void)tid; (void)lane; (void)wave; (void)gw;
            norm_phase(x, KARG_IN(kq, 4), modl, modl + DM, XN, KARG_IN(kq, 6), KARG_IN(kq, 7), LF, L, tid, lane, wave, gw, ngw);
            __syncthreads();
            shiftw_mfma(mod, ws, SW, L, tid, lane, gw, ngw);
            __syncthreads();
        } else if (KEN(K_GEMM_BF16) && kind == K_GEMM_BF16) {
            const int tid = tidx(), lane = tid & 63, wave = __builtin_amdgcn_readfirstlane(tid >> 6), gw = blockIdx.x * NWAVES + wave; (void)tid; (void)lane; (void)wave; (void)gw;
            if (ph == 2) { for (int bh = blockIdx.x; bh < BATCH * NH; bh += G) cumsum_block(LF, FK, bh, L, tid, wave, lane); }
            pg8::Gemm g{XN, (const bf16*)(ws + (ph == 2 ? WS_WQKV : WS_WCIN)), M, 3 * DM, DM}; pg8::StaticOrder S; S.init(M, 3 * DM, G, (int)blockIdx.x);
            pg8::EpiBf16<0> E{Qb, DM, DM, (size_t)(WS_K - WS_Q) / 2, ph == 2 ? QSCALE : 1.0f, ph == 2 ? (const float*)nullptr : (const float*)SS, SW + SW_CIN, 3 * DM, SEQ, ph == 2 ? (bf16*)nullptr : Kb, 8, ph == 2 ? (float*)(ws + WS_NRM) : (float*)nullptr};
            pg8::gemm_phase<pg8::EpiBf16<0>, pg8::StaticOrder, true, true>(L, g, S, E);
        } else if (KEN(K_ATTN) && kind == K_ATTN) {
            attn_phase((const hbf*)Qb, (const hbf*)Kb, (const hbf*)Vb, (hbf*)Ob, FK, (const float*)(ws + WS_NRM), (char*)lds);
        } else if (KEN(K_GEMM_RES) && kind == K_GEMM_RES) {
            const bf16* A = mlp_half ? Ub : Ob; const int Kd = mlp_half ? FF : DM;
            const size_t wo = mlp_half ? (layer ? WS_WDN1 : WS_WDN0) : (layer ? WS_WCOUT : WS_WO);
            pg8::Gemm g{A, (const bf16*)(ws + wo), M, DM, Kd}; pg8::StaticOrder S; S.init(M, DM, G, (int)blockIdx.x);
            const float* n_gain = mlp_half ? KARG_IN(kq, 4) + DM : KARG_IN(kq, 5) + (size_t)layer * DM;
            const float* n_scale = mlp_half ? mod + (size_t)4 * NMOD + DM : modl + 4 * DM;
            bf16* XRB = (bf16*)(ws + WS_XRB);
            pg8::EpiRes E{ph == 4 ? x : (const float*)nullptr, ph == 4 ? (const bf16*)nullptr : (const bf16*)XRB, (float*)nullptr, XRB, DM, modl + (mlp_half ? 5 * DM : 2 * DM), SEQ, NMOD, ph == 11 ? (bf16*)nullptr : XN, n_gain, n_scale, SS};
            pg8::gemm_phase<pg8::EpiRes, pg8::StaticOrder, true, true>(L, g, S, E);
        } else if (KEN(K_GEMM_SQ) && kind == K_GEMM_SQ) {
            pg8::Gemm g{XN, (const bf16*)(ws + (layer ? WS_WUP1 : WS_WUP0)), M, FF, DM}; pg8::StaticOrder S; S.init(M, FF, G, (int)blockIdx.x);
#if defined(PROBE_NULL_EPI)
            if (rep_left < PROBE_REP_N) { pg8::EpiNull E0{Ub}; pg8::gemm_phase<pg8::EpiNull, pg8::StaticOrder, true, true>(L, g, S, E0); } else
#endif
            { pg8::EpiBf16<2> E{Ub, FF, 0, 0, 1.0f, SS, SW + (layer ? SW_UP1 : SW_UP0), FF, SEQ, (bf16*)nullptr, 0, (float*)nullptr};
            pg8::gemm_phase<pg8::EpiBf16<2>, pg8::StaticOrder, true, true>(L, g, S, E); }
        } else if (KEN(K_CONV) && kind == K_CONV) {
            const int tid = tidx(), lane = tid & 63, wave = __builtin_amdgcn_readfirstlane(tid >> 6), gw = blockIdx.x * NWAVES + wave; (void)tid; (void)lane; (void)wave; (void)gw;
            conv_phase(Qb, Kb, KARG_IN(kq, 10), Ob, lane, gw, ngw);
        } else if (KEN(K_FINAL) && kind == K_FINAL) {
            const int tid = tidx(), lane = tid & 63, wave = __builtin_amdgcn_readfirstlane(tid >> 6), gw = blockIdx.x * NWAVES + wave; (void)tid; (void)lane; (void)wave; (void)gw;
            final_norm_phase((const bf16*)(ws + WS_XRB), XR, KARG_IN(kq, 14), lane, gw, ngw);
        }
#if defined(PROBE_REP_KIND)
        if (kind == PROBE_REP_KIND && !(kind == K_GEMM_RES && ph != 4) && rep_left > 0) { --rep_left; xcd_barrier(xbar); --ph; continue; }
        rep_left = PROBE_REP_N;
#endif
#if defined(PROBE_EXTRA_SYNC)
        for (int es = 0; es < PROBE_EXTRA_SYNC; ++es) xcd_barrier(xbar);
#endif
        if (ph + 1 < ph_hi) { if (ph_hi > NPHASES) cg::this_grid().sync(); else xcd_barrier(xbar); }
    }
}

extern "C" void kernel_launch(void* const* d_in, const int* in_sizes, int n_in, void* d_out, int out_size, void* d_ws, size_t ws_size, hipStream_t stream) {
    static int grid = 0;
    if (grid == 0) {
        if (n_in != 15 || in_sizes[0] != M * DM || out_size != M * DM || ws_size < WS_END) { fprintf(stderr, "kernel_launch: shape/workspace mismatch (n_in %d, in0 %d, out %d, ws %zu)\n", n_in, n_in > 0 ? in_sizes[0] : -1, out_size, ws_size); grid = -1; return; }
        int dev = 0, cus = 0, per_cu = 0;
        (void)hipGetDevice(&dev); (void)hipDeviceGetAttribute(&cus, hipDeviceAttributeMultiprocessorCount, dev);
        if (hipFuncSetAttribute((const void*)fwd_mega, hipFuncAttributeMaxDynamicSharedMemorySize, LDS_TOTAL) != hipSuccess) { fprintf(stderr, "kernel_launch: hipFuncSetAttribute failed\n"); grid = -1; return; }
        if (hipOccupancyMaxActiveBlocksPerMultiprocessor(&per_cu, (const void*)fwd_mega, NTHREADS, LDS_TOTAL) != hipSuccess || per_cu < 1) { fprintf(stderr, "kernel_launch: occupancy query says %d blocks per CU\n", per_cu); per_cu = 1; }
        (void)hipGetLastError();
        grid = cus > 0 ? cus : 256;
    }
    if (grid < 0) return;
    Args a{};
    for (int i = 0; i < 15; ++i) a.in[i] = (const float*)d_in[i];
    a.out = (float*)d_out; a.ws = (unsigned char*)d_ws;
#if MK_N_LAUNCHES == 1
    a.ph_lo = 0; a.ph_hi = NPHASES;
    (void)hipMemsetAsync(d_ws, 0, 16384, stream);
    void* args[] = {&a};
    hipError_t e = hipLaunchCooperativeKernel((const void*)fwd_mega, dim3(grid), dim3(NTHREADS), args, LDS_TOTAL, stream);
    if (e != hipSuccess) fprintf(stderr, "kernel_launch: cooperative launch failed: %s (grid %d)\n", hipGetErrorString(e), grid);
#else
    for (int ph = 0; ph < NPHASES; ++ph) { a.ph_lo = ph; a.ph_hi = ph + 1; hipLaunchKernelGGL(fwd_mega, dim3(grid), dim3(NTHREADS), LDS_TOTAL, stream, a); }
#endif
}
```

```cpp
#include <hip/hip_runtime.h>
#include <hip/hip_bf16.h>
#include <hip/hip_cooperative_groups.h>
#include <cstdio>
#include <cstdint>
#include <cmath>
namespace cg = cooperative_groups;
#ifndef MK_N_LAUNCHES
#define MK_N_LAUNCHES 1
#endif
__device__ __forceinline__ int tidx() { int t = threadIdx.x; asm volatile("" : "+v"(t)); return t; }
namespace pg8 {
#define PG8_LAS __attribute__((address_space(3)))
typedef unsigned short bf16_t;
typedef short bf16x8 __attribute__((ext_vector_type(8)));
typedef float f32x4 __attribute__((ext_vector_type(4)));
typedef unsigned u32x4 __attribute__((ext_vector_type(4)));
constexpr int BM = 256, BK = 64, HALF = 128, HTB = HALF * BK * 2  , STAGE_BYTES = 8 * HTB, NXCD = 8, WGM = 8;

__host__ __device__ __forceinline__ int lds_byte(int r, int c) { const int st = (r >> 4) * 2 + (c >> 5), rr = r & 15, cc = c & 31, ob = rr * 64 + cc * 2; return st * 1024 + (ob ^ (((ob >> 9) & 1) << 5)); }
__host__ __device__ __forceinline__ void stage_rc(int b, int& R, int& C) { const int st = b / 1024, sb = b % 1024, swz = sb ^ (((sb >> 9) & 1) << 5); R = (st >> 1) * 16 + swz / 64; C = (st & 1) * 32 + (swz % 64) / 2; }
__host__ __device__ __forceinline__ int perm32(int rho) { const int n = rho >> 4, i = rho & 15; return 8 * (i >> 2) + 4 * n + (i & 3); }

struct Unit { int pm, pn; };
struct Gemm { const bf16_t* A; const bf16_t* Bt; int M, N, K; };

struct StaticOrder {
    int nM, nN, nwg, G, c;
    __host__ __device__ void init(int M, int N, int G_, int c_) { nM = M / BM; nN = N / BM; nwg = nM * nN; G = G_; c = c_; }
    __host__ __device__ bool next(int i, Unit& u) const {
        const long L = (long)i * G + c; if (L >= nwg) return false;
        int wgid = (int)L; { const int q = nwg / NXCD, r = nwg % NXCD, xcd = wgid % NXCD, off = wgid / NXCD; wgid = (xcd < r ? xcd * (q + 1) : r * (q + 1) + (xcd - r) * q) + off; }
        const int nig = WGM * nN, gid = wgid / nig, fm = gid * WGM, gsz = (nM - fm) < WGM ? (nM - fm) : WGM;
        u.pm = fm + ((wgid % nig) % gsz); u.pn = (wgid % nig) / gsz; return true;
    }
    __device__ __forceinline__ void a_ready(const Unit&) const {}
    __device__ __forceinline__ void done(const Unit&) const {}
};

__device__ __forceinline__ unsigned cvt_pk_bf16(float lo, float hi) { unsigned r; asm volatile("v_cvt_pk_bf16_f32 %0, %1, %2" : "=v"(r) : "v"(lo), "v"(hi)); return r; }
template <int ACT> struct EpiBf16 {
    static constexpr bool PERM = true, AFTER_DRAIN = false;
    bf16_t* O; int ldc; int split_cols; size_t split_stride; float scale0;
    const float* ss; const float* sw; int sw_stride; int rows_per_batch;
    bf16_t* cu_out; int cu_from;
    float* nrm;
    __device__ __forceinline__ void operator()(const f32x4 (&acc)[2][2][4][2], const Unit& u, int wr, int wc, int fr, int fq) const {
        const int row0 = u.pm * BM + wr * 64 + fr; int colt = u.pn * BM; bf16_t* base = O;
        const bool do_nrm = nrm != nullptr && u.pn < 16;
        float sc = 1.f; if (split_cols) { const int t = colt / split_cols; base += (size_t)t * split_stride; colt -= t * split_cols; if (t == 0) sc = scale0; }
        const int col0 = colt + wc * 32 + 8 * fq;
        f32x4 swv[2][2];
        if (ss) { const float* swp = sw + (size_t)((u.pm * BM) / rows_per_batch) * sw_stride + u.pn * BM + wc * 32 + 8 * fq;
#pragma unroll
            for (int bj = 0; bj < 2; ++bj)
#pragma unroll
                for (int n = 0; n < 2; ++n) swv[bj][n] = *(const f32x4*)(swp + bj * HALF + 4 * n); }
#pragma unroll
        for (int ai = 0; ai < 2; ++ai)
#pragma unroll
            for (int m = 0; m < 4; ++m) { const int row = row0 + ai * HALF + m * 16; bf16_t* rowp = base + (size_t)row * ldc + col0;
                float inv = 1.f;
                if (ss) { const f32x4* sp = (const f32x4*)(ss + (size_t)row * 32 + fq * 8); const f32x4 p0 = sp[0], p1 = sp[1];
                    float s = ((p0[0] + p0[1]) + (p0[2] + p0[3])) + ((p1[0] + p1[1]) + (p1[2] + p1[3]));
                    s += __shfl_xor(s, 16); s += __shfl_xor(s, 32); inv = 1.0f / sqrtf(s * (1.f / 2048.f) + 1e-6f); }
                f32x4 va[2][2];
#pragma unroll
                for (int bj = 0; bj < 2; ++bj) { f32x4 v0 = acc[ai][bj][m][0], v1 = acc[ai][bj][m][1];
                    if (ss) { v0 = v0 * inv + swv[bj][0]; v1 = v1 * inv + swv[bj][1]; }
                    if (ACT == 2) { v0 = __builtin_elementwise_max(v0, (f32x4){0.f, 0.f, 0.f, 0.f}); v1 = __builtin_elementwise_max(v1, (f32x4){0.f, 0.f, 0.f, 0.f}); v0 = v0 * v0; v1 = v1 * v1; }
                    v0 = v0 * sc; v1 = v1 * sc;
                    if (do_nrm) { float s2 = ((v0[0] * v0[0] + v0[1] * v0[1]) + (v0[2] * v0[2] + v0[3] * v0[3])) + ((v1[0] * v1[0] + v1[1] * v1[1]) + (v1[2] * v1[2] + v1[3] * v1[3]));
                        s2 += __shfl_xor(s2, 16); s2 += __shfl_xor(s2, 32);
                        if (fq == 0) nrm[((size_t)(((u.pn >> 3) * 4 + (row >> 12)) * 16 + (u.pn & 7) * 2 + bj) * 4096 + (row & 4095)) * 4 + wc] = s2; }
                    va[bj][0] = v0; va[bj][1] = v1; }
                if (cu_out != nullptr && u.pn >= cu_from) {
                    const f32x4 p0 = va[0][0] * va[1][0], p1 = va[0][1] * va[1][1];
                    u32x4 w; w.x = cvt_pk_bf16(p0[0], p0[1]); w.y = cvt_pk_bf16(p0[2], p0[3]); w.z = cvt_pk_bf16(p1[0], p1[1]); w.w = cvt_pk_bf16(p1[2], p1[3]);
                    *(u32x4*)(cu_out + (size_t)row * ldc + (u.pn - cu_from) * HALF + wc * 32 + 8 * fq) = w;
                } else {
#pragma unroll
                    for (int bj = 0; bj < 2; ++bj) { const f32x4 v0 = va[bj][0], v1 = va[bj][1];
                        u32x4 w; w.x = cvt_pk_bf16(v0[0], v0[1]); w.y = cvt_pk_bf16(v0[2], v0[3]); w.z = cvt_pk_bf16(v1[0], v1[1]); w.w = cvt_pk_bf16(v1[2], v1[3]);
                        *(u32x4*)(rowp + bj * HALF) = w; } } }
    }
};
struct EpiRes {
    static constexpr bool PERM = true, AFTER_DRAIN = false;
    const float* base32; const bf16_t* base16; float* out32; bf16_t* out16; int ldc; const float* gate; int rows_per_batch; int gate_stride;
    bf16_t* An; const float* n_gain; const float* n_scale; float* ss;
    __device__ __forceinline__ void operator()(const f32x4 (&acc)[2][2][4][2], const Unit& u, int wr, int wc, int fr, int fq) const {
        const int bidx = (u.pm * BM) / rows_per_batch; const float* g = gate + (size_t)bidx * gate_stride;
        const int col0 = u.pn * BM + wc * 32 + 8 * fq;
        f32x4 gv[2][2], cav[2][2];
#pragma unroll
        for (int bj = 0; bj < 2; ++bj)
#pragma unroll
            for (int n = 0; n < 2; ++n) { gv[bj][n] = *(const f32x4*)(g + col0 + bj * HALF + 4 * n);
                if (An) cav[bj][n] = *(const f32x4*)(n_gain + col0 + bj * HALF + 4 * n) * (*(const f32x4*)(n_scale + (size_t)bidx * gate_stride + col0 + bj * HALF + 4 * n) + 1.f); }
#pragma unroll
        for (int h = 0; h < 4; ++h) { const int ai = h >> 1, m0 = (h & 1) * 2;
            f32x4 pre[2][2][2];
            if (base32) {
#pragma unroll
                for (int mm = 0; mm < 2; ++mm) { const size_t off = (size_t)(u.pm * BM + ai * HALF + wr * 64 + (m0 + mm) * 16 + fr) * ldc + col0;
#pragma unroll
                    for (int bj = 0; bj < 2; ++bj)
#pragma unroll
                        for (int n = 0; n < 2; ++n) pre[mm][bj][n] = *(const f32x4*)(base32 + off + bj * HALF + 4 * n); }
            } else { u32x4 raw[2][2];
#pragma unroll
                for (int mm = 0; mm < 2; ++mm) { const size_t off = (size_t)(u.pm * BM + ai * HALF + wr * 64 + (m0 + mm) * 16 + fr) * ldc + col0;
#pragma unroll
                    for (int bj = 0; bj < 2; ++bj) raw[mm][bj] = *(const u32x4*)(base16 + off + bj * HALF); }
#pragma unroll
                for (int mm = 0; mm < 2; ++mm)
#pragma unroll
                    for (int bj = 0; bj < 2; ++bj) { const u32x4 w = raw[mm][bj];
                        pre[mm][bj][0] = (f32x4){__uint_as_float(w.x << 16), __uint_as_float(w.x & 0xffff0000u), __uint_as_float(w.y << 16), __uint_as_float(w.y & 0xffff0000u)};
                        pre[mm][bj][1] = (f32x4){__uint_as_float(w.z << 16), __uint_as_float(w.z & 0xffff0000u), __uint_as_float(w.w << 16), __uint_as_float(w.w & 0xffff0000u)}; } }
#pragma unroll
            for (int mm = 0; mm < 2; ++mm) { const int m = m0 + mm; const int row = u.pm * BM + ai * HALF + wr * 64 + m * 16 + fr; const size_t off = (size_t)row * ldc + col0;
                float ssum = 0.f;
#pragma unroll
                for (int bj = 0; bj < 2; ++bj) { f32x4 o[2];
#pragma unroll
                    for (int n = 0; n < 2; ++n) { o[n] = pre[mm][bj][n] + gv[bj][n] * acc[ai][bj][m][n];
                        ssum += (o[n][0] * o[n][0] + o[n][1] * o[n][1]) + (o[n][2] * o[n][2] + o[n][3] * o[n][3]); }
                    if (out32) { *(f32x4*)(out32 + off + bj * HALF) = o[0]; *(f32x4*)(out32 + off + bj * HALF + 4) = o[1]; }
                    else { u32x4 w; w.x = cvt_pk_bf16(o[0][0], o[0][1]); w.y = cvt_pk_bf16(o[0][2], o[0][3]); w.z = cvt_pk_bf16(o[1][0], o[1][1]); w.w = cvt_pk_bf16(o[1][2], o[1][3]); *(u32x4*)(out16 + off + bj * HALF) = w; }
                    if (An) { const f32x4 a0 = o[0] * cav[bj][0], a1 = o[1] * cav[bj][1]; u32x4 w; w.x = cvt_pk_bf16(a0[0], a0[1]); w.y = cvt_pk_bf16(a0[2], a0[3]); w.z = cvt_pk_bf16(a1[0], a1[1]); w.w = cvt_pk_bf16(a1[2], a1[3]);
                        *(u32x4*)(An + off + bj * HALF) = w; } }
                if (An) { ssum += __shfl_xor(ssum, 16); ssum += __shfl_xor(ssum, 32); if (fq == 0) ss[(size_t)row * 32 + u.pn * 4 + wc] = ssum; } }
            asm volatile("" ::: "memory");
        }
    }
};
struct EpiNull {
    static constexpr bool PERM = true, AFTER_DRAIN = false; bf16_t* O;
    __device__ __forceinline__ void operator()(const f32x4 (&acc)[2][2][4][2], const Unit& u, int wr, int wc, int fr, int fq) const {
        float s = 0.f;
#pragma unroll
        for (int ai = 0; ai < 2; ++ai)
#pragma unroll
            for (int bj = 0; bj < 2; ++bj)
#pragma unroll
                for (int m = 0; m < 4; ++m)
#pragma unroll
                    for (int n = 0; n < 2; ++n) s += acc[ai][bj][m][n][0] + acc[ai][bj][m][n][1] + acc[ai][bj][m][n][2] + acc[ai][bj][m][n][3];
        if (s == 1.2345e-30f) O[0] = 1;
    }
};
struct EpiCoal {
    static constexpr bool PERM = true, AFTER_DRAIN = false; bf16_t* O;
    __device__ __forceinline__ void operator()(const f32x4 (&acc)[2][2][4][2], const Unit& u, int wr, int wc, int fr, int fq) const {
        bf16_t* base = O + ((size_t)((u.pm * 32 + u.pn) & 511) * 65536) + (size_t)(wr * 4 + wc) * 8192 + (size_t)(fq * 16 + fr) * 8;
#pragma unroll
        for (int ai = 0; ai < 2; ++ai)
#pragma unroll
            for (int m = 0; m < 4; ++m)
#pragma unroll
                for (int bj = 0; bj < 2; ++bj) { f32x4 v0 = acc[ai][bj][m][0], v1 = acc[ai][bj][m][1];
                    v0 = __builtin_elementwise_max(v0, (f32x4){0.f, 0.f, 0.f, 0.f}); v1 = __builtin_elementwise_max(v1, (f32x4){0.f, 0.f, 0.f, 0.f}); v0 = v0 * v0; v1 = v1 * v1;
                    u32x4 w; w.x = cvt_pk_bf16(v0[0], v0[1]); w.y = cvt_pk_bf16(v0[2], v0[3]); w.z = cvt_pk_bf16(v1[0], v1[1]); w.w = cvt_pk_bf16(v1[2], v1[3]);
                    *(u32x4*)(base + (size_t)((ai * 4 + m) * 2 + bj) * 512) = w; }
    }
};
template <class Epi, class Sched, bool ALIGN_EPI = false, bool SP2 = false>
__device__ __forceinline__ void gemm_phase(PG8_LAS unsigned char* lds, const Gemm g, const Sched& S, const Epi& E) {
    const int tid = tidx(), wid = __builtin_amdgcn_readfirstlane(tid >> 6), lane = tid & 63, wr = wid >> 2, wc = wid & 3, fr = lane & 15, fq = lane >> 4;
    const int K = g.K, nt = K / BK;
    unsigned voffA[2], voffB[2];
#pragma unroll
    for (int i = 0; i < 2; ++i) { int R, C; stage_rc(tid * 16 + i * 8192, R, C); const int Rb = Epi::PERM ? ((R & ~31) + perm32(R & 31)) : R;
        voffA[i] = (unsigned)(R * K + C) * 2u; voffB[i] = (unsigned)(Rb * K + C) * 2u; }
    const size_t kstep = (size_t)(BK * 2);
    const size_t hstep = (size_t)HALF * K * 2;
    const size_t tstep = 2 * hstep;
    const unsigned ldsw = (unsigned)wid * 1024u;
    const int aoff = lds_byte(wr * 64 + fr, fq * 8), boff = lds_byte(wc * 32 + fr, fq * 8);
#define PG8_SA(b, h) (((b) * 2 + (h)) * HTB)
#define PG8_SB(b, h) ((4 + (b) * 2 + (h)) * HTB)
#define PG8_STAGE(bufoff, gbase, voff) do { _Pragma("unroll") for (int _i = 0; _i < 2; ++_i) \
        __builtin_amdgcn_global_load_lds((const unsigned*)((const char*)(gbase) + (voff)[_i]), (PG8_LAS unsigned*)(lds + (bufoff) + ldsw + _i * 8192), 16, 0, 0); } while (0)
#define PG8_LDA(dst, b, h) do { _Pragma("unroll") for (int m = 0; m < 4; ++m) _Pragma("unroll") for (int k = 0; k < 2; ++k) dst[m][k] = *(const PG8_LAS bf16x8*)(lds + PG8_SA(b, h) + aoff + m * 2048 + k * 1024); } while (0)
#define PG8_LDB(dst, b, h) do { _Pragma("unroll") for (int n = 0; n < 2; ++n) _Pragma("unroll") for (int k = 0; k < 2; ++k) dst[n][k] = *(const PG8_LAS bf16x8*)(lds + PG8_SB(b, h) + boff + n * 2048 + k * 1024); } while (0)
#define PG8_MMA(ai, bj, At, Bt) do { __builtin_amdgcn_s_setprio(1); _Pragma("unroll") for (int m = 0; m < 4; ++m) _Pragma("unroll") for (int n = 0; n < 2; ++n) _Pragma("unroll") for (int k = 0; k < 2; ++k) \
        acc[ai][bj][m][n] = __builtin_amdgcn_mfma_f32_16x16x32_bf16(Bt[n][k], At[m][k], acc[ai][bj][m][n], 0, 0, 0); __builtin_amdgcn_s_setprio(0); } while (0)
#define PG8_WAIT_V(n) asm volatile("s_waitcnt vmcnt(" #n ")" ::: "memory")
#define PG8_WAIT_L(n) asm volatile("s_waitcnt lgkmcnt(" #n ")" ::: "memory")
#define PG8_BAR __builtin_amdgcn_s_barrier()
#define PG8_SCHED __builtin_amdgcn_sched_barrier(0)
    Unit cur, nxt; int ui = 0;
    if (!S.next(0, cur)) return;
    f32x4 acc[2][2][4][2];
#pragma unroll
    for (int a = 0; a < 2; ++a)
#pragma unroll
        for (int b = 0; b < 2; ++b)
#pragma unroll
            for (int m = 0; m < 4; ++m)
#pragma unroll
                for (int n = 0; n < 2; ++n) acc[a][b][m][n] = (f32x4){0.f, 0.f, 0.f, 0.f};
    bf16x8 At[4][2], B0[2][2], B1[2][2];
    const char* cA = (const char*)g.A + (size_t)cur.pm * tstep; const char* cB = (const char*)g.Bt + (size_t)cur.pn * tstep;
    S.a_ready(cur);
    if constexpr (SP2) {
        PG8_STAGE(PG8_SB(0, 0), cB, voffB); PG8_STAGE(PG8_SB(0, 1), cB + hstep, voffB); PG8_STAGE(PG8_SA(0, 0), cA, voffA); PG8_STAGE(PG8_SA(0, 1), cA + hstep, voffA);
        if (wr == 1) PG8_BAR;
        PG8_WAIT_V(2); PG8_BAR;
        PG8_STAGE(PG8_SB(1, 0), cB + kstep, voffB); PG8_STAGE(PG8_SA(1, 0), cA + kstep, voffA); PG8_STAGE(PG8_SB(1, 1), cB + hstep + kstep, voffB);
        PG8_WAIT_V(6); PG8_BAR;
    } else {
        PG8_STAGE(PG8_SB(0, 0), cB, voffB); PG8_STAGE(PG8_SA(0, 0), cA, voffA); PG8_STAGE(PG8_SB(0, 1), cB + hstep, voffB); PG8_STAGE(PG8_SA(0, 1), cA + hstep, voffA);
        if (wr == 1) PG8_BAR;
        PG8_WAIT_V(4); PG8_BAR;
        PG8_STAGE(PG8_SB(1, 0), cB + kstep, voffB); PG8_STAGE(PG8_SA(1, 0), cA + kstep, voffA); PG8_STAGE(PG8_SB(1, 1), cB + hstep + kstep, voffB);
        PG8_WAIT_V(6); PG8_BAR;
    }
    for (;;) {
        const bool has_next = S.next(ui + 1, nxt);
        const char* nA = has_next ? (const char*)g.A + (size_t)nxt.pm * tstep : cA; const char* nB = has_next ? (const char*)g.Bt + (size_t)nxt.pn * tstep : cB;
        for (int t = 0; t < nt; t += 2) {
            const bool last = (t == nt - 2);
            const char* a1 = cA + (size_t)(t + 1) * kstep;
            const char* a2 = last ? nA : cA + (size_t)(t + 2) * kstep; const char* b2 = last ? nB : cB + (size_t)(t + 2) * kstep;
            const char* a3 = a2 + kstep; const char* b3 = b2 + kstep;
            if (last && has_next) S.a_ready(nxt);
            if constexpr (SP2) {
            PG8_LDB(B0, 0, 0); PG8_LDB(B1, 0, 1); PG8_SCHED; PG8_LDA(At, 0, 0); PG8_STAGE(PG8_SA(1, 1), a1 + hstep, voffA);
            PG8_WAIT_V(8); PG8_WAIT_L(0); PG8_BAR; PG8_MMA(0, 0, At, B0); PG8_MMA(0, 1, At, B1); PG8_BAR; PG8_SCHED;
            PG8_LDA(At, 0, 1); PG8_STAGE(PG8_SB(0, 0), b2, voffB); PG8_STAGE(PG8_SB(0, 1), b2 + hstep, voffB); PG8_STAGE(PG8_SA(0, 0), a2, voffA);
            PG8_WAIT_V(8); PG8_WAIT_L(0); PG8_BAR; PG8_MMA(1, 0, At, B0); PG8_MMA(1, 1, At, B1); PG8_BAR; PG8_SCHED;
            PG8_LDB(B0, 1, 0); PG8_LDB(B1, 1, 1); PG8_SCHED; PG8_LDA(At, 1, 0); PG8_STAGE(PG8_SA(0, 1), a2 + hstep, voffA);
            PG8_WAIT_V(8); PG8_WAIT_L(0); PG8_BAR; PG8_MMA(0, 0, At, B0); PG8_MMA(0, 1, At, B1); PG8_BAR; PG8_SCHED;
            PG8_LDA(At, 1, 1); PG8_STAGE(PG8_SB(1, 0), b3, voffB); PG8_STAGE(PG8_SB(1, 1), b3 + hstep, voffB); PG8_STAGE(PG8_SA(1, 0), a3, voffA);
            PG8_WAIT_V(8); PG8_WAIT_L(0); PG8_BAR; PG8_MMA(1, 0, At, B0); PG8_MMA(1, 1, At, B1); PG8_BAR; PG8_SCHED;
            } else {
            PG8_LDB(B0, 0, 0); PG8_SCHED; PG8_LDA(At, 0, 0); PG8_STAGE(PG8_SA(1, 1), a1 + hstep, voffA);
            PG8_WAIT_L(8); PG8_BAR; PG8_WAIT_L(0); PG8_MMA(0, 0, At, B0); PG8_BAR; PG8_SCHED;
            PG8_LDB(B1, 0, 1); PG8_STAGE(PG8_SB(0, 0), b2, voffB);
            PG8_BAR; PG8_WAIT_L(0); PG8_MMA(0, 1, At, B1); PG8_BAR;
            PG8_LDA(At, 0, 1); PG8_STAGE(PG8_SA(0, 0), a2, voffA);
            PG8_BAR; PG8_WAIT_L(0); PG8_MMA(1, 0, At, B0); PG8_BAR; PG8_SCHED;
            PG8_STAGE(PG8_SB(0, 1), b2 + hstep, voffB);
            PG8_WAIT_V(6); PG8_BAR; PG8_MMA(1, 1, At, B1); PG8_BAR;
            PG8_LDB(B0, 1, 0); PG8_SCHED; PG8_LDA(At, 1, 0); PG8_STAGE(PG8_SA(0, 1), a2 + hstep, voffA);
            PG8_WAIT_L(8); PG8_BAR; PG8_WAIT_L(0); PG8_MMA(0, 0, At, B0); PG8_BAR; PG8_SCHED;
            PG8_LDB(B1, 1, 1); PG8_STAGE(PG8_SB(1, 0), b3, voffB);
            PG8_BAR; PG8_WAIT_L(0); PG8_MMA(0, 1, At, B1); PG8_BAR;
            PG8_LDA(At, 1, 1); PG8_STAGE(PG8_SA(1, 0), a3, voffA);
            PG8_BAR; PG8_WAIT_L(0); PG8_MMA(1, 0, At, B0); PG8_BAR; PG8_SCHED;
            PG8_STAGE(PG8_SB(1, 1), b3 + hstep, voffB);
            PG8_WAIT_V(6); PG8_BAR; PG8_MMA(1, 1, At, B1); PG8_BAR;
            }
        }
        if constexpr (ALIGN_EPI) { if (wr == 0) PG8_BAR; }
        if constexpr (!Epi::AFTER_DRAIN) { E(acc, cur, wr, wc, fr, fq); S.done(cur); }
        if (!has_next) break;
#pragma unroll
        for (int a = 0; a < 2; ++a)
#pragma unroll
            for (int b = 0; b < 2; ++b)
#pragma unroll
                for (int m = 0; m < 4; ++m)
#pragma unroll
                    for (int n = 0; n < 2; ++n) acc[a][b][m][n] = (f32x4){0.f, 0.f, 0.f, 0.f};
        cur = nxt; cA = nA; cB = nB; ++ui;
        if constexpr (ALIGN_EPI) { if (wr == 1) PG8_BAR; }
    }
    PG8_WAIT_V(0);
    if constexpr (!ALIGN_EPI) { if (wr == 0) PG8_BAR; }
    PG8_BAR;
    if constexpr (Epi::AFTER_DRAIN) { E.fused(acc, cur, wr, wc, fr, fq, lds, wid, lane); S.done(cur); }
#undef PG8_SA
#undef PG8_SB
#undef PG8_STAGE
#undef PG8_LDA
#undef PG8_LDB
#undef PG8_MMA
#undef PG8_WAIT_V
#undef PG8_WAIT_L
#undef PG8_BAR
#undef PG8_SCHED
}
}
namespace att {
enum { ORDER_NATURAL = 0, ORDER_REVERSED = 1, ORDER_PAIRED = 2, ORDER_XCD = 4 };
constexpr int D = 128, PITCH = 2048;
constexpr float THR = 8.f;
constexpr bool WSKIP = false;
constexpr int NW = 8, QBLK = 32, KVBLK = 64, QB = NW * QBLK;
constexpr int SHM_V = KVBLK * D * 2, SHM_K = KVBLK * D * 2;
constexpr int LDS_BYTES = 2 * SHM_V + 2 * SHM_K + NW * 64 * 4;


using bf16 = __hip_bfloat16;
typedef short bf16x8 __attribute__((ext_vector_type(8)));
typedef short s16x4 __attribute__((ext_vector_type(4)));
typedef float f32x16 __attribute__((ext_vector_type(16)));
typedef float f32x4 __attribute__((ext_vector_type(4)));
typedef unsigned u32x4 __attribute__((ext_vector_type(4)));
template <class A, class Bt> struct same_t { static constexpr bool v = false; };
template <class A> struct same_t<A, A> { static constexpr bool v = true; };

#define KSWZ(row, colB) ((row) * 256 + ((colB) ^ (((row) & 7) << 4)))
#define SBAR() __builtin_amdgcn_sched_barrier(0)
__device__ __forceinline__ int v_st(int k, int c) { const int kk = (k & ~0xC) | ((k & 4) << 1) | ((k & 8) >> 1); return ((kk >> 3) * 4 + (c >> 5)) * 512 + ((kk & 7) * 32 + (c & 31)) * 2; }
__device__ __forceinline__ int v_rd_base(int lane) { return ((lane & 3) << 3) | (((lane >> 2) & 3) << 6) | (((lane >> 4) & 1) << 5) | (((lane >> 5) & 1) << 8); }
constexpr int v_rd_off(int d0, int ks, int half) { return d0 * 512 + ks * 4096 + half * 2048; }
__device__ __forceinline__ int crow(int r, int hi) { return (r & 3) + 8 * (r >> 2) + 4 * hi; }
__device__ __forceinline__ unsigned cvtpk(float lo, float hi) {
    unsigned r; asm volatile("v_cvt_pk_bf16_f32 %0, %1, %2" : "=v"(r) : "v"(lo), "v"(hi)); return r;
}
__device__ __forceinline__ bf16x8 pack8(f32x4 a, f32x4 b) {
    u32x4 w = {cvtpk(a[0], a[1]), cvtpk(a[2], a[3]), cvtpk(b[0], b[1]), cvtpk(b[2], b[3])};
    return *reinterpret_cast<bf16x8*>(&w);
}
template <class T> __device__ __forceinline__ bf16x8 load8(const T* p) {
    if constexpr (same_t<T, float>::v) { return pack8(*(const f32x4*)p, *(const f32x4*)(p + 4)); }
    else { return *reinterpret_cast<const bf16x8*>(p); }
}
__device__ __forceinline__ void mask_tile(f32x16& p0, f32x16& p1, int dq, unsigned W) {
    const float NEG = -__builtin_inff();
#pragma unroll
    for (int r = 0; r < 16; ++r) {
        const int c = (r & 3) + 8 * (r >> 2);
        if ((unsigned)(dq - c) >= W) p0[r] = NEG;
        if ((unsigned)(dq - c - 32) >= W) p1[r] = NEG;
    }
}
__device__ __forceinline__ void partialSM(f32x16& p0, f32x16& p1, float& m_reg, float& mn, float& alpha) {
    float pmax = p0[0]; for (int r = 1; r < 16; ++r) pmax = fmaxf(pmax, p0[r]); for (int r = 0; r < 16; ++r) pmax = fmaxf(pmax, p1[r]);
    { auto rr = __builtin_amdgcn_permlane32_swap(__float_as_uint(pmax), __float_as_uint(pmax), false, false);
      pmax = fmaxf(__uint_as_float(rr[0]), __uint_as_float(rr[1])); }
    if (__builtin_expect(__all((pmax - m_reg) <= THR), 1)) { mn = m_reg; alpha = 1.f; }
    else { mn = fmaxf(m_reg, pmax); alpha = __builtin_amdgcn_exp2f(m_reg - mn); m_reg = mn; }
    for (int r = 0; r < 16; ++r) p0[r] = p0[r] - mn; for (int r = 0; r < 16; ++r) p1[r] = p1[r] - mn;
    for (int r = 0; r < 16; ++r) p0[r] = __builtin_amdgcn_exp2f(p0[r]);
}
__device__ __forceinline__ void finishSM(f32x16& p0, f32x16& p1, float alpha, float& l_reg, bf16x8& pa0, bf16x8& pa1, bf16x8& pa2, bf16x8& pa3) {
    for (int r = 0; r < 16; ++r) p1[r] = __builtin_amdgcn_exp2f(p1[r]);
    float ps = 0; for (int r = 0; r < 16; ++r) ps += p0[r]; for (int r = 0; r < 16; ++r) ps += p1[r];
    { auto rr = __builtin_amdgcn_permlane32_swap(__float_as_uint(ps), __float_as_uint(ps), false, false);
      ps = __uint_as_float(rr[0]) + __uint_as_float(rr[1]); }
    l_reg = l_reg * alpha + ps;
#define PK4(P, B_, OUT) do { unsigned a0 = cvtpk(P[B_+0], P[B_+1]), a1 = cvtpk(P[B_+2], P[B_+3]);                          \
        unsigned b0 = cvtpk(P[B_+4], P[B_+5]), b1 = cvtpk(P[B_+6], P[B_+7]);                                             \
        auto r0 = __builtin_amdgcn_permlane32_swap(a0, b0, false, false); auto r1 = __builtin_amdgcn_permlane32_swap(a1, b1, false, false); \
        u32x4 w = {r0[0], r1[0], r0[1], r1[1]}; OUT = *reinterpret_cast<bf16x8*>(&w); } while (0)
    PK4(p0, 0, pa0); PK4(p0, 8, pa1); PK4(p1, 0, pa2); PK4(p1, 8, pa3);
#undef PK4
}
template <int KB, bool SK>
__device__ __forceinline__ void qkt(f32x16& p0, f32x16& p1, const char* K_lds, int r32, int hi, const bf16x8* qr, bool act, const char* Ft) {
    if (SK && !act) { const float NEG = -__builtin_inff();
#pragma unroll
        for (int r = 0; r < 16; ++r) { p0[r] = NEG; p1[r] = NEG; } return; }
    { const f32x4* fp = (const f32x4*)Ft;
      const f32x4 a0 = fp[0], a1 = fp[2], a2 = fp[4], a3 = fp[6], b0_ = fp[8], b1_ = fp[10], b2_ = fp[12], b3_ = fp[14];
      p0 = (f32x16){a0[0], a0[1], a0[2], a0[3], a1[0], a1[1], a1[2], a1[3], a2[0], a2[1], a2[2], a2[3], a3[0], a3[1], a3[2], a3[3]};
      p1 = (f32x16){b0_[0], b0_[1], b0_[2], b0_[3], b1_[0], b1_[1], b1_[2], b1_[3], b2_[0], b2_[1], b2_[2], b2_[3], b3_[0], b3_[1], b3_[2], b3_[3]}; }
    const char* kb[4];
#pragma unroll
    for (int dd = 0; dd < 4; ++dd) kb[dd] = K_lds + KB * SHM_K + KSWZ(r32, (dd * 16 + hi * 8) * 2);
#pragma unroll
    for (int d0 = 0; d0 < 8; ++d0) { const char* a = kb[d0 & 3] + (d0 >> 2) * 128;
        bf16x8 b0 = *reinterpret_cast<const bf16x8*>(a);
        bf16x8 b1 = *reinterpret_cast<const bf16x8*>(a + 32 * 256);
        p0 = __builtin_amdgcn_mfma_f32_32x32x16_bf16(b0, qr[d0], p0, 0, 0, 0);
        p1 = __builtin_amdgcn_mfma_f32_32x32x16_bf16(b1, qr[d0], p1, 0, 0, 0); }
}
template <int VB, bool SK>
__device__ __forceinline__ void pv_tile(f32x16* o, int vb0, bf16x8 pa0, bf16x8 pa1, bf16x8 pa2, bf16x8 pa3, bool act) {
    if (SK && !act) return;
#define TRRD(dst, off) asm volatile("ds_read_b64_tr_b16 %0, %1 offset:%2" : "=&v"(dst) : "v"(vb0), "i"(off) : "memory")
#define PV_D0(d0) do { s16x4 l0, l1, l2, l3, h0, h1, h2, h3; constexpr int b_ = VB * SHM_V + v_rd_off(d0, 0, 0);     \
        TRRD(l0, b_); TRRD(h0, b_ + 2048); TRRD(l1, b_ + 4096); TRRD(h1, b_ + 6144); TRRD(l2, b_ + 8192); TRRD(h2, b_ + 10240); TRRD(l3, b_ + 12288); TRRD(h3, b_ + 14336); \
        asm volatile("s_waitcnt lgkmcnt(0)" ::: "memory"); SBAR();                 \
        o[d0] = __builtin_amdgcn_mfma_f32_32x32x16_bf16(pa0, (bf16x8){l0[0], l0[1], l0[2], l0[3], h0[0], h0[1], h0[2], h0[3]}, o[d0], 0, 0, 0);   \
        o[d0] = __builtin_amdgcn_mfma_f32_32x32x16_bf16(pa1, (bf16x8){l1[0], l1[1], l1[2], l1[3], h1[0], h1[1], h1[2], h1[3]}, o[d0], 0, 0, 0);   \
        o[d0] = __builtin_amdgcn_mfma_f32_32x32x16_bf16(pa2, (bf16x8){l2[0], l2[1], l2[2], l2[3], h2[0], h2[1], h2[2], h2[3]}, o[d0], 0, 0, 0);   \
        o[d0] = __builtin_amdgcn_mfma_f32_32x32x16_bf16(pa3, (bf16x8){l3[0], l3[1], l3[2], l3[3], h3[0], h3[1], h3[2], h3[3]}, o[d0], 0, 0, 0); } while (0)
    PV_D0(0); PV_D0(1); PV_D0(2); PV_D0(3);
#undef PV_D0
#undef TRRD
}

template <class TIn, class TOut> struct BlockRef { const TIn* Q; const TIn* K; const TIn* V; TOut* O; const float* F; int P0; int jlo; };
template <class TIn> struct Seam {
    bf16x8 qr[8];
    bf16x8 st_v0, st_v1, st_k0, st_k1; f32x4 sf0, sf1, sf2, sf3;
    f32x4 tq[16];
};
__device__ __forceinline__ int swa_jlo(int P0, int W) { const int lowk = P0 - W + 1; return lowk > 0 ? lowk / KVBLK : 0; }
#define ROW(p, k0, rr) ((p) + (size_t)((k0) + (rr)) * PITCH + sc)
#define VMW() asm volatile("s_waitcnt vmcnt(0)" ::: "memory")
#define VMWN(n) asm volatile("s_waitcnt vmcnt(%0)" :: "i"(n) : "memory")
#define GROW(p, k0, vo) ((const char*)((p) + (size_t)(k0) * PITCH) + (vo))
#define SLOAD_H(Kp, Vp, k0) do { S.st_v0 = *(const bf16x8*)GROW(Vp, k0, vo0); S.st_v1 = *(const bf16x8*)GROW(Vp, k0, vo1);              \
                         S.st_k0 = *(const bf16x8*)GROW(Kp, k0, vo0); S.st_k1 = *(const bf16x8*)GROW(Kp, k0, vo1); } while (0)
#define SWRITE_HK(bf) do { *(bf16x8*)(K_lds + (bf) * SHM_K + kws) = S.st_k0; *(bf16x8*)(K_lds + (bf) * SHM_K + kws + 32 * 256) = S.st_k1; } while (0)
#define SWRITE_HV(bf) do { *(bf16x8*)(V_lds + (bf) * SHM_V + vst0) = S.st_v0; *(bf16x8*)(V_lds + (bf) * SHM_V + vst1) = S.st_v1; } while (0)
#define SWRITE_H(bf) do { SWRITE_HV(bf); SWRITE_HK(bf); } while (0)
#define SLOAD_F(p, k0) do { S.sf0 = *(const f32x4*)ROW(p, k0, sr); S.sf1 = *(const f32x4*)(ROW(p, k0, sr) + 4);                \
                            S.sf2 = *(const f32x4*)ROW(p, k0, 32 + sr); S.sf3 = *(const f32x4*)(ROW(p, k0, 32 + sr) + 4); } while (0)
#define SWRITE_KF(bf) do { *(bf16x8*)(K_lds + (bf) * SHM_K + kws) = pack8(S.sf0, S.sf1); *(bf16x8*)(K_lds + (bf) * SHM_K + kws + 32 * 256) = pack8(S.sf2, S.sf3); } while (0)
#define SWRITE_VF(bf) do { *(bf16x8*)(V_lds + (bf) * SHM_V + vst0) = pack8(S.sf0, S.sf1); *(bf16x8*)(V_lds + (bf) * SHM_V + vst1) = pack8(S.sf2, S.sf3); } while (0)
template <class TIn, class TOut>
__device__ __forceinline__ void causal_swa_prime(const BlockRef<TIn, TOut>& cur, int W, char* lds, Seam<TIn>& S, char* Fdst) {
    constexpr bool F32 = same_t<TIn, float>::v;
    const int tid = tidx(), wid = __builtin_amdgcn_readfirstlane(tid >> 6), lane = tid & 63, r32 = lane & 31, hi = lane >> 5;
    const int sr = tid >> 4, sc = (tid & 15) * 8, kws = KSWZ(sr, sc * 2); char* K_lds = lds + 2 * SHM_V;
    const unsigned vo0 = (unsigned)(sr * PITCH + sc) * 2u, vo1 = vo0 + 32u * PITCH * 2u, qvo = (unsigned)(r32 * PITCH + hi * 8) * 2u;
    const int kb0 = cur.jlo * KVBLK;
    for (int d0 = 0; d0 < 8; ++d0) S.qr[d0] = __builtin_nontemporal_load((const bf16x8*)((const char*)(cur.Q + (size_t)(wid * QBLK) * PITCH) + qvo + d0 * 32));
    if constexpr (F32) { SLOAD_F((const float*)cur.K, kb0); VMW(); SWRITE_KF(0); SBAR(); SLOAD_F((const float*)cur.V, kb0); }
    else { const f32x4 fa = *(const f32x4*)(cur.F + tid * 4), fb = *(const f32x4*)(cur.F + 2048 + tid * 4);
           SLOAD_H(cur.K, cur.V, kb0); VMW(); SWRITE_HK(0);
           *(f32x4*)(Fdst + tid * 16) = fa; *(f32x4*)(Fdst + 8192 + tid * 16) = fb; }
    __syncthreads();
}
template <class TIn, class TOut>
__device__ __forceinline__ void causal_swa_block(const BlockRef<TIn, TOut>& cur, const BlockRef<TIn, TOut>& nxt, int skv, int W, char* lds, Seam<TIn>& S, const char* Fcur, char* Fnext) {
    constexpr bool F32 = same_t<TIn, float>::v;
    const int tid = tidx(), wid = __builtin_amdgcn_readfirstlane(tid >> 6), lane = tid & 63, r32 = lane & 31, hi = lane >> 5;
    const int j_lo = cur.jlo;
    int j_hi = (cur.P0 + QB - 1) / KVBLK + 1; if (j_hi > skv / KVBLK) j_hi = skv / KVBLK;
    const int NT = j_hi - j_lo;
    const int kbn = nxt.jlo * KVBLK;
    const int qlo = cur.P0 + wid * QBLK, qm = qlo + r32 - 4 * hi;
    char* V_lds = lds; char* K_lds = lds + 2 * SHM_V;
    float* ws = (float*)(lds + 2 * SHM_V + 2 * SHM_K) + wid * 64; float* li_l = ws, * al_l = ws + 32;
    float m_reg = *(const float*)(Fcur + (size_t)(cur.P0 + wid * QBLK + r32) * 4), l_reg = 0; f32x16 o[4] = {};
    const unsigned vo0 = (unsigned)((tid >> 4) * PITCH + (tid & 15) * 8) * 2u, vo1 = vo0 + 32u * PITCH * 2u, qvo = (unsigned)(r32 * PITCH + hi * 8) * 2u;
    const int sr = tid >> 4, sc = (tid & 15) * 8, vst0 = v_st(sr, sc), vst1 = v_st(32 + sr, sc), kws = KSWZ(sr, sc * 2);
    const int vb0 = (int)(uintptr_t)V_lds + v_rd_base(lane);
    const TIn* Kh = cur.K; const TIn* Vh = cur.V;
#define RESC(a) do { if (__any((a) < 1.f)) { if (hi == 0) al_l[r32] = (a); asm volatile("s_waitcnt lgkmcnt(0)" ::: "memory");              \
                     for (int d_ = 0; d_ < 4; ++d_) for (int r = 0; r < 16; ++r) o[d_][r] *= al_l[crow(r, hi)]; } } while (0)
#define KBASE(t) ((j_lo + (t)) * KVBLK)
#define ACT(t) (KBASE(t) <= qlo + QBLK - 1 && KBASE(t) + KVBLK - 1 >= qlo - W + 1)
#define MASKT(P0_, P1_, t) do { const int kb_ = KBASE(t); if ((!SK || ACT(t)) && (kb_ + KVBLK - 1 > qlo || kb_ <= qlo + QBLK - 1 - W)) mask_tile(P0_, P1_, qm - kb_, (unsigned)W); } while (0)
    constexpr int NQL = F32 ? 16 : 8;
    constexpr bool SK = WSKIP && !F32;
#define SEAM_K0() do { VMWN(NQL); if constexpr (F32) { SWRITE_KF(0); SBAR(); SLOAD_F((const float*)nxt.V, kbn); } else { SWRITE_HK(0); } SBAR(); } while (0)
    f32x16 pA0, pA1, pB0, pB1; float mnA, mnB, alA, alB; bf16x8 pa0, pa1, pa2, pa3;
    if constexpr (F32) { VMW(); SWRITE_VF(0); SBAR(); } else { SWRITE_HV(0); SBAR(); }
    if (NT > 1) { if constexpr (F32) SLOAD_F((const float*)Kh, KBASE(1)); else SLOAD_H(Kh, Vh, KBASE(1)); }
    SBAR(); qkt<0, SK>(pA0, pA1, K_lds, r32, hi, S.qr, ACT(0), Fcur + KBASE(0) * 4 + hi * 16);
    if constexpr (F32) { if (NT > 1) { VMW(); SWRITE_KF(1); SBAR(); SLOAD_F((const float*)Vh, KBASE(1)); } }
    MASKT(pA0, pA1, 0); partialSM(pA0, pA1, m_reg, mnA, alA);
    if (NT > 1) { VMW(); if constexpr (F32) { SWRITE_VF(1); SBAR(); if (NT > 2) SLOAD_F((const float*)Kh, KBASE(2)); } else SWRITE_H(1); }
    __syncthreads();
#define HALF_STEP(PX0, PX1, mnX, alX, PY0, PY1, alY, t, KB, VB, SB) do {                                                      \
        SBAR(); qkt<KB, SK>(PX0, PX1, K_lds, r32, hi, S.qr, ACT(t), Fcur + KBASE(t) * 4 + hi * 16);                                             \
        finishSM(PY0, PY1, alY, l_reg, pa0, pa1, pa2, pa3); SBAR();                                                           \
        if ((t) + 1 < NT) { if constexpr (F32) { VMW(); SWRITE_KF(SB); SBAR(); SLOAD_F((const float*)Vh, KBASE((t) + 1)); }  \
                            else { SLOAD_H(Kh, Vh, KBASE((t) + 1)); } SBAR(); }                                               \
        pv_tile<VB, SK>(o, vb0, pa0, pa1, pa2, pa3, ACT((t) - 1)); MASKT(PX0, PX1, (t)); partialSM(PX0, PX1, m_reg, mnX, alX);                                        \
        __syncthreads();                                                                                                      \
        if ((t) + 1 < NT) { VMW(); if constexpr (F32) { SWRITE_VF(SB); SBAR(); if ((t) + 2 < NT) SLOAD_F((const float*)Kh, KBASE((t) + 2)); } \
                            else { SWRITE_H(SB); } }                                                                          \
        RESC(alX); __syncthreads(); } while (0)
    for (int t = 1; t + 1 < NT; t += 2) {
        HALF_STEP(pB0, pB1, mnB, alB, pA0, pA1, alA, t, 1, 0, 0);
        HALF_STEP(pA0, pA1, mnA, alA, pB0, pB1, alB, t + 1, 0, 1, 1);
    }
    const bool even = (NT & 1) == 0;
    if (even) { SBAR(); qkt<1, SK>(pB0, pB1, K_lds, r32, hi, S.qr, ACT(NT - 1), Fcur + KBASE(NT - 1) * 4 + hi * 16); SBAR(); }
#define QROW(e) (nxt.Q + (size_t)(wid * QBLK + r32) * PITCH + ((e) >> 1) * 16 + hi * 8 + ((e) & 1) * 4)
    if constexpr (F32) { SLOAD_F((const float*)nxt.K, kbn); SBAR();
#pragma unroll
        for (int e = 0; e < 8; ++e) S.tq[e] = *(const f32x4*)QROW(e); }
    if constexpr (!F32) { SLOAD_H(nxt.K, nxt.V, kbn); SBAR();
#pragma unroll
        for (int d0 = 0; d0 < 8; ++d0) S.qr[d0] = __builtin_nontemporal_load((const bf16x8*)((const char*)(nxt.Q + (size_t)(wid * QBLK) * PITCH) + qvo + d0 * 32)); }
    SBAR();
    finishSM(pA0, pA1, alA, l_reg, pa0, pa1, pa2, pa3); SBAR();
    if constexpr (F32) {
#pragma unroll
        for (int e = 8; e < 16; ++e) S.tq[e] = *(const f32x4*)QROW(e); SBAR(); }
#undef QROW
    pv_tile<0, SK>(o, vb0, pa0, pa1, pa2, pa3, ACT(even ? NT - 2 : NT - 1));
    if (even) { MASKT(pB0, pB1, NT - 1); partialSM(pB0, pB1, m_reg, mnB, alB); __syncthreads(); RESC(alB);
        finishSM(pB0, pB1, alB, l_reg, pa0, pa1, pa2, pa3); SBAR(); pv_tile<1, SK>(o, vb0, pa0, pa1, pa2, pa3, ACT(NT - 1)); }
    SBAR(); SEAM_K0();
    { const f32x4 nfa = *(const f32x4*)(nxt.F + tid * 4), nfb = *(const f32x4*)(nxt.F + 2048 + tid * 4); VMW();
      *(f32x4*)(Fnext + tid * 16) = nfa; *(f32x4*)(Fnext + 8192 + tid * 16) = nfb; SBAR(); }
    if (hi == 0) li_l[r32] = l_reg; asm volatile("s_waitcnt lgkmcnt(0)" ::: "memory");
    float rli[16];
#pragma unroll
    for (int r = 0; r < 16; ++r) rli[r] = __builtin_amdgcn_rcpf(li_l[crow(r, hi)]);
    TOut* Ow = cur.O + (size_t)(wid * QBLK) * PITCH; const unsigned ovo = (unsigned)(4 * hi * PITCH + r32) * 2u;
#pragma unroll
    for (int r = 0; r < 16; ++r) { const int orow = crow(r, hi);
#pragma unroll
        for (int d0 = 0; d0 < 4; ++d0) { const float v = o[d0][r] * rli[r];
            if constexpr (same_t<TOut, float>::v) { Ow[(size_t)orow * PITCH + d0 * 32 + r32] = v; }
            else { const float vn = __shfl_xor(v, 1);
                   if ((r32 & 1) == 0) *(unsigned*)((char*)(Ow + (size_t)((r & 3) + 8 * (r >> 2)) * PITCH + d0 * 32) + ovo) = cvtpk(v, vn); } } }
    if constexpr (F32) {
#pragma unroll
        for (int d0 = 0; d0 < 8; ++d0) S.qr[d0] = pack8(S.tq[2 * d0], S.tq[2 * d0 + 1]); }
    __syncthreads();
#undef RESC
#undef KBASE
#undef ACT
#undef MASKT
#undef SEAM_K0
#undef HALF_STEP
}
#undef ROW
#undef VMW
#undef VMWN
#undef SLOAD_H
#undef GROW
#undef SWRITE_HK
#undef SWRITE_HV
#undef SWRITE_H
#undef SLOAD_F
#undef SWRITE_KF
#undef SWRITE_VF

constexpr int ATT_F_OFF = LDS_BYTES;
constexpr int ATT_LDS_TOTAL = LDS_BYTES + 2 * 16384;
}
constexpr int BATCH = 4, SEQ = 4096, DM = 2048, NH = 16, HD = 128, FF = 8192, M = BATCH * SEQ;
constexpr int NIN = 3 * DM + NH;
constexpr int NMOD = 6 * DM;
constexpr float RMS_EPS = 1e-6f;
constexpr float LOG2E = 1.4426950408889634f;
constexpr float QSCALE = 0.08838834764831845f * LOG2E;
constexpr int NWAVES = 8, NTHREADS = 512;
constexpr int LDS_TOTAL = 147456;
constexpr int NPHASES = 13;
#ifndef PH_MASK
#define PH_MASK 0xff
#endif
#define KEN(k) ((PH_MASK >> (k)) & 1)
constexpr size_t MiB = 1u << 20;
constexpr size_t WS_MOD = 1 * MiB, WS_SW = 1 * MiB + 512 * 1024, WS_LF = 2 * MiB, WS_FK = 3 * MiB;
constexpr size_t WS_SS = 516 * MiB;
constexpr int SW_UP0 = 0, SW_CIN = 4 * 8192, SW_UP1 = 4 * 8192 + 4 * 6144;
constexpr size_t WS_WQKV = 4 * MiB, WS_WO = 28 * MiB, WS_WCIN = 36 * MiB, WS_WCOUT = 60 * MiB, WS_WUP0 = 68 * MiB, WS_WUP1 = 100 * MiB, WS_WDN0 = 132 * MiB, WS_WDN1 = 164 * MiB;
constexpr size_t WS_XN = 196 * MiB, WS_Q = 260 * MiB, WS_K = 324 * MiB, WS_V = 388 * MiB, WS_O = 452 * MiB, WS_U = 260 * MiB, WS_XRB = 518 * MiB, WS_NRM = 582 * MiB, WS_END = 590 * MiB;
static_assert(WS_U + (size_t)M * FF * 2 == WS_SS && WS_O + (size_t)M * DM * 2 == WS_SS && WS_SS + (size_t)M * 32 * 4 == WS_XRB && WS_XRB + (size_t)M * DM * 2 == WS_NRM && WS_NRM + (size_t)2 * M * 64 * 4 == WS_END && WS_XN + (size_t)M * DM * 2 == WS_Q, "d_ws map");

#define LAS __attribute__((address_space(3)))
typedef unsigned short bf16;
typedef unsigned v4u __attribute__((ext_vector_type(4)));
typedef unsigned v2u __attribute__((ext_vector_type(2)));
typedef float f32x4 __attribute__((ext_vector_type(4)));
typedef float f32x2 __attribute__((ext_vector_type(2)));
#define LDS_WAIT() asm volatile("s_waitcnt lgkmcnt(0)" ::: "memory")
__device__ __forceinline__ unsigned pk2(float lo, float hi) { unsigned r; asm volatile("v_cvt_pk_bf16_f32 %0, %1, %2" : "=v"(r) : "v"(lo), "v"(hi)); return r; }
__device__ __forceinline__ float bf_lo(unsigned w) { return __uint_as_float(w << 16); }
__device__ __forceinline__ float bf_hi(unsigned w) { return __uint_as_float(w & 0xffff0000u); }
__device__ __forceinline__ float wave_sum(float v) {
#pragma unroll
    for (int o = 1; o < 64; o <<= 1) v += __shfl_xor(v, o);
    return v;
}

__device__ __forceinline__ void p0_gemv(const float* c, const float* ada_w, const float* ada_b, float* mod, LAS unsigned char* lds, int tid, int wave, int lane) {
    LAS f32x4* cact = (LAS f32x4*)lds;
    LAS float* red = (LAS float*)(lds + 32768);
    for (int k = tid; k < DM; k += NTHREADS) { f32x4 v;
#pragma unroll
        for (int b = 0; b < 4; ++b) { const float cv = c[b * DM + k]; v[b] = cv / (1.f + expf(-cv)); }
        cact[k] = v; }
    __syncthreads();
    for (int it = blockIdx.x; it < 192; it += gridDim.x) {
        const int l = it / 96, n0 = (it % 96) * 128;
        const float* wp = ada_w + ((size_t)l * DM + 256 * wave) * NMOD + n0 + 2 * lane;
        f32x2 acc[4];
#pragma unroll
        for (int b = 0; b < 4; ++b) acc[b] = (f32x2){0.f, 0.f};
#pragma unroll 16
        for (int kk = 0; kk < 256; ++kk) { const f32x2 wv = __builtin_nontemporal_load((const f32x2*)(wp + (size_t)kk * NMOD));   const f32x4 cv = cact[256 * wave + kk];
#pragma unroll
            for (int b = 0; b < 4; ++b) acc[b] += wv * cv[b]; }
#pragma unroll
        for (int b = 0; b < 4; ++b) *(LAS f32x2*)(red + (wave * 4 + b) * 128 + 2 * lane) = acc[b];
        __syncthreads();
        { const int b = tid >> 7, col = tid & 127; float s = ada_b[l * NMOD + n0 + col];
#pragma unroll
          for (int w = 0; w < 8; ++w) s += red[(w * 4 + b) * 128 + col];
          mod[(size_t)(l * 4 + b) * NMOD + n0 + col] = s; }
        __syncthreads();
    }
}
__device__ __forceinline__ void p0_transpose_item(const float* W, int ld, int K, int nblk, bf16* WT, LAS float* scr, int item, int lane, bool cumap = false) {
    const int kb = item / nblk, nb = item % nblk, k0 = 64 * kb, n0 = 32 * nb;
    const int d0 = !cumap || n0 < DM ? n0 : (n0 < 2 * DM ? DM + 256 * ((n0 - DM) >> 7) + ((n0 - DM) & 127) : DM + 256 * ((n0 - 2 * DM) >> 7) + 128 + ((n0 - 2 * DM) & 127));
#pragma unroll 8
    for (int i = 0; i < 32; ++i) { const int kk = 2 * i + (lane >> 5); scr[kk * 33 + (lane & 31)] = __builtin_nontemporal_load(W + (size_t)(k0 + kk) * ld + n0 + (lane & 31)); }
    LDS_WAIT(); asm volatile("" ::: "memory");
    const int c = lane & 7;
#pragma unroll
    for (int j = 0; j < 4; ++j) { const int n = (lane >> 3) + 8 * j; const LAS float* s = scr + (8 * c) * 33 + n;
        v4u o; o.x = pk2(s[0 * 33], s[1 * 33]); o.y = pk2(s[2 * 33], s[3 * 33]); o.z = pk2(s[4 * 33], s[5 * 33]); o.w = pk2(s[6 * 33], s[7 * 33]);
        *(v4u*)(WT + (size_t)(d0 + n) * K + k0 + 8 * c) = o; }
    LDS_WAIT(); asm volatile("" ::: "memory");
}
struct Args { const float* in[15]; float* out; unsigned char* ws; int ph_lo, ph_hi; };
typedef const __attribute__((address_space(4))) unsigned char* kargp_t;
#define KARG_IN(kq, i) (*(const float* const __attribute__((address_space(4)))*)((kq) + 8 * (i)))
#define KARG_OUT(kq) (*(float* const __attribute__((address_space(4)))*)((kq) + 120))
#define KARG_WS(kq) (*(unsigned char* const __attribute__((address_space(4)))*)((kq) + 128))
static_assert(sizeof(Args) == 144, "Args layout");
__device__ __forceinline__ void p0_transposes(kargp_t kq, LAS unsigned char* lds, int wave, int lane, int gw, int ngw) {
    LAS float* scr = (LAS float*)(lds + wave * 16384);
    unsigned char* ws = KARG_WS(kq);
    constexpr int I_IN = 32 * 192, I_SQ = 32 * 64, I_UP = 32 * 256, I_DN = 128 * 64;
    constexpr int NITEMS = 2 * I_IN + 2 * I_SQ + 2 * I_UP + 2 * I_DN;
    const bool deal = (ngw == 2048); static_assert(NITEMS == 1536 * 22 + 512 * 30, "prologue item deal");
    const int lo_wave = gw < 1536, first = deal ? (lo_wave ? gw : 33792 + (gw - 1536)) : gw, step = deal ? (lo_wave ? 1536 : 512) : ngw, stop = deal ? (lo_wave ? 33792 : NITEMS) : NITEMS;
    for (int it = first + ((stop - 1 - first) / step) * step; it >= first; it -= step) {
        int r = it;
        if (r < I_IN) { p0_transpose_item(KARG_IN(kq, 6), NIN, DM, 192, (bf16*)(ws + WS_WQKV), scr, r, lane); continue; } r -= I_IN;
        if (r < I_SQ) { p0_transpose_item(KARG_IN(kq, 8), DM, DM, 64, (bf16*)(ws + WS_WO), scr, r, lane); continue; } r -= I_SQ;
        if (r < I_IN) { p0_transpose_item(KARG_IN(kq, 9), 3 * DM, DM, 192, (bf16*)(ws + WS_WCIN), scr, r, lane, true); continue; } r -= I_IN;
        if (r < I_SQ) { p0_transpose_item(KARG_IN(kq, 11), DM, DM, 64, (bf16*)(ws + WS_WCOUT), scr, r, lane); continue; } r -= I_SQ;
        if (r < I_UP) { p0_transpose_item(KARG_IN(kq, 12), FF, DM, 256, (bf16*)(ws + WS_WUP0), scr, r, lane); continue; } r -= I_UP;
        if (r < I_UP) { p0_transpose_item(KARG_IN(kq, 12) + (size_t)DM * FF, FF, DM, 256, (bf16*)(ws + WS_WUP1), scr, r, lane); continue; } r -= I_UP;
        if (r < I_DN) { p0_transpose_item(KARG_IN(kq, 13), DM, FF, 64, (bf16*)(ws + WS_WDN0), scr, r, lane); continue; } r -= I_DN;
        p0_transpose_item(KARG_IN(kq, 13) + (size_t)FF * DM, DM, FF, 64, (bf16*)(ws + WS_WDN1), scr, r, lane);
    }
}
__device__ __forceinline__ void ld8(const bf16* p, float (&f)[8]) { const v4u w = *(const v4u*)p; f[0] = bf_lo(w.x); f[1] = bf_hi(w.x); f[2] = bf_lo(w.y); f[3] = bf_hi(w.y); f[4] = bf_lo(w.z); f[5] = bf_hi(w.z); f[6] = bf_lo(w.w); f[7] = bf_hi(w.w); }
__device__ __forceinline__ void shiftw_mfma(const float* mod, unsigned char* ws, float* SW, LAS unsigned char* lds, int tid, int lane, int gw, int ngw) {
    LAS bf16* S = (LAS bf16*)lds;
#pragma unroll
    for (int it = 0; it < 3 * 4 * DM / 4 / NTHREADS; ++it) { const int idx = tid + it * NTHREADS, mat = idx / DM, b = (idx / (DM / 4)) & 3, k = (idx & (DM / 4 - 1)) * 4;
        const float* shp = mat == 0 ? mod + 3 * DM : (mat == 1 ? mod + (size_t)4 * NMOD : mod + (size_t)4 * NMOD + 3 * DM);
        const f32x4 v = *(const f32x4*)(shp + (size_t)b * NMOD + k); unsigned hb[4], lb[4];
#pragma unroll
        for (int i = 0; i < 4; ++i) { hb[i] = pk2(v[i], 0.f) & 0xffffu; lb[i] = pk2(v[i] - __uint_as_float(hb[i] << 16), 0.f) & 0xffffu; }
        v2u h2, l2; h2.x = hb[0] | (hb[1] << 16); h2.y = hb[2] | (hb[3] << 16); l2.x = lb[0] | (lb[1] << 16); l2.y = lb[2] | (lb[3] << 16);
        *(LAS v2u*)(S + (mat * 8 + b) * DM + k) = h2; *(LAS v2u*)(S + (mat * 8 + 4 + b) * DM + k) = l2; }
    __syncthreads();
    const int fr = lane & 15, fq = lane >> 4;
    for (int g = gw; g < 1408; g += ngw) {
        const int mat = g < 512 ? 0 : (g < 896 ? 1 : 2), g0 = g - (mat == 0 ? 0 : (mat == 1 ? 512 : 896)), N = mat == 1 ? 3 * DM : FF;
        const bf16* Wt = (const bf16*)(ws + (mat == 0 ? WS_WUP0 : (mat == 1 ? WS_WCIN : WS_WUP1)));
        float* sw = SW + (mat == 0 ? SW_UP0 : (mat == 1 ? SW_CIN : SW_UP1));
        const bf16* wp = Wt + (size_t)(g0 * 16 + fr) * DM + 8 * fq;
        const LAS bf16* sp = S + (mat * 8 + (fr & 7)) * DM + 8 * fq;
        pg8::f32x4 acc = {0.f, 0.f, 0.f, 0.f};
#pragma unroll 8
        for (int kk = 0; kk < DM / 32; ++kk) { const pg8::bf16x8 wf = *(const pg8::bf16x8*)(wp + 32 * kk); pg8::bf16x8 sf = *(const LAS pg8::bf16x8*)(sp + 32 * kk);
            if (fr >= 8) sf = (pg8::bf16x8){0, 0, 0, 0, 0, 0, 0, 0};
            acc = __builtin_amdgcn_mfma_f32_16x16x32_bf16(wf, sf, acc, 0, 0, 0); }
        pg8::f32x4 r;
#pragma unroll
        for (int i = 0; i < 4; ++i) r[i] = acc[i] + __shfl_xor(acc[i], 4);
        if (fr < 4) *(pg8::f32x4*)(sw + (size_t)fr * N + g0 * 16 + 4 * fq) = r;
    }
}
constexpr int WFT_LD = DM + 8;
__device__ __forceinline__ void norm_phase(const float* src, const float* gain, const float* shp, const float* scp, bf16* XN,
                                           const float* w_in, const float* b_f, float* LF, LAS unsigned char* lds, int tid, int lane, int wave, int gw, int ngw) {
    LAS bf16* WFT = (LAS bf16*)lds;
#pragma unroll
    for (int idx = tid; idx < 8192; idx += NTHREADS) { const int k = idx >> 2, n4 = idx & 3;
        const f32x4 v = *(const f32x4*)(w_in + (size_t)k * NIN + 3 * DM + 4 * n4);
#pragma unroll
        for (int i = 0; i < 4; ++i) { const unsigned hb = pk2(v[i], 0.f) & 0xffffu; const unsigned lb = pk2(v[i] - __uint_as_float(hb << 16), 0.f) & 0xffffu;
            WFT[(4 * n4 + i) * WFT_LD + k] = (bf16)hb; WFT[(16 + 4 * n4 + i) * WFT_LD + k] = (bf16)lb; } }
    for (int grp = gw; grp < M / 8; grp += ngw) {
        const int row0 = grp * 8, b = row0 / SEQ;
        for (int rq = 0; rq < 2; ++rq) {
            asm volatile("" ::: "memory");
            f32x4 v[4][8]; float inv[4];
#pragma unroll
            for (int r = 0; r < 4; ++r)
#pragma unroll
                for (int j = 0; j < 8; ++j) v[r][j] = __builtin_nontemporal_load((const f32x4*)(src + (size_t)(row0 + 4 * rq + r) * DM) + lane + 64 * j);
#pragma unroll
            for (int r = 0; r < 4; ++r) { float ss = 0.f;
#pragma unroll
                for (int j = 0; j < 8; ++j) ss += (v[r][j].x * v[r][j].x + v[r][j].y * v[r][j].y) + (v[r][j].z * v[r][j].z + v[r][j].w * v[r][j].w);
                inv[r] = 1.0f / sqrtf(wave_sum(ss) * (1.f / DM) + RMS_EPS); }
#pragma unroll
            for (int j = 0; j < 8; ++j) { const f32x4 g = ((const f32x4*)gain)[lane + 64 * j], sc = ((const f32x4*)(scp + (size_t)b * NMOD))[lane + 64 * j], sh = ((const f32x4*)(shp + (size_t)b * NMOD))[lane + 64 * j];
                const f32x4 ca = g * (sc + 1.f);
#pragma unroll
                for (int r = 0; r < 4; ++r) { const f32x4 h = (v[r][j] * inv[r]) * ca + sh; v2u w; w.x = pk2(h.x, h.y); w.y = pk2(h.z, h.w);
                    ((v2u*)(XN + (size_t)(row0 + 4 * rq + r) * DM))[lane + 64 * j] = w; } }
        }
    }
    __syncthreads();
    if ((wave & 1) == 0) {
        const int fr = lane & 15, fq = lane >> 4;
        for (int grp = gw; grp < M / 8; grp += ngw) {
            const int row0 = grp * 8, b = row0 / SEQ;
            const bf16* xp = XN + (size_t)(row0 + fr) * DM + 8 * fq;
            const LAS bf16* yh = WFT + fr * WFT_LD + 8 * fq; const LAS bf16* yl = yh + 16 * WFT_LD;
            pg8::f32x4 ah = {0.f, 0.f, 0.f, 0.f}, al = {0.f, 0.f, 0.f, 0.f};
#pragma unroll 8
            for (int kk = 0; kk < DM / 32; ++kk) { const pg8::bf16x8 xf = *(const pg8::bf16x8*)(xp + 32 * kk);
                ah = __builtin_amdgcn_mfma_f32_16x16x32_bf16(xf, *(const LAS pg8::bf16x8*)(yh + 32 * kk), ah, 0, 0, 0);
                al = __builtin_amdgcn_mfma_f32_16x16x32_bf16(xf, *(const LAS pg8::bf16x8*)(yl + 32 * kk), al, 0, 0, 0); }
            const float bias = b_f[fr]; pg8::f32x4 lf;
#pragma unroll
            for (int i = 0; i < 4; ++i) { const float z = ah[i] + al[i] + bias; lf[i] = fminf(z, 0.f) - log1pf(expf(-fabsf(z))); }
            *(pg8::f32x4*)(LF + (size_t)(b * NH + fr) * SEQ + (row0 % SEQ) + 4 * fq) = lf;
        }
    }
}
__device__ __forceinline__ void cumsum_block(const float* LF, float* FK, int bh, LAS unsigned char* lds, int tid, int wave, int lane) {
    const f32x4 a = *(const f32x4*)(LF + (size_t)bh * SEQ + 8 * tid), b = *(const f32x4*)(LF + (size_t)bh * SEQ + 8 * tid + 4);
    float p[8]; p[0] = a.x; p[1] = p[0] + a.y; p[2] = p[1] + a.z; p[3] = p[2] + a.w; p[4] = p[3] + b.x; p[5] = p[4] + b.y; p[6] = p[5] + b.z; p[7] = p[6] + b.w;
    float incl = p[7];
#pragma unroll
    for (int o = 1; o < 64; o <<= 1) { const float t = __shfl_up(incl, o); if (lane >= o) incl += t; }
    LAS float* wt = (LAS float*)lds;
    if (lane == 63) wt[wave] = incl;
    __syncthreads();
    float off = incl - p[7];
    for (int w = 0; w < wave; ++w) off += wt[w];
    f32x4 o0, o1; o0.x = -(off + p[0]) * LOG2E; o0.y = -(off + p[1]) * LOG2E; o0.z = -(off + p[2]) * LOG2E; o0.w = -(off + p[3]) * LOG2E;
    o1.x = -(off + p[4]) * LOG2E; o1.y = -(off + p[5]) * LOG2E; o1.z = -(off + p[6]) * LOG2E; o1.w = -(off + p[7]) * LOG2E;
    *(f32x4*)(FK + (size_t)bh * SEQ + 8 * tid) = o0; *(f32x4*)(FK + (size_t)bh * SEQ + 8 * tid + 4) = o1;
    __syncthreads();
}
typedef __hip_bfloat16 hbf;
__device__ __forceinline__ void att_item(int L, int pass, int& bh, int& qb) {
    const int xcd = L & 7, k = L >> 3; bh = (k >> 3) * 8 + xcd; const int x0 = k & 7, x = (L >= 256) ? 7 - x0 : x0; qb = pass ? 15 - x : x;
}
__device__ __forceinline__ att::BlockRef<hbf, hbf> att_ref(int L, int pass, int jlo, const hbf* Q, const hbf* K, const hbf* V, hbf* O, const float* FK) {
    int bh, qb; att_item(L, pass, bh, qb);
    const int b = bh >> 4, h = bh & 15; const size_t rowbase = (size_t)b * SEQ;
    att::BlockRef<hbf, hbf> r;
    r.Q = Q + (rowbase + (size_t)qb * 256) * DM + h * HD; r.O = O + (rowbase + (size_t)qb * 256) * DM + h * HD;
    r.K = K + rowbase * DM + h * HD; r.V = V + rowbase * DM + h * HD; r.F = FK + (size_t)bh * SEQ; r.P0 = qb * 256; r.jlo = jlo;
    return r;
}
__device__ __forceinline__ int att_jlo(int L, int pass, const float* NRM, const float* FK, LAS unsigned char* lds, int tid, int lane, int wave) {
    int bh, qb; att_item(L, pass, bh, qb);
    const int b = bh >> 4, h = bh & 15, P0 = qb * 256; const size_t rowbase = (size_t)b * SEQ;
    const float* NQ = NRM + (size_t)bh * SEQ * 4; const float* NK = NRM + ((size_t)(BATCH * NH) + bh) * SEQ * 4;
    float kq = 0.f, kk = 0.f;
    if (tid < 256) { const f32x4 v = *(const f32x4*)(NQ + (size_t)(P0 + tid) * 4); kq = (v[0] + v[1]) + (v[2] + v[3]); }
    for (int s = tid; s < P0 + 256; s += NTHREADS) { const f32x4 v = *(const f32x4*)(NK + (size_t)s * 4); kk = fmaxf(kk, (v[0] + v[1]) + (v[2] + v[3])); }
#pragma unroll
    for (int o = 1; o < 64; o <<= 1) { kq = fmaxf(kq, __shfl_xor(kq, o)); kk = fmaxf(kk, __shfl_xor(kk, o)); }
    LAS float* red = (LAS float*)(lds + 122880);
    if (lane == 0) { red[wave] = kq; red[8 + wave] = kk; }
    __syncthreads();
    float mq = 0.f, mk = 0.f;
#pragma unroll
    for (int w = 0; w < 8; ++w) { mq = fmaxf(mq, red[w]); mk = fmaxf(mk, red[8 + w]); }
    const float B = 1.02f * sqrtf(mq * mk);
    const float* F = FK + (size_t)bh * SEQ;
    const float fend = F[64 * lane + 63], f0 = F[P0];
    const bool skip = (64 * lane + 63 < P0) && (2.f * B + fend - f0 < -60.f);
    const int jlo = __popcll(__ballot(skip));
    __syncthreads();
    return __builtin_amdgcn_readfirstlane(jlo);
}
__device__ __forceinline__ void attn_phase(const hbf* Q, const hbf* K, const hbf* V, hbf* O, const float* FK, const float* NRM, char* lds) {
    constexpr int total = 8 * BATCH * NH, W = 1 << 30;
    const int stride = gridDim.x; int L = blockIdx.x; if (L >= total) return;
    const int L0 = L;
    int jl0, jl1, jl2 = 0, jl3 = 0;
    { const int tid = tidx(), lane = tid & 63, wave = __builtin_amdgcn_readfirstlane(tid >> 6);
      jl0 = att_jlo(L0, 0, NRM, FK, (LAS unsigned char*)lds, tid, lane, wave); jl1 = att_jlo(L0, 1, NRM, FK, (LAS unsigned char*)lds, tid, lane, wave);
      if (L0 + stride < total) { jl2 = att_jlo(L0 + stride, 0, NRM, FK, (LAS unsigned char*)lds, tid, lane, wave); jl3 = att_jlo(L0 + stride, 1, NRM, FK, (LAS unsigned char*)lds, tid, lane, wave); } }
    int pass = 0, fsel = 0;
    att::BlockRef<hbf, hbf> cur = att_ref(L, 0, jl0, Q, K, V, O, FK);
    att::Seam<hbf> S;
    att::causal_swa_prime<hbf, hbf>(cur, W, lds, S, lds + att::ATT_F_OFF);
    for (;;) {
        const bool more_pass = pass == 0, more_item = (L == L0) && (L + stride < total), last = !more_pass && !more_item;
        int passn = pass + 1, Ln = L;
        if (!more_pass) { passn = 0; Ln = more_item ? L + stride : L; }
        const int jn = (Ln == L0) ? (passn ? jl1 : jl0) : (passn ? jl3 : jl2);
        const att::BlockRef<hbf, hbf> nxt = last ? cur : att_ref(Ln, passn, jn, Q, K, V, O, FK);
        att::causal_swa_block<hbf, hbf>(cur, nxt, SEQ, W, lds, S, lds + att::ATT_F_OFF + fsel * 16384, lds + att::ATT_F_OFF + (fsel ^ 1) * 16384);
        if (last) break;
        cur = nxt; pass = passn; L = Ln; fsel ^= 1;
    }
}
__device__ __forceinline__ void conv_phase(const bf16* BG, const bf16* P, const float* cw, bf16* Y, int lane, int gw, int ngw) {
    for (int grp = gw; grp < M / 8; grp += ngw) {
        const int row0 = grp * 8, t0 = row0 % SEQ;
        for (int j = 0; j < 4; ++j) {
            const int ch = (lane + 64 * j) * 8;
            float w0[8], w1[8], w2[8], pm2[8], pm1[8];
#pragma unroll
            for (int i = 0; i < 8; ++i) { w0[i] = cw[ch + i]; w1[i] = cw[DM + ch + i]; w2[i] = cw[2 * DM + ch + i]; pm2[i] = 0.f; pm1[i] = 0.f; }
            if (t0 > 0) { ld8(P + (size_t)(row0 - 2) * DM + ch, pm2); ld8(P + (size_t)(row0 - 1) * DM + ch, pm1); }
#pragma unroll
            for (int r = 0; r < 8; ++r) { float p8[8], b8[8], y[8];
                ld8(P + (size_t)(row0 + r) * DM + ch, p8); ld8(BG + (size_t)(row0 + r) * DM + ch, b8);
#pragma unroll
                for (int i = 0; i < 8; ++i) { y[i] = b8[i] * (w0[i] * pm2[i] + w1[i] * pm1[i] + w2[i] * p8[i]); pm2[i] = pm1[i]; pm1[i] = p8[i]; }
                v4u o; o.x = pk2(y[0], y[1]); o.y = pk2(y[2], y[3]); o.z = pk2(y[4], y[5]); o.w = pk2(y[6], y[7]);
                *(v4u*)(Y + (size_t)(row0 + r) * DM + ch) = o; }
        }
    }
}
__device__ __forceinline__ void final_norm_phase(const bf16* xr, float* out, const float* gain, int lane, int gw, int ngw) {
    for (int r0 = gw * 4; r0 < M; r0 += ngw * 4) {
        v4u raw[4][4];
#pragma unroll
        for (int r = 0; r < 4; ++r)
#pragma unroll
            for (int j = 0; j < 4; ++j) raw[r][j] = *(const v4u*)(xr + (size_t)(r0 + r) * DM + (lane + 64 * j) * 8);
        float inv[4];
#pragma unroll
        for (int r = 0; r < 4; ++r) { float ss = 0.f;
#pragma unroll
            for (int j = 0; j < 4; ++j) { const unsigned w[4] = {raw[r][j].x, raw[r][j].y, raw[r][j].z, raw[r][j].w};
#pragma unroll
                for (int i = 0; i < 4; ++i) { const float a = bf_lo(w[i]), b = bf_hi(w[i]); ss += a * a + b * b; } }
            inv[r] = 1.0f / sqrtf(wave_sum(ss) * (1.f / DM) + RMS_EPS); }
#pragma unroll
        for (int j = 0; j < 4; ++j) { const f32x4 g0 = *(const f32x4*)(gain + (lane + 64 * j) * 8), g1 = *(const f32x4*)(gain + (lane + 64 * j) * 8 + 4);
#pragma unroll
            for (int r = 0; r < 4; ++r) { const v4u w = raw[r][j]; f32x4 o0, o1;
                o0[0] = bf_lo(w.x); o0[1] = bf_hi(w.x); o0[2] = bf_lo(w.y); o0[3] = bf_hi(w.y); o1[0] = bf_lo(w.z); o1[1] = bf_hi(w.z); o1[2] = bf_lo(w.w); o1[3] = bf_hi(w.w);
                o0 = (o0 * inv[r]) * g0; o1 = (o1 * inv[r]) * g1;
                *(f32x4*)(out + (size_t)(r0 + r) * DM + (lane + 64 * j) * 8) = o0; *(f32x4*)(out + (size_t)(r0 + r) * DM + (lane + 64 * j) * 8 + 4) = o1; } }
    }
}

#define XB_TMO      128
#define XB_XCNT(j)  (256  + 64 * (j))
#define XB_XSUB(j)  (1280 + 64 * (j))
#define XB_XGEN(j)  (2304 + 64 * (j))
#define XB_TOP      3328
#define XB_TOPGEN   3392
#define XCD_BAR_WORDS 3456
#define XB_SPIN_CAP (1u << 18)

__device__ __forceinline__ unsigned xb_ld(unsigned* p)              { return __hip_atomic_load(p, __ATOMIC_RELAXED, __HIP_MEMORY_SCOPE_AGENT); }
__device__ __forceinline__ unsigned xb_add(unsigned* p, unsigned v) { return __hip_atomic_fetch_add(p, v, __ATOMIC_RELAXED, __HIP_MEMORY_SCOPE_AGENT); }
__device__ __forceinline__ unsigned xb_xcc_id() { return (unsigned)__builtin_amdgcn_s_getreg((3 << 11) | 20) & 0xFu; }
#define XB_SPIN(cond, bar) do { unsigned _sp = 0; while (cond) { __builtin_amdgcn_s_sleep(1); \
    if ((++_sp & 255u) == 0u) { if (xb_ld(&(bar)[XB_TMO])) break; if (_sp > XB_SPIN_CAP) { atomicAdd(&(bar)[XB_TMO], 1u); break; } } } } while (0)

struct XcdBarrier {
    unsigned* bar; unsigned x;
    volatile LAS unsigned* st;
};

__device__ __forceinline__ XcdBarrier xcd_barrier_post(unsigned* bar, volatile LAS unsigned* st) {
    XcdBarrier b; b.bar = bar; b.x = xb_xcc_id(); b.st = st;
    if (threadIdx.x == 0) (void)xb_add(&bar[XB_XCNT(b.x)], 1u);
    return b;
}
__device__ __forceinline__ void xcd_barrier_complete(unsigned* bar, unsigned x, unsigned& nloc, unsigned& nx) {
    const unsigned G = gridDim.x * gridDim.y * gridDim.z;
    unsigned sum, cnt, mine, sp = 0u;
    for (;;) {
        sum = 0u; cnt = 0u; mine = 0u;
#pragma unroll
        for (unsigned j = 0; j < 16; ++j) { const unsigned c = xb_ld(&bar[XB_XCNT(j)]); sum += c; cnt += (c > 0u) ? 1u : 0u; mine = (j == x) ? c : mine; }
        if (sum == G) break;
        __builtin_amdgcn_s_sleep(1);
        if ((++sp & 255u) == 0u) { if (xb_ld(&bar[XB_TMO])) break; if (sp > XB_SPIN_CAP) { atomicAdd(&bar[XB_TMO], 1u); break; } }
    }
    nloc = mine > 0u ? mine : 1u; nx = cnt > 0u ? cnt : 1u;
}

__device__ __forceinline__ void xcd_barrier(const XcdBarrier& b) {
    asm volatile("s_waitcnt vmcnt(0)" ::: "memory");
    __syncthreads();
    if (threadIdx.x == 0) {
        unsigned* bar = b.bar;
        __builtin_amdgcn_s_waitcnt(0);
        unsigned nloc = b.st[0], nx = b.st[1];
        if (nloc == 0u) { xcd_barrier_complete(bar, b.x, nloc, nx); b.st[0] = nloc; b.st[1] = nx; }
        const unsigned old = xb_add(&bar[XB_XSUB(b.x)], 1u);
        const unsigned gen = old / nloc;
        if (old + 1u == (gen + 1u) * nloc) {
            __builtin_amdgcn_fence(__ATOMIC_RELEASE, "agent");
            asm volatile("s_waitcnt vmcnt(0)" ::: "memory");
            const unsigned og = xb_add(&bar[XB_TOP], 1u);
            const unsigned tg = og / nx;
            if (og + 1u == (tg + 1u) * nx) xb_add(&bar[XB_TOPGEN], 1u);
            else XB_SPIN(xb_ld(&bar[XB_TOPGEN]) == tg, bar);
            __builtin_amdgcn_fence(__ATOMIC_ACQUIRE, "agent");
            xb_add(&bar[XB_XGEN(b.x)], 1u);
            asm volatile("s_waitcnt vmcnt(0)" ::: "memory");
        } else {
            XB_SPIN(xb_ld(&bar[XB_XGEN(b.x)]) == gen, bar);
            __builtin_amdgcn_fence(__ATOMIC_ACQUIRE, "agent");
            asm volatile("s_waitcnt vmcnt(0)" ::: "memory");
        }
    }
    __syncthreads();
}

enum { K_PRO = 0, K_NORM, K_GEMM_BF16, K_ATTN, K_GEMM_RES, K_GEMM_SQ, K_CONV, K_FINAL };
__global__ void __launch_bounds__(NTHREADS, 2) fwd_mega(Args a) {
    extern __shared__ __attribute__((aligned(16))) unsigned char lds[];
    LAS unsigned char* L = (LAS unsigned char*)lds;
    const int G = gridDim.x, ngw = G * NWAVES;
    const kargp_t kp = (kargp_t)__builtin_amdgcn_kernarg_segment_ptr();
    const int ph_lo = a.ph_lo, ph_hi = a.ph_hi;
    volatile LAS unsigned* MISC = (volatile LAS unsigned*)(L + LDS_TOTAL - 256);
    if (tidx() < 32) MISC[tidx()] = 0u;
    __syncthreads();
    XcdBarrier xbar; xbar.bar = (unsigned*)a.ws; xbar.x = 0; xbar.st = nullptr;
    if (ph_hi - ph_lo > 1) xbar = xcd_barrier_post((unsigned*)a.ws, MISC + 8);
#if defined(PROBE_REP_KIND)
    int rep_left = PROBE_REP_N;
#endif
    for (int ph = ph_lo; ph < ph_hi; ++ph) {
        kargp_t kq = kp; asm volatile("" : "+s"(kq));
        unsigned char* ws = KARG_WS(kq);
        const float* x = KARG_IN(kq, 0);
        float* mod = (float*)(ws + WS_MOD); float* LF = (float*)(ws + WS_LF); float* FK = (float*)(ws + WS_FK);
        bf16* XN = (bf16*)(ws + WS_XN); bf16* Qb = (bf16*)(ws + WS_Q); bf16* Kb = (bf16*)(ws + WS_K); bf16* Vb = (bf16*)(ws + WS_V); bf16* Ob = (bf16*)(ws + WS_O); bf16* Ub = (bf16*)(ws + WS_U);
        float* XR = KARG_OUT(kq);
        const int layer = ph >= 7 ? 1 : 0;
        int kind;
        switch (ph) {
            case 0: kind = K_PRO; break;
            case 1: kind = K_NORM; break;
            case 2: case 7: kind = K_GEMM_BF16; break;
            case 3: kind = K_ATTN; break;
            case 4: case 6: case 9: case 11: kind = K_GEMM_RES; break;
            case 5: case 10: kind = K_GEMM_SQ; break;
            case 8: kind = K_CONV; break;
            default: kind = K_FINAL; break;
        }
        const bool mlp_half = (ph == 5 || ph == 6 || ph == 10 || ph == 11);
        const float* modl = mod + (size_t)layer * 4 * NMOD;
        float* SS = (float*)(ws + WS_SS); float* SW = (float*)(ws + WS_SW);
        if (KEN(K_PRO) && kind == K_PRO) {
            const int tid = tidx(), lane = tid & 63, wave = __builtin_amdgcn_readfirstlane(tid >> 6), gw = blockIdx.x * NWAVES + wave; (void)tid; (void)lane; (void)wave; (void)gw;
            p0_gemv(KARG_IN(kq, 1), KARG_IN(kq, 2), KARG_IN(kq, 3), mod, L, tid, wave, lane);
            p0_transposes(kq, L, wave, lane, gw, ngw);
            __syncthreads();
        } else if (KEN(K_NORM) && kind == K_NORM) {
            const int tid = tidx(), lane = tid & 63, wave = __builtin_amdgcn_readfirstlane(tid >> 6), gw = blockIdx.x * NWAVES + wave; (void)tid; (void)lane; (void)wave; (void)gw;
            norm_phase(x, KARG_IN(kq, 4), modl, modl + DM, XN, KARG_IN(kq, 6), KARG_IN(kq, 7), LF, L, tid, lane, wave, gw, ngw);
            __syncthreads();
            shiftw_mfma(mod, ws, SW, L, tid, lane, gw, ngw);
            __syncthreads();
        } else if (KEN(K_GEMM_BF16) && kind == K_GEMM_BF16) {
            const int tid = tidx(), lane = tid & 63, wave = __builtin_amdgcn_readfirstlane(tid >> 6), gw = blockIdx.x * NWAVES + wave; (void)tid; (void)lane; (void)wave; (void)gw;
            if (ph == 2) { for (int bh = blockIdx.x; bh < BATCH * NH; bh += G) cumsum_block(LF, FK, bh, L, tid, wave, lane); }
            pg8::Gemm g{XN, (const bf16*)(ws + (ph == 2 ? WS_WQKV : WS_WCIN)), M, 3 * DM, DM}; pg8::StaticOrder S; S.init(M, 3 * DM, G, (int)blockIdx.x);
            pg8::EpiBf16<0> E{Qb, DM, DM, (size_t)(WS_K - WS_Q) / 2, ph == 2 ? QSCALE : 1.0f, ph == 2 ? (const float*)nullptr : (const float*)SS, SW + SW_CIN, 3 * DM, SEQ, ph == 2 ? (bf16*)nullptr : Kb, 8, ph == 2 ? (float*)(ws + WS_NRM) : (float*)nullptr};
            pg8::gemm_phase<pg8::EpiBf16<0>, pg8::StaticOrder, true, true>(L, g, S, E);
        } else if (KEN(K_ATTN) && kind == K_ATTN) {
            attn_phase((const hbf*)Qb, (const hbf*)Kb, (const hbf*)Vb, (hbf*)Ob, FK, (const float*)(ws + WS_NRM), (char*)lds);
        } else if (KEN(K_GEMM_RES) && kind == K_GEMM_RES) {
            const bf16* A = mlp_half ? Ub : Ob; const int Kd = mlp_half ? FF : DM;
            const size_t wo = mlp_half ? (layer ? WS_WDN1 : WS_WDN0) : (layer ? WS_WCOUT : WS_WO);
            pg8::Gemm g{A, (const bf16*)(ws + wo), M, DM, Kd}; pg8::StaticOrder S; S.init(M, DM, G, (int)blockIdx.x);
            const float* n_gain = mlp_half ? KARG_IN(kq, 4) + DM : KARG_IN(kq, 5) + (size_t)layer * DM;
            const float* n_scale = mlp_half ? mod + (size_t)4 * NMOD + DM : modl + 4 * DM;
            bf16* XRB = (bf16*)(ws + WS_XRB);
            pg8::EpiRes E{ph == 4 ? x : (const float*)nullptr, ph == 4 ? (const bf16*)nullptr : (const bf16*)XRB, (float*)nullptr, XRB, DM, modl + (mlp_half ? 5 * DM : 2 * DM), SEQ, NMOD, ph == 11 ? (bf16*)nullptr : XN, n_gain, n_scale, SS};
            pg8::gemm_phase<pg8::EpiRes, pg8::StaticOrder, true, true>(L, g, S, E);
        } else if (KEN(K_GEMM_SQ) && kind == K_GEMM_SQ) {
            pg8::Gemm g{XN, (const bf16*)(ws + (layer ? WS_WUP1 : WS_WUP0)), M, FF, DM}; pg8::StaticOrder S; S.init(M, FF, G, (int)blockIdx.x);
#if defined(PROBE_NULL_EPI)
            if (rep_left < PROBE_REP_N) { pg8::EpiNull E0{Ub}; pg8::gemm_phase<pg8::EpiNull, pg8::StaticOrder, true, true>(L, g, S, E0); } else
#endif
            { pg8::EpiBf16<2> E{Ub, FF, 0, 0, 1.0f, SS, SW + (layer ? SW_UP1 : SW_UP0), FF, SEQ, (bf16*)nullptr, 0, (float*)nullptr};
            pg8::gemm_phase<pg8::EpiBf16<2>, pg8::StaticOrder, true, true>(L, g, S, E); }
        } else if (KEN(K_CONV) && kind == K_CONV) {
            const int tid = tidx(), lane = tid & 63, wave = __builtin_amdgcn_readfirstlane(tid >> 6), gw = blockIdx.x * NWAVES + wave; (void)tid; (void)lane; (void)wave; (void)gw;
            conv_phase(Qb, Kb, KARG_IN(kq, 10), Ob, lane, gw, ngw);
        } else if (KEN(K_FINAL) && kind == K_FINAL) {
            const int tid = tidx(), lane = tid & 63, wave = __builtin_amdgcn_readfirstlane(tid >> 6), gw = blockIdx.x * NWAVES + wave; (void)tid; (void)lane; (void)wave; (void)gw;
            final_norm_phase((const bf16*)(ws + WS_XRB), XR, KARG_IN(kq, 14), lane, gw, ngw);
        }
#if defined(PROBE_REP_KIND)
        if (kind == PROBE_REP_KIND && !(kind == K_GEMM_RES && ph != 4) && rep_left > 0) { --rep_left; xcd_barrier(xbar); --ph; continue; }
        rep_left = PROBE_REP_N;
#endif
#if defined(PROBE_EXTRA_SYNC)
        for (int es = 0; es < PROBE_EXTRA_SYNC; ++es) xcd_barrier(xbar);
#endif
        if (ph + 1 < ph_hi) { if (ph_hi > NPHASES) cg::this_grid().sync(); else xcd_barrier(xbar); }
    }
}

extern "C" void kernel_launch(void* const* d_in, const int* in_sizes, int n_in, void* d_out, int out_size, void* d_ws, size_t ws_size, hipStream_t stream) {
    static int grid = 0;
    if (grid == 0) {
        if (n_in != 15 || in_sizes[0] != M * DM || out_size != M * DM || ws_size < WS_END) { fprintf(stderr, "kernel_launch: shape/workspace mismatch (n_in %d, in0 %d, out %d, ws %zu)\n", n_in, n_in > 0 ? in_sizes[0] : -1, out_size, ws_size); grid = -1; return; }
        int dev = 0, cus = 0, per_cu = 0;
        (void)hipGetDevice(&dev); (void)hipDeviceGetAttribute(&cus, hipDeviceAttributeMultiprocessorCount, dev);
        if (hipFuncSetAttribute((const void*)fwd_mega, hipFuncAttributeMaxDynamicSharedMemorySize, LDS_TOTAL) != hipSuccess) { fprintf(stderr, "kernel_launch: hipFuncSetAttribute failed\n"); grid = -1; return; }
        if (hipOccupancyMaxActiveBlocksPerMultiprocessor(&per_cu, (const void*)fwd_mega, NTHREADS, LDS_TOTAL) != hipSuccess || per_cu < 1) { fprintf(stderr, "kernel_launch: occupancy query says %d blocks per CU\n", per_cu); per_cu = 1; }
        (void)hipGetLastError();
        grid = cus > 0 ? cus : 256;
    }
    if (grid < 0) return;
    Args a{};
    for (int i = 0; i < 15; ++i) a.in[i] = (const float*)d_in[i];
    a.out = (float*)d_out; a.ws = (unsigned char*)d_ws;
#if MK_N_LAUNCHES == 1
    a.ph_lo = 0; a.ph_hi = NPHASES;
    (void)hipMemsetAsync(d_ws, 0, 16384, stream);
    void* args[] = {&a};
    hipError_t e = hipLaunchCooperativeKernel((const void*)fwd_mega, dim3(grid), dim3(NTHREADS), args, LDS_TOTAL, stream);
    if (e != hipSuccess) fprintf(stderr, "kernel_launch: cooperative launch failed: %s (grid %d)\n", hipGetErrorString(e), grid);
#else
    for (int ph = 0; ph < NPHASES; ++ph) { a.ph_lo = ph; a.ph_hi = ph + 1; hipLaunchKernelGGL(fwd_mega, dim3(grid), dim3(NTHREADS), LDS_TOTAL, stream, a); }
#endif
}
```

```cpp
#include <hip/hip_runtime.h>
#include <hip/hip_bf16.h>
#include <hip/hip_cooperative_groups.h>
#include <cstdio>
#include <cstdint>
#include <cmath>
namespace cg = cooperative_groups;
#ifndef MK_N_LAUNCHES
#define MK_N_LAUNCHES 1
#endif
__device__ __forceinline__ int tidx() { int t = threadIdx.x; asm volatile("" : "+v"(t)); return t; }
namespace pg8 {
#define PG8_LAS __attribute__((address_space(3)))
typedef unsigned short bf16_t;
typedef short bf16x8 __attribute__((ext_vector_type(8)));
typedef float f32x4 __attribute__((ext_vector_type(4)));
typedef unsigned u32x4 __attribute__((ext_vector_type(4)));
constexpr int BM = 256, BK = 64, HALF = 128, HTB = HALF * BK * 2  , STAGE_BYTES = 8 * HTB, NXCD = 8, WGM = 8;

__host__ __device__ __forceinline__ int lds_byte(int r, int c) { const int st = (r >> 4) * 2 + (c >> 5), rr = r & 15, cc = c & 31, ob = rr * 64 + cc * 2; return st * 1024 + (ob ^ (((ob >> 9) & 1) << 5)); }
__host__ __device__ __forceinline__ void stage_rc(int b, int& R, int& C) { const int st = b / 1024, sb = b % 1024, swz = sb ^ (((sb >> 9) & 1) << 5); R = (st >> 1) * 16 + swz / 64; C = (st & 1) * 32 + (swz % 64) / 2; }
__host__ __device__ __forceinline__ int perm32(int rho) { const int n = rho >> 4, i = rho & 15; return 8 * (i >> 2) + 4 * n + (i & 3); }

struct Unit { int pm, pn; };
struct Gemm { const bf16_t* A; const bf16_t* Bt; int M, N, K; };

struct StaticOrder {
    int nM, nN, nwg, G, c, wgm;
    __host__ __device__ void init(int M, int N, int G_, int c_, int wgm_ = WGM) { nM = M / BM; nN = N / BM; nwg = nM * nN; G = G_; c = c_; wgm = wgm_; }
    __host__ __device__ bool next(int i, Unit& u) const {
        const long L = (long)i * G + c; if (L >= nwg) return false;
        int wgid = (int)L; { const int q = nwg / NXCD, r = nwg % NXCD, xcd = wgid % NXCD, off = wgid / NXCD; wgid = (xcd < r ? xcd * (q + 1) : r * (q + 1) + (xcd - r) * q) + off; }
        const int nig = wgm * nN, gid = wgid / nig, fm = gid * wgm, gsz = (nM - fm) < wgm ? (nM - fm) : wgm;
        u.pm = fm + ((wgid % nig) % gsz); u.pn = (wgid % nig) / gsz; return true;
    }
    __device__ __forceinline__ void a_ready(const Unit&) const {}
    __device__ __forceinline__ void done(const Unit&) const {}
};

__device__ __forceinline__ unsigned cvt_pk_bf16(float lo, float hi) { unsigned r; asm volatile("v_cvt_pk_bf16_f32 %0, %1, %2" : "=v"(r) : "v"(lo), "v"(hi)); return r; }
template <int ACT> struct EpiBf16 {
    static constexpr bool PERM = true, AFTER_DRAIN = false;
    bf16_t* O; int ldc; int split_cols; size_t split_stride; float scale0;
    const float* ss; const float* sw; int sw_stride; int rows_per_batch;
    bf16_t* cu_out; int cu_from;
    float* nrm;
    __device__ __forceinline__ void operator()(const f32x4 (&acc)[2][2][4][2], const Unit& u, int wr, int wc, int fr, int fq) const {
        const int row0 = u.pm * BM + wr * 64 + fr; int colt = u.pn * BM; bf16_t* base = O;
        const bool do_nrm = nrm != nullptr && u.pn < 16;
        float sc = 1.f; if (split_cols) { const int t = colt / split_cols; base += (size_t)t * split_stride; colt -= t * split_cols; if (t == 0) sc = scale0; }
        const int col0 = colt + wc * 32 + 8 * fq;
        f32x4 swv[2][2];
        if (ss) { const float* swp = sw + (size_t)((u.pm * BM) / rows_per_batch) * sw_stride + u.pn * BM + wc * 32 + 8 * fq;
#pragma unroll
            for (int bj = 0; bj < 2; ++bj)
#pragma unroll
                for (int n = 0; n < 2; ++n) swv[bj][n] = *(const f32x4*)(swp + bj * HALF + 4 * n); }
#pragma unroll
        for (int ai = 0; ai < 2; ++ai)
#pragma unroll
            for (int m = 0; m < 4; ++m) { const int row = row0 + ai * HALF + m * 16; bf16_t* rowp = base + (size_t)row * ldc + col0;
                float inv = 1.f;
                if (ss) { const f32x4* sp = (const f32x4*)(ss + (size_t)row * 32 + fq * 8); const f32x4 p0 = sp[0], p1 = sp[1];
                    float s = ((p0[0] + p0[1]) + (p0[2] + p0[3])) + ((p1[0] + p1[1]) + (p1[2] + p1[3]));
                    s += __shfl_xor(s, 16); s += __shfl_xor(s, 32); inv = 1.0f / sqrtf(s * (1.f / 2048.f) + 1e-6f); }
                f32x4 va[2][2];
#pragma unroll
                for (int bj = 0; bj < 2; ++bj) { f32x4 v0 = acc[ai][bj][m][0], v1 = acc[ai][bj][m][1];
                    if (ss) { v0 = v0 * inv + swv[bj][0]; v1 = v1 * inv + swv[bj][1]; }
                    if (ACT == 2) { v0 = __builtin_elementwise_max(v0, (f32x4){0.f, 0.f, 0.f, 0.f}); v1 = __builtin_elementwise_max(v1, (f32x4){0.f, 0.f, 0.f, 0.f}); v0 = v0 * v0; v1 = v1 * v1; }
                    v0 = v0 * sc; v1 = v1 * sc;
                    if (do_nrm) { float s2 = ((v0[0] * v0[0] + v0[1] * v0[1]) + (v0[2] * v0[2] + v0[3] * v0[3])) + ((v1[0] * v1[0] + v1[1] * v1[1]) + (v1[2] * v1[2] + v1[3] * v1[3]));
                        s2 += __shfl_xor(s2, 16); s2 += __shfl_xor(s2, 32);
                        if (fq == 0) nrm[((size_t)(((u.pn >> 3) * 4 + (row >> 12)) * 16 + (u.pn & 7) * 2 + bj) * 4096 + (row & 4095)) * 4 + wc] = s2; }
                    va[bj][0] = v0; va[bj][1] = v1; }
                if (cu_out != nullptr && u.pn >= cu_from) {
                    const f32x4 p0 = va[0][0] * va[1][0], p1 = va[0][1] * va[1][1];
                    u32x4 w; w.x = cvt_pk_bf16(p0[0], p0[1]); w.y = cvt_pk_bf16(p0[2], p0[3]); w.z = cvt_pk_bf16(p1[0], p1[1]); w.w = cvt_pk_bf16(p1[2], p1[3]);
                    *(u32x4*)(cu_out + (size_t)row * ldc + (u.pn - cu_from) * HALF + wc * 32 + 8 * fq) = w;
                } else {
#pragma unroll
                    for (int bj = 0; bj < 2; ++bj) { const f32x4 v0 = va[bj][0], v1 = va[bj][1];
                        u32x4 w; w.x = cvt_pk_bf16(v0[0], v0[1]); w.y = cvt_pk_bf16(v0[2], v0[3]); w.z = cvt_pk_bf16(v1[0], v1[1]); w.w = cvt_pk_bf16(v1[2], v1[3]);
                        *(u32x4*)(rowp + bj * HALF) = w; } } }
    }
};
struct EpiRes {
    static constexpr bool PERM = true, AFTER_DRAIN = false;
    const float* base32; const bf16_t* base16; float* out32; bf16_t* out16; int ldc; const float* gate; int rows_per_batch; int gate_stride;
    bf16_t* An; const float* n_gain; const float* n_scale; float* ss;
    __device__ __forceinline__ void operator()(const f32x4 (&acc)[2][2][4][2], const Unit& u, int wr, int wc, int fr, int fq) const {
        const int bidx = (u.pm * BM) / rows_per_batch; const float* g = gate + (size_t)bidx * gate_stride;
        const int col0 = u.pn * BM + wc * 32 + 8 * fq;
        f32x4 gv[2][2], cav[2][2];
#pragma unroll
        for (int bj = 0; bj < 2; ++bj)
#pragma unroll
            for (int n = 0; n < 2; ++n) { gv[bj][n] = *(const f32x4*)(g + col0 + bj * HALF + 4 * n);
                if (An) cav[bj][n] = *(const f32x4*)(n_gain + col0 + bj * HALF + 4 * n) * (*(const f32x4*)(n_scale + (size_t)bidx * gate_stride + col0 + bj * HALF + 4 * n) + 1.f); }
#pragma unroll
        for (int h = 0; h < 4; ++h) { const int ai = h >> 1, m0 = (h & 1) * 2;
            f32x4 pre[2][2][2];
            if (base32) {
#pragma unroll
                for (int mm = 0; mm < 2; ++mm) { const size_t off = (size_t)(u.pm * BM + ai * HALF + wr * 64 + (m0 + mm) * 16 + fr) * ldc + col0;
#pragma unroll
                    for (int bj = 0; bj < 2; ++bj)
#pragma unroll
                        for (int n = 0; n < 2; ++n) pre[mm][bj][n] = *(const f32x4*)(base32 + off + bj * HALF + 4 * n); }
            } else { u32x4 raw[2][2];
#pragma unroll
                for (int mm = 0; mm < 2; ++mm) { const size_t off = (size_t)(u.pm * BM + ai * HALF + wr * 64 + (m0 + mm) * 16 + fr) * ldc + col0;
#pragma unroll
                    for (int bj = 0; bj < 2; ++bj) raw[mm][bj] = *(const u32x4*)(base16 + off + bj * HALF); }
#pragma unroll
                for (int mm = 0; mm < 2; ++mm)
#pragma unroll
                    for (int bj = 0; bj < 2; ++bj) { const u32x4 w = raw[mm][bj];
                        pre[mm][bj][0] = (f32x4){__uint_as_float(w.x << 16), __uint_as_float(w.x & 0xffff0000u), __uint_as_float(w.y << 16), __uint_as_float(w.y & 0xffff0000u)};
                        pre[mm][bj][1] = (f32x4){__uint_as_float(w.z << 16), __uint_as_float(w.z & 0xffff0000u), __uint_as_float(w.w << 16), __uint_as_float(w.w & 0xffff0000u)}; } }
#pragma unroll
            for (int mm = 0; mm < 2; ++mm) { const int m = m0 + mm; const int row = u.pm * BM + ai * HALF + wr * 64 + m * 16 + fr; const size_t off = (size_t)row * ldc + col0;
                float ssum = 0.f;
#pragma unroll
                for (int bj = 0; bj < 2; ++bj) { f32x4 o[2];
#pragma unroll
                    for (int n = 0; n < 2; ++n) { o[n] = pre[mm][bj][n] + gv[bj][n] * acc[ai][bj][m][n];
                        ssum += (o[n][0] * o[n][0] + o[n][1] * o[n][1]) + (o[n][2] * o[n][2] + o[n][3] * o[n][3]); }
                    if (out32) { *(f32x4*)(out32 + off + bj * HALF) = o[0]; *(f32x4*)(out32 + off + bj * HALF + 4) = o[1]; }
                    else { u32x4 w; w.x = cvt_pk_bf16(o[0][0], o[0][1]); w.y = cvt_pk_bf16(o[0][2], o[0][3]); w.z = cvt_pk_bf16(o[1][0], o[1][1]); w.w = cvt_pk_bf16(o[1][2], o[1][3]); *(u32x4*)(out16 + off + bj * HALF) = w; }
                    if (An) { const f32x4 a0 = o[0] * cav[bj][0], a1 = o[1] * cav[bj][1]; u32x4 w; w.x = cvt_pk_bf16(a0[0], a0[1]); w.y = cvt_pk_bf16(a0[2], a0[3]); w.z = cvt_pk_bf16(a1[0], a1[1]); w.w = cvt_pk_bf16(a1[2], a1[3]);
                        *(u32x4*)(An + off + bj * HALF) = w; } }
                if (An) { ssum += __shfl_xor(ssum, 16); ssum += __shfl_xor(ssum, 32); if (fq == 0) ss[(size_t)row * 32 + u.pn * 4 + wc] = ssum; } }
            asm volatile("" ::: "memory");
        }
    }
};
struct EpiNull {
    static constexpr bool PERM = true, AFTER_DRAIN = false; bf16_t* O;
    __device__ __forceinline__ void operator()(const f32x4 (&acc)[2][2][4][2], const Unit& u, int wr, int wc, int fr, int fq) const {
        float s = 0.f;
#pragma unroll
        for (int ai = 0; ai < 2; ++ai)
#pragma unroll
            for (int bj = 0; bj < 2; ++bj)
#pragma unroll
                for (int m = 0; m < 4; ++m)
#pragma unroll
                    for (int n = 0; n < 2; ++n) s += acc[ai][bj][m][n][0] + acc[ai][bj][m][n][1] + acc[ai][bj][m][n][2] + acc[ai][bj][m][n][3];
        if (s == 1.2345e-30f) O[0] = 1;
    }
};
struct EpiCoal {
    static constexpr bool PERM = true, AFTER_DRAIN = false; bf16_t* O;
    __device__ __forceinline__ void operator()(const f32x4 (&acc)[2][2][4][2], const Unit& u, int wr, int wc, int fr, int fq) const {
        bf16_t* base = O + ((size_t)((u.pm * 32 + u.pn) & 511) * 65536) + (size_t)(wr * 4 + wc) * 8192 + (size_t)(fq * 16 + fr) * 8;
#pragma unroll
        for (int ai = 0; ai < 2; ++ai)
#pragma unroll
            for (int m = 0; m < 4; ++m)
#pragma unroll
                for (int bj = 0; bj < 2; ++bj) { f32x4 v0 = acc[ai][bj][m][0], v1 = acc[ai][bj][m][1];
                    v0 = __builtin_elementwise_max(v0, (f32x4){0.f, 0.f, 0.f, 0.f}); v1 = __builtin_elementwise_max(v1, (f32x4){0.f, 0.f, 0.f, 0.f}); v0 = v0 * v0; v1 = v1 * v1;
                    u32x4 w; w.x = cvt_pk_bf16(v0[0], v0[1]); w.y = cvt_pk_bf16(v0[2], v0[3]); w.z = cvt_pk_bf16(v1[0], v1[1]); w.w = cvt_pk_bf16(v1[2], v1[3]);
                    *(u32x4*)(base + (size_t)((ai * 4 + m) * 2 + bj) * 512) = w; }
    }
};
template <class Epi, class Sched, bool ALIGN_EPI = false, bool SP2 = false>
__device__ __forceinline__ void gemm_phase(PG8_LAS unsigned char* lds, const Gemm g, const Sched& S, const Epi& E) {
    const int tid = tidx(), wid = __builtin_amdgcn_readfirstlane(tid >> 6), lane = tid & 63, wr = wid >> 2, wc = wid & 3, fr = lane & 15, fq = lane >> 4;
    const int K = g.K, nt = K / BK;
    unsigned voffA[2], voffB[2];
#pragma unroll
    for (int i = 0; i < 2; ++i) { int R, C; stage_rc(tid * 16 + i * 8192, R, C); const int Rb = Epi::PERM ? ((R & ~31) + perm32(R & 31)) : R;
        voffA[i] = (unsigned)(R * K + C) * 2u; voffB[i] = (unsigned)(Rb * K + C) * 2u; }
    const size_t kstep = (size_t)(BK * 2);
    const size_t hstep = (size_t)HALF * K * 2;
    const size_t tstep = 2 * hstep;
    const unsigned ldsw = (unsigned)wid * 1024u;
    const int aoff = lds_byte(wr * 64 + fr, fq * 8), boff = lds_byte(wc * 32 + fr, fq * 8);
#define PG8_SA(b, h) (((b) * 2 + (h)) * HTB)
#define PG8_SB(b, h) ((4 + (b) * 2 + (h)) * HTB)
#define PG8_STAGE(bufoff, gbase, voff) do { _Pragma("unroll") for (int _i = 0; _i < 2; ++_i) \
        __builtin_amdgcn_global_load_lds((const unsigned*)((const char*)(gbase) + (voff)[_i]), (PG8_LAS unsigned*)(lds + (bufoff) + ldsw + _i * 8192), 16, 0, 0); } while (0)
#define PG8_LDA(dst, b, h) do { _Pragma("unroll") for (int m = 0; m < 4; ++m) _Pragma("unroll") for (int k = 0; k < 2; ++k) dst[m][k] = *(const PG8_LAS bf16x8*)(lds + PG8_SA(b, h) + aoff + m * 2048 + k * 1024); } while (0)
#define PG8_LDB(dst, b, h) do { _Pragma("unroll") for (int n = 0; n < 2; ++n) _Pragma("unroll") for (int k = 0; k < 2; ++k) dst[n][k] = *(const PG8_LAS bf16x8*)(lds + PG8_SB(b, h) + boff + n * 2048 + k * 1024); } while (0)
#define PG8_MMA(ai, bj, At, Bt) do { __builtin_amdgcn_s_setprio(1); _Pragma("unroll") for (int m = 0; m < 4; ++m) _Pragma("unroll") for (int n = 0; n < 2; ++n) _Pragma("unroll") for (int k = 0; k < 2; ++k) \
        acc[ai][bj][m][n] = __builtin_amdgcn_mfma_f32_16x16x32_bf16(Bt[n][k], At[m][k], acc[ai][bj][m][n], 0, 0, 0); __builtin_amdgcn_s_setprio(0); } while (0)
#define PG8_WAIT_V(n) asm volatile("s_waitcnt vmcnt(" #n ")" ::: "memory")
#define PG8_WAIT_L(n) asm volatile("s_waitcnt lgkmcnt(" #n ")" ::: "memory")
#define PG8_BAR __builtin_amdgcn_s_barrier()
#define PG8_SCHED __builtin_amdgcn_sched_barrier(0)
    Unit cur, nxt; int ui = 0;
    if (!S.next(0, cur)) return;
    f32x4 acc[2][2][4][2];
#pragma unroll
    for (int a = 0; a < 2; ++a)
#pragma unroll
        for (int b = 0; b < 2; ++b)
#pragma unroll
            for (int m = 0; m < 4; ++m)
#pragma unroll
                for (int n = 0; n < 2; ++n) acc[a][b][m][n] = (f32x4){0.f, 0.f, 0.f, 0.f};
    bf16x8 At[4][2], B0[2][2], B1[2][2];
    const char* cA = (const char*)g.A + (size_t)cur.pm * tstep; const char* cB = (const char*)g.Bt + (size_t)cur.pn * tstep;
    S.a_ready(cur);
    if constexpr (SP2) {
        PG8_STAGE(PG8_SB(0, 0), cB, voffB); PG8_STAGE(PG8_SB(0, 1), cB + hstep, voffB); PG8_STAGE(PG8_SA(0, 0), cA, voffA); PG8_STAGE(PG8_SA(0, 1), cA + hstep, voffA);
        if (wr == 1) PG8_BAR;
        PG8_WAIT_V(2); PG8_BAR;
        PG8_STAGE(PG8_SB(1, 0), cB + kstep, voffB); PG8_STAGE(PG8_SA(1, 0), cA + kstep, voffA); PG8_STAGE(PG8_SB(1, 1), cB + hstep + kstep, voffB);
        PG8_WAIT_V(6); PG8_BAR;
    } else {
        PG8_STAGE(PG8_SB(0, 0), cB, voffB); PG8_STAGE(PG8_SA(0, 0), cA, voffA); PG8_STAGE(PG8_SB(0, 1), cB + hstep, voffB); PG8_STAGE(PG8_SA(0, 1), cA + hstep, voffA);
        if (wr == 1) PG8_BAR;
        PG8_WAIT_V(4); PG8_BAR;
        PG8_STAGE(PG8_SB(1, 0), cB + kstep, voffB); PG8_STAGE(PG8_SA(1, 0), cA + kstep, voffA); PG8_STAGE(PG8_SB(1, 1), cB + hstep + kstep, voffB);
        PG8_WAIT_V(6); PG8_BAR;
    }
    for (;;) {
        const bool has_next = S.next(ui + 1, nxt);
        const char* nA = has_next ? (const char*)g.A + (size_t)nxt.pm * tstep : cA; const char* nB = has_next ? (const char*)g.Bt + (size_t)nxt.pn * tstep : cB;
        for (int t = 0; t < nt; t += 2) {
            const bool last = (t == nt - 2);
            const char* a1 = cA + (size_t)(t + 1) * kstep;
            const char* a2 = last ? nA : cA + (size_t)(t + 2) * kstep; const char* b2 = last ? nB : cB + (size_t)(t + 2) * kstep;
            const char* a3 = a2 + kstep; const char* b3 = b2 + kstep;
            if (last && has_next) S.a_ready(nxt);
            if constexpr (SP2) {
            PG8_LDB(B0, 0, 0); PG8_LDB(B1, 0, 1); PG8_SCHED; PG8_LDA(At, 0, 0); PG8_STAGE(PG8_SA(1, 1), a1 + hstep, voffA);
            PG8_WAIT_V(8); PG8_WAIT_L(0); PG8_BAR; PG8_MMA(0, 0, At, B0); PG8_MMA(0, 1, At, B1); PG8_BAR; PG8_SCHED;
            PG8_LDA(At, 0, 1); PG8_STAGE(PG8_SB(0, 0), b2, voffB); PG8_STAGE(PG8_SB(0, 1), b2 + hstep, voffB); PG8_STAGE(PG8_SA(0, 0), a2, voffA);
            PG8_WAIT_V(8); PG8_WAIT_L(0); PG8_BAR; PG8_MMA(1, 0, At, B0); PG8_MMA(1, 1, At, B1); PG8_BAR; PG8_SCHED;
            PG8_LDB(B0, 1, 0); PG8_LDB(B1, 1, 1); PG8_SCHED; PG8_LDA(At, 1, 0); PG8_STAGE(PG8_SA(0, 1), a2 + hstep, voffA);
            PG8_WAIT_V(8); PG8_WAIT_L(0); PG8_BAR; PG8_MMA(0, 0, At, B0); PG8_MMA(0, 1, At, B1); PG8_BAR; PG8_SCHED;
            PG8_LDA(At, 1, 1); PG8_STAGE(PG8_SB(1, 0), b3, voffB); PG8_STAGE(PG8_SB(1, 1), b3 + hstep, voffB); PG8_STAGE(PG8_SA(1, 0), a3, voffA);
            PG8_WAIT_V(8); PG8_WAIT_L(0); PG8_BAR; PG8_MMA(1, 0, At, B0); PG8_MMA(1, 1, At, B1); PG8_BAR; PG8_SCHED;
            } else {
            PG8_LDB(B0, 0, 0); PG8_SCHED; PG8_LDA(At, 0, 0); PG8_STAGE(PG8_SA(1, 1), a1 + hstep, voffA);
            PG8_WAIT_L(8); PG8_BAR; PG8_WAIT_L(0); PG8_MMA(0, 0, At, B0); PG8_BAR; PG8_SCHED;
            PG8_LDB(B1, 0, 1); PG8_STAGE(PG8_SB(0, 0), b2, voffB);
            PG8_BAR; PG8_WAIT_L(0); PG8_MMA(0, 1, At, B1); PG8_BAR;
            PG8_LDA(At, 0, 1); PG8_STAGE(PG8_SA(0, 0), a2, voffA);
            PG8_BAR; PG8_WAIT_L(0); PG8_MMA(1, 0, At, B0); PG8_BAR; PG8_SCHED;
            PG8_STAGE(PG8_SB(0, 1), b2 + hstep, voffB);
            PG8_WAIT_V(6); PG8_BAR; PG8_MMA(1, 1, At, B1); PG8_BAR;
            PG8_LDB(B0, 1, 0); PG8_SCHED; PG8_LDA(At, 1, 0); PG8_STAGE(PG8_SA(0, 1), a2 + hstep, voffA);
            PG8_WAIT_L(8); PG8_BAR; PG8_WAIT_L(0); PG8_MMA(0, 0, At, B0); PG8_BAR; PG8_SCHED;
            PG8_LDB(B1, 1, 1); PG8_STAGE(PG8_SB(1, 0), b3, voffB);
            PG8_BAR; PG8_WAIT_L(0); PG8_MMA(0, 1, At, B1); PG8_BAR;
            PG8_LDA(At, 1, 1); PG8_STAGE(PG8_SA(1, 0), a3, voffA);
            PG8_BAR; PG8_WAIT_L(0); PG8_MMA(1, 0, At, B0); PG8_BAR; PG8_SCHED;
            PG8_STAGE(PG8_SB(1, 1), b3 + hstep, voffB);
            PG8_WAIT_V(6); PG8_BAR; PG8_MMA(1, 1, At, B1); PG8_BAR;
            }
        }
        if constexpr (ALIGN_EPI) { if (wr == 0) PG8_BAR; }
        if constexpr (!Epi::AFTER_DRAIN) { E(acc, cur, wr, wc, fr, fq); S.done(cur); }
        if (!has_next) break;
#pragma unroll
        for (int a = 0; a < 2; ++a)
#pragma unroll
            for (int b = 0; b < 2; ++b)
#pragma unroll
                for (int m = 0; m < 4; ++m)
#pragma unroll
                    for (int n = 0; n < 2; ++n) acc[a][b][m][n] = (f32x4){0.f, 0.f, 0.f, 0.f};
        cur = nxt; cA = nA; cB = nB; ++ui;
        if constexpr (ALIGN_EPI) { if (wr == 1) PG8_BAR; }
    }
    PG8_WAIT_V(0);
    if constexpr (!ALIGN_EPI) { if (wr == 0) PG8_BAR; }
    PG8_BAR;
    if constexpr (Epi::AFTER_DRAIN) { E.fused(acc, cur, wr, wc, fr, fq, lds, wid, lane); S.done(cur); }
#undef PG8_SA
#undef PG8_SB
#undef PG8_STAGE
#undef PG8_LDA
#undef PG8_LDB
#undef PG8_MMA
#undef PG8_WAIT_V
#undef PG8_WAIT_L
#undef PG8_BAR
#undef PG8_SCHED
}
}
namespace att {
enum { ORDER_NATURAL = 0, ORDER_REVERSED = 1, ORDER_PAIRED = 2, ORDER_XCD = 4 };
constexpr int D = 128, PITCH = 2048;
constexpr float THR = 8.f;
constexpr bool WSKIP = false;
constexpr int NW = 8, QBLK = 32, KVBLK = 64, QB = NW * QBLK;
constexpr int SHM_V = KVBLK * D * 2, SHM_K = KVBLK * D * 2;
constexpr int LDS_BYTES = 2 * SHM_V + 2 * SHM_K + NW * 64 * 4;


using bf16 = __hip_bfloat16;
typedef short bf16x8 __attribute__((ext_vector_type(8)));
typedef short s16x4 __attribute__((ext_vector_type(4)));
typedef float f32x16 __attribute__((ext_vector_type(16)));
typedef float f32x4 __attribute__((ext_vector_type(4)));
typedef unsigned u32x4 __attribute__((ext_vector_type(4)));
template <class A, class Bt> struct same_t { static constexpr bool v = false; };
template <class A> struct same_t<A, A> { static constexpr bool v = true; };

#define KSWZ(row, colB) ((row) * 256 + ((colB) ^ (((row) & 7) << 4)))
#define SBAR() __builtin_amdgcn_sched_barrier(0)
__device__ __forceinline__ int v_st(int k, int c) { const int kk = (k & ~0xC) | ((k & 4) << 1) | ((k & 8) >> 1); return ((kk >> 3) * 4 + (c >> 5)) * 512 + ((kk & 7) * 32 + (c & 31)) * 2; }
__device__ __forceinline__ int v_rd_base(int lane) { return ((lane & 3) << 3) | (((lane >> 2) & 3) << 6) | (((lane >> 4) & 1) << 5) | (((lane >> 5) & 1) << 8); }
constexpr int v_rd_off(int d0, int ks, int half) { return d0 * 512 + ks * 4096 + half * 2048; }
__device__ __forceinline__ int crow(int r, int hi) { return (r & 3) + 8 * (r >> 2) + 4 * hi; }
__device__ __forceinline__ unsigned cvtpk(float lo, float hi) {
    unsigned r; asm volatile("v_cvt_pk_bf16_f32 %0, %1, %2" : "=v"(r) : "v"(lo), "v"(hi)); return r;
}
__device__ __forceinline__ bf16x8 pack8(f32x4 a, f32x4 b) {
    u32x4 w = {cvtpk(a[0], a[1]), cvtpk(a[2], a[3]), cvtpk(b[0], b[1]), cvtpk(b[2], b[3])};
    return *reinterpret_cast<bf16x8*>(&w);
}
template <class T> __device__ __forceinline__ bf16x8 load8(const T* p) {
    if constexpr (same_t<T, float>::v) { return pack8(*(const f32x4*)p, *(const f32x4*)(p + 4)); }
    else { return *reinterpret_cast<const bf16x8*>(p); }
}
__device__ __forceinline__ void mask_tile(f32x16& p0, f32x16& p1, int dq, unsigned W) {
    const float NEG = -__builtin_inff();
#pragma unroll
    for (int r = 0; r < 16; ++r) {
        const int c = (r & 3) + 8 * (r >> 2);
        if ((unsigned)(dq - c) >= W) p0[r] = NEG;
        if ((unsigned)(dq - c - 32) >= W) p1[r] = NEG;
    }
}
__device__ __forceinline__ void partialSM(f32x16& p0, f32x16& p1, float& m_reg, float& mn, float& alpha) {
    float pmax = p0[0]; for (int r = 1; r < 16; ++r) pmax = fmaxf(pmax, p0[r]); for (int r = 0; r < 16; ++r) pmax = fmaxf(pmax, p1[r]);
    { auto rr = __builtin_amdgcn_permlane32_swap(__float_as_uint(pmax), __float_as_uint(pmax), false, false);
      pmax = fmaxf(__uint_as_float(rr[0]), __uint_as_float(rr[1])); }
    if (__builtin_expect(__all((pmax - m_reg) <= THR), 1)) { mn = m_reg; alpha = 1.f; }
    else { mn = fmaxf(m_reg, pmax); alpha = __builtin_amdgcn_exp2f(m_reg - mn); m_reg = mn; }
    for (int r = 0; r < 16; ++r) p0[r] = p0[r] - mn; for (int r = 0; r < 16; ++r) p1[r] = p1[r] - mn;
    for (int r = 0; r < 16; ++r) p0[r] = __builtin_amdgcn_exp2f(p0[r]);
}
__device__ __forceinline__ void finishSM(f32x16& p0, f32x16& p1, float alpha, float& l_reg, bf16x8& pa0, bf16x8& pa1, bf16x8& pa2, bf16x8& pa3) {
    for (int r = 0; r < 16; ++r) p1[r] = __builtin_amdgcn_exp2f(p1[r]);
    float ps = 0; for (int r = 0; r < 16; ++r) ps += p0[r]; for (int r = 0; r < 16; ++r) ps += p1[r];
    { auto rr = __builtin_amdgcn_permlane32_swap(__float_as_uint(ps), __float_as_uint(ps), false, false);
      ps = __uint_as_float(rr[0]) + __uint_as_float(rr[1]); }
    l_reg = l_reg * alpha + ps;
#define PK4(P, B_, OUT) do { unsigned a0 = cvtpk(P[B_+0], P[B_+1]), a1 = cvtpk(P[B_+2], P[B_+3]);                          \
        unsigned b0 = cvtpk(P[B_+4], P[B_+5]), b1 = cvtpk(P[B_+6], P[B_+7]);                                             \
        auto r0 = __builtin_amdgcn_permlane32_swap(a0, b0, false, false); auto r1 = __builtin_amdgcn_permlane32_swap(a1, b1, false, false); \
        u32x4 w = {r0[0], r1[0], r0[1], r1[1]}; OUT = *reinterpret_cast<bf16x8*>(&w); } while (0)
    PK4(p0, 0, pa0); PK4(p0, 8, pa1); PK4(p1, 0, pa2); PK4(p1, 8, pa3);
#undef PK4
}
template <int KB, bool SK>
__device__ __forceinline__ void qkt(f32x16& p0, f32x16& p1, const char* K_lds, int r32, int hi, const bf16x8* qr, bool act, const char* Ft) {
    if (SK && !act) { const float NEG = -__builtin_inff();
#pragma unroll
        for (int r = 0; r < 16; ++r) { p0[r] = NEG; p1[r] = NEG; } return; }
    { const f32x4* fp = (const f32x4*)Ft;
      const f32x4 a0 = fp[0], a1 = fp[2], a2 = fp[4], a3 = fp[6], b0_ = fp[8], b1_ = fp[10], b2_ = fp[12], b3_ = fp[14];
      p0 = (f32x16){a0[0], a0[1], a0[2], a0[3], a1[0], a1[1], a1[2], a1[3], a2[0], a2[1], a2[2], a2[3], a3[0], a3[1], a3[2], a3[3]};
      p1 = (f32x16){b0_[0], b0_[1], b0_[2], b0_[3], b1_[0], b1_[1], b1_[2], b1_[3], b2_[0], b2_[1], b2_[2], b2_[3], b3_[0], b3_[1], b3_[2], b3_[3]}; }
    const char* kb[4];
#pragma unroll
    for (int dd = 0; dd < 4; ++dd) kb[dd] = K_lds + KB * SHM_K + KSWZ(r32, (dd * 16 + hi * 8) * 2);
#pragma unroll
    for (int d0 = 0; d0 < 8; ++d0) { const char* a = kb[d0 & 3] + (d0 >> 2) * 128;
        bf16x8 b0 = *reinterpret_cast<const bf16x8*>(a);
        bf16x8 b1 = *reinterpret_cast<const bf16x8*>(a + 32 * 256);
        p0 = __builtin_amdgcn_mfma_f32_32x32x16_bf16(b0, qr[d0], p0, 0, 0, 0);
        p1 = __builtin_amdgcn_mfma_f32_32x32x16_bf16(b1, qr[d0], p1, 0, 0, 0); }
}
template <int VB, bool SK>
__device__ __forceinline__ void pv_tile(f32x16* o, int vb0, bf16x8 pa0, bf16x8 pa1, bf16x8 pa2, bf16x8 pa3, bool act) {
    if (SK && !act) return;
#define TRRD(dst, off) asm volatile("ds_read_b64_tr_b16 %0, %1 offset:%2" : "=&v"(dst) : "v"(vb0), "i"(off) : "memory")
#define PV_D0(d0) do { s16x4 l0, l1, l2, l3, h0, h1, h2, h3; constexpr int b_ = VB * SHM_V + v_rd_off(d0, 0, 0);     \
        TRRD(l0, b_); TRRD(h0, b_ + 2048); TRRD(l1, b_ + 4096); TRRD(h1, b_ + 6144); TRRD(l2, b_ + 8192); TRRD(h2, b_ + 10240); TRRD(l3, b_ + 12288); TRRD(h3, b_ + 14336); \
        asm volatile("s_waitcnt lgkmcnt(0)" ::: "memory"); SBAR();                 \
        o[d0] = __builtin_amdgcn_mfma_f32_32x32x16_bf16(pa0, (bf16x8){l0[0], l0[1], l0[2], l0[3], h0[0], h0[1], h0[2], h0[3]}, o[d0], 0, 0, 0);   \
        o[d0] = __builtin_amdgcn_mfma_f32_32x32x16_bf16(pa1, (bf16x8){l1[0], l1[1], l1[2], l1[3], h1[0], h1[1], h1[2], h1[3]}, o[d0], 0, 0, 0);   \
        o[d0] = __builtin_amdgcn_mfma_f32_32x32x16_bf16(pa2, (bf16x8){l2[0], l2[1], l2[2], l2[3], h2[0], h2[1], h2[2], h2[3]}, o[d0], 0, 0, 0);   \
        o[d0] = __builtin_amdgcn_mfma_f32_32x32x16_bf16(pa3, (bf16x8){l3[0], l3[1], l3[2], l3[3], h3[0], h3[1], h3[2], h3[3]}, o[d0], 0, 0, 0); } while (0)
    PV_D0(0); PV_D0(1); PV_D0(2); PV_D0(3);
#undef PV_D0
#undef TRRD
}

template <class TIn, class TOut> struct BlockRef { const TIn* Q; const TIn* K; const TIn* V; TOut* O; const float* F; int P0; int jlo; };
template <class TIn> struct Seam {
    bf16x8 qr[8];
    bf16x8 st_v0, st_v1, st_k0, st_k1; f32x4 sf0, sf1, sf2, sf3;
    f32x4 tq[16];
};
__device__ __forceinline__ int swa_jlo(int P0, int W) { const int lowk = P0 - W + 1; return lowk > 0 ? lowk / KVBLK : 0; }
#define ROW(p, k0, rr) ((p) + (size_t)((k0) + (rr)) * PITCH + sc)
#define VMW() asm volatile("s_waitcnt vmcnt(0)" ::: "memory")
#define VMWN(n) asm volatile("s_waitcnt vmcnt(%0)" :: "i"(n) : "memory")
#define GROW(p, k0, vo) ((const char*)((p) + (size_t)(k0) * PITCH) + (vo))
#define SLOAD_H(Kp, Vp, k0) do { S.st_v0 = *(const bf16x8*)GROW(Vp, k0, vo0); S.st_v1 = *(const bf16x8*)GROW(Vp, k0, vo1);              \
                         S.st_k0 = *(const bf16x8*)GROW(Kp, k0, vo0); S.st_k1 = *(const bf16x8*)GROW(Kp, k0, vo1); } while (0)
#define SWRITE_HK(bf) do { *(bf16x8*)(K_lds + (bf) * SHM_K + kws) = S.st_k0; *(bf16x8*)(K_lds + (bf) * SHM_K + kws + 32 * 256) = S.st_k1; } while (0)
#define SWRITE_HV(bf) do { *(bf16x8*)(V_lds + (bf) * SHM_V + vst0) = S.st_v0; *(bf16x8*)(V_lds + (bf) * SHM_V + vst1) = S.st_v1; } while (0)
#define SWRITE_H(bf) do { SWRITE_HV(bf); SWRITE_HK(bf); } while (0)
#define SLOAD_F(p, k0) do { S.sf0 = *(const f32x4*)ROW(p, k0, sr); S.sf1 = *(const f32x4*)(ROW(p, k0, sr) + 4);                \
                            S.sf2 = *(const f32x4*)ROW(p, k0, 32 + sr); S.sf3 = *(const f32x4*)(ROW(p, k0, 32 + sr) + 4); } while (0)
#define SWRITE_KF(bf) do { *(bf16x8*)(K_lds + (bf) * SHM_K + kws) = pack8(S.sf0, S.sf1); *(bf16x8*)(K_lds + (bf) * SHM_K + kws + 32 * 256) = pack8(S.sf2, S.sf3); } while (0)
#define SWRITE_VF(bf) do { *(bf16x8*)(V_lds + (bf) * SHM_V + vst0) = pack8(S.sf0, S.sf1); *(bf16x8*)(V_lds + (bf) * SHM_V + vst1) = pack8(S.sf2, S.sf3); } while (0)
template <class TIn, class TOut>
__device__ __forceinline__ void causal_swa_prime(const BlockRef<TIn, TOut>& cur, int W, char* lds, Seam<TIn>& S, char* Fdst) {
    constexpr bool F32 = same_t<TIn, float>::v;
    const int tid = tidx(), wid = __builtin_amdgcn_readfirstlane(tid >> 6), lane = tid & 63, r32 = lane & 31, hi = lane >> 5;
    const int sr = tid >> 4, sc = (tid & 15) * 8, kws = KSWZ(sr, sc * 2); char* K_lds = lds + 2 * SHM_V;
    const unsigned vo0 = (unsigned)(sr * PITCH + sc) * 2u, vo1 = vo0 + 32u * PITCH * 2u, qvo = (unsigned)(r32 * PITCH + hi * 8) * 2u;
    const int kb0 = cur.jlo * KVBLK;
    for (int d0 = 0; d0 < 8; ++d0) S.qr[d0] = *(const bf16x8*)((const char*)(cur.Q + (size_t)(wid * QBLK) * PITCH) + qvo + d0 * 32);
    if constexpr (F32) { SLOAD_F((const float*)cur.K, kb0); VMW(); SWRITE_KF(0); SBAR(); SLOAD_F((const float*)cur.V, kb0); }
    else { const f32x4 fa = *(const f32x4*)(cur.F + tid * 4), fb = *(const f32x4*)(cur.F + 2048 + tid * 4);
           SLOAD_H(cur.K, cur.V, kb0); VMW(); SWRITE_HK(0);
           *(f32x4*)(Fdst + tid * 16) = fa; *(f32x4*)(Fdst + 8192 + tid * 16) = fb; }
    __syncthreads();
}
template <class TIn, class TOut>
__device__ __forceinline__ void causal_swa_block(const BlockRef<TIn, TOut>& cur, const BlockRef<TIn, TOut>& nxt, int skv, int W, char* lds, Seam<TIn>& S, const char* Fcur, char* Fnext) {
    constexpr bool F32 = same_t<TIn, float>::v;
    const int tid = tidx(), wid = __builtin_amdgcn_readfirstlane(tid >> 6), lane = tid & 63, r32 = lane & 31, hi = lane >> 5;
    const int j_lo = cur.jlo;
    int j_hi = (cur.P0 + QB - 1) / KVBLK + 1; if (j_hi > skv / KVBLK) j_hi = skv / KVBLK;
    const int NT = j_hi - j_lo;
    const int kbn = nxt.jlo * KVBLK;
    const int qlo = cur.P0 + wid * QBLK, qm = qlo + r32 - 4 * hi;
    char* V_lds = lds; char* K_lds = lds + 2 * SHM_V;
    float* ws = (float*)(lds + 2 * SHM_V + 2 * SHM_K) + wid * 64; float* li_l = ws, * al_l = ws + 32;
    float m_reg = *(const float*)(Fcur + (size_t)(cur.P0 + wid * QBLK + r32) * 4), l_reg = 0; f32x16 o[4] = {};
    const unsigned vo0 = (unsigned)((tid >> 4) * PITCH + (tid & 15) * 8) * 2u, vo1 = vo0 + 32u * PITCH * 2u, qvo = (unsigned)(r32 * PITCH + hi * 8) * 2u;
    const int sr = tid >> 4, sc = (tid & 15) * 8, vst0 = v_st(sr, sc), vst1 = v_st(32 + sr, sc), kws = KSWZ(sr, sc * 2);
    const int vb0 = (int)(uintptr_t)V_lds + v_rd_base(lane);
    const TIn* Kh = cur.K; const TIn* Vh = cur.V;
#define RESC(a) do { if (__any((a) < 1.f)) { if (hi == 0) al_l[r32] = (a); asm volatile("s_waitcnt lgkmcnt(0)" ::: "memory");              \
                     for (int d_ = 0; d_ < 4; ++d_) for (int r = 0; r < 16; ++r) o[d_][r] *= al_l[crow(r, hi)]; } } while (0)
#define KBASE(t) ((j_lo + (t)) * KVBLK)
#define ACT(t) (KBASE(t) <= qlo + QBLK - 1 && KBASE(t) + KVBLK - 1 >= qlo - W + 1)
#define MASKT(P0_, P1_, t) do { const int kb_ = KBASE(t); if ((!SK || ACT(t)) && (kb_ + KVBLK - 1 > qlo || kb_ <= qlo + QBLK - 1 - W)) mask_tile(P0_, P1_, qm - kb_, (unsigned)W); } while (0)
    constexpr int NQL = F32 ? 16 : 8;
    constexpr bool SK = WSKIP && !F32;
#define SEAM_K0() do { VMWN(NQL); if constexpr (F32) { SWRITE_KF(0); SBAR(); SLOAD_F((const float*)nxt.V, kbn); } else { SWRITE_HK(0); } SBAR(); } while (0)
    f32x16 pA0, pA1, pB0, pB1; float mnA, mnB, alA, alB; bf16x8 pa0, pa1, pa2, pa3;
    if constexpr (F32) { VMW(); SWRITE_VF(0); SBAR(); } else { SWRITE_HV(0); SBAR(); }
    if (NT > 1) { if constexpr (F32) SLOAD_F((const float*)Kh, KBASE(1)); else SLOAD_H(Kh, Vh, KBASE(1)); }
    SBAR(); qkt<0, SK>(pA0, pA1, K_lds, r32, hi, S.qr, ACT(0), Fcur + KBASE(0) * 4 + hi * 16);
    if constexpr (F32) { if (NT > 1) { VMW(); SWRITE_KF(1); SBAR(); SLOAD_F((const float*)Vh, KBASE(1)); } }
    MASKT(pA0, pA1, 0); partialSM(pA0, pA1, m_reg, mnA, alA);
    if (NT > 1) { VMW(); if constexpr (F32) { SWRITE_VF(1); SBAR(); if (NT > 2) SLOAD_F((const float*)Kh, KBASE(2)); } else SWRITE_H(1); }
    __syncthreads();
#define HALF_STEP(PX0, PX1, mnX, alX, PY0, PY1, alY, t, KB, VB, SB) do {                                                      \
        SBAR(); qkt<KB, SK>(PX0, PX1, K_lds, r32, hi, S.qr, ACT(t), Fcur + KBASE(t) * 4 + hi * 16);                                             \
        finishSM(PY0, PY1, alY, l_reg, pa0, pa1, pa2, pa3); SBAR();                                                           \
        if ((t) + 1 < NT) { if constexpr (F32) { VMW(); SWRITE_KF(SB); SBAR(); SLOAD_F((const float*)Vh, KBASE((t) + 1)); }  \
                            else { SLOAD_H(Kh, Vh, KBASE((t) + 1)); } SBAR(); }                                               \
        pv_tile<VB, SK>(o, vb0, pa0, pa1, pa2, pa3, ACT((t) - 1)); MASKT(PX0, PX1, (t)); partialSM(PX0, PX1, m_reg, mnX, alX);                                        \
        __syncthreads();                                                                                                      \
        if ((t) + 1 < NT) { VMW(); if constexpr (F32) { SWRITE_VF(SB); SBAR(); if ((t) + 2 < NT) SLOAD_F((const float*)Kh, KBASE((t) + 2)); } \
                            else { SWRITE_H(SB); } }                                                                          \
        RESC(alX); __syncthreads(); } while (0)
    for (int t = 1; t + 1 < NT; t += 2) {
        HALF_STEP(pB0, pB1, mnB, alB, pA0, pA1, alA, t, 1, 0, 0);
        HALF_STEP(pA0, pA1, mnA, alA, pB0, pB1, alB, t + 1, 0, 1, 1);
    }
    const bool even = (NT & 1) == 0;
    if (even) { SBAR(); qkt<1, SK>(pB0, pB1, K_lds, r32, hi, S.qr, ACT(NT - 1), Fcur + KBASE(NT - 1) * 4 + hi * 16); SBAR(); }
#define QROW(e) (nxt.Q + (size_t)(wid * QBLK + r32) * PITCH + ((e) >> 1) * 16 + hi * 8 + ((e) & 1) * 4)
    if constexpr (F32) { SLOAD_F((const float*)nxt.K, kbn); SBAR();
#pragma unroll
        for (int e = 0; e < 8; ++e) S.tq[e] = *(const f32x4*)QROW(e); }
    if constexpr (!F32) { SLOAD_H(nxt.K, nxt.V, kbn); SBAR();
#pragma unroll
        for (int d0 = 0; d0 < 8; ++d0) S.qr[d0] = *(const bf16x8*)((const char*)(nxt.Q + (size_t)(wid * QBLK) * PITCH) + qvo + d0 * 32); }
    SBAR();
    finishSM(pA0, pA1, alA, l_reg, pa0, pa1, pa2, pa3); SBAR();
    if constexpr (F32) {
#pragma unroll
        for (int e = 8; e < 16; ++e) S.tq[e] = *(const f32x4*)QROW(e); SBAR(); }
#undef QROW
    pv_tile<0, SK>(o, vb0, pa0, pa1, pa2, pa3, ACT(even ? NT - 2 : NT - 1));
    if (even) { MASKT(pB0, pB1, NT - 1); partialSM(pB0, pB1, m_reg, mnB, alB); __syncthreads(); RESC(alB);
        finishSM(pB0, pB1, alB, l_reg, pa0, pa1, pa2, pa3); SBAR(); pv_tile<1, SK>(o, vb0, pa0, pa1, pa2, pa3, ACT(NT - 1)); }
    SBAR(); SEAM_K0();
    { const f32x4 nfa = *(const f32x4*)(nxt.F + tid * 4), nfb = *(const f32x4*)(nxt.F + 2048 + tid * 4); VMW();
      *(f32x4*)(Fnext + tid * 16) = nfa; *(f32x4*)(Fnext + 8192 + tid * 16) = nfb; SBAR(); }
    if (hi == 0) li_l[r32] = l_reg; asm volatile("s_waitcnt lgkmcnt(0)" ::: "memory");
    float rli[16];
#pragma unroll
    for (int r = 0; r < 16; ++r) rli[r] = __builtin_amdgcn_rcpf(li_l[crow(r, hi)]);
    TOut* Ow = cur.O + (size_t)(wid * QBLK) * PITCH; const unsigned ovo = (unsigned)(4 * hi * PITCH + r32) * 2u;
#pragma unroll
    for (int r = 0; r < 16; ++r) { const int orow = crow(r, hi);
#pragma unroll
        for (int d0 = 0; d0 < 4; ++d0) { const float v = o[d0][r] * rli[r];
            if constexpr (same_t<TOut, float>::v) { Ow[(size_t)orow * PITCH + d0 * 32 + r32] = v; }
            else { const float vn = __shfl_xor(v, 1);
                   if ((r32 & 1) == 0) *(unsigned*)((char*)(Ow + (size_t)((r & 3) + 8 * (r >> 2)) * PITCH + d0 * 32) + ovo) = cvtpk(v, vn); } } }
    if constexpr (F32) {
#pragma unroll
        for (int d0 = 0; d0 < 8; ++d0) S.qr[d0] = pack8(S.tq[2 * d0], S.tq[2 * d0 + 1]); }
    __syncthreads();
#undef RESC
#undef KBASE
#undef ACT
#undef MASKT
#undef SEAM_K0
#undef HALF_STEP
}
#undef ROW
#undef VMW
#undef VMWN
#undef SLOAD_H
#undef GROW
#undef SWRITE_HK
#undef SWRITE_HV
#undef SWRITE_H
#undef SLOAD_F
#undef SWRITE_KF
#undef SWRITE_VF

constexpr int ATT_F_OFF = LDS_BYTES;
constexpr int ATT_LDS_TOTAL = LDS_BYTES + 2 * 16384;
}
constexpr int BATCH = 4, SEQ = 4096, DM = 2048, NH = 16, HD = 128, FF = 8192, M = BATCH * SEQ;
constexpr int NIN = 3 * DM + NH;
constexpr int NMOD = 6 * DM;
constexpr float RMS_EPS = 1e-6f;
constexpr float LOG2E = 1.4426950408889634f;
constexpr float QSCALE = 0.08838834764831845f * LOG2E;
constexpr int NWAVES = 8, NTHREADS = 512;
constexpr int LDS_TOTAL = 147456;
constexpr int NPHASES = 13;
#ifndef PH_MASK
#define PH_MASK 0xff
#endif
#define KEN(k) ((PH_MASK >> (k)) & 1)
constexpr size_t MiB = 1u << 20;
constexpr size_t WS_MOD = 1 * MiB, WS_SW = 1 * MiB + 512 * 1024, WS_LF = 2 * MiB, WS_FK = 3 * MiB;
constexpr size_t WS_SS = 516 * MiB;
constexpr int SW_UP0 = 0, SW_CIN = 4 * 8192, SW_UP1 = 4 * 8192 + 4 * 6144;
constexpr size_t WS_WQKV = 4 * MiB, WS_WO = 28 * MiB, WS_WCIN = 36 * MiB, WS_WCOUT = 60 * MiB, WS_WUP0 = 68 * MiB, WS_WUP1 = 100 * MiB, WS_WDN0 = 132 * MiB, WS_WDN1 = 164 * MiB;
constexpr size_t WS_XN = 196 * MiB, WS_Q = 260 * MiB, WS_K = 324 * MiB, WS_V = 388 * MiB, WS_O = 452 * MiB, WS_U = 260 * MiB, WS_XRB = 518 * MiB, WS_NRM = 582 * MiB, WS_END = 590 * MiB;
static_assert(WS_U + (size_t)M * FF * 2 == WS_SS && WS_O + (size_t)M * DM * 2 == WS_SS && WS_SS + (size_t)M * 32 * 4 == WS_XRB && WS_XRB + (size_t)M * DM * 2 == WS_NRM && WS_NRM + (size_t)2 * M * 64 * 4 == WS_END && WS_XN + (size_t)M * DM * 2 == WS_Q, "d_ws map");

#define LAS __attribute__((address_space(3)))
typedef unsigned short bf16;
typedef unsigned v4u __attribute__((ext_vector_type(4)));
typedef unsigned v2u __attribute__((ext_vector_type(2)));
typedef float f32x4 __attribute__((ext_vector_type(4)));
typedef float f32x2 __attribute__((ext_vector_type(2)));
#define LDS_WAIT() asm volatile("s_waitcnt lgkmcnt(0)" ::: "memory")
__device__ __forceinline__ unsigned pk2(float lo, float hi) { unsigned r; asm volatile("v_cvt_pk_bf16_f32 %0, %1, %2" : "=v"(r) : "v"(lo), "v"(hi)); return r; }
__device__ __forceinline__ float bf_lo(unsigned w) { return __uint_as_float(w << 16); }
__device__ __forceinline__ float bf_hi(unsigned w) { return __uint_as_float(w & 0xffff0000u); }
__device__ __forceinline__ float wave_sum(float v) {
#pragma unroll
    for (int o = 1; o < 64; o <<= 1) v += __shfl_xor(v, o);
    return v;
}

__device__ __forceinline__ void p0_gemv(const float* c, const float* ada_w, const float* ada_b, float* mod, LAS unsigned char* lds, int tid, int wave, int lane) {
    LAS f32x4* cact = (LAS f32x4*)lds;
    LAS float* red = (LAS float*)(lds + 32768);
    for (int k = tid; k < DM; k += NTHREADS) { f32x4 v;
#pragma unroll
        for (int b = 0; b < 4; ++b) { const float cv = c[b * DM + k]; v[b] = cv / (1.f + expf(-cv)); }
        cact[k] = v; }
    __syncthreads();
    for (int it = blockIdx.x; it < 192; it += gridDim.x) {
        const int l = it / 96, n0 = (it % 96) * 128;
        const float* wp = ada_w + ((size_t)l * DM + 256 * wave) * NMOD + n0 + 2 * lane;
        f32x2 acc[4];
#pragma unroll
        for (int b = 0; b < 4; ++b) acc[b] = (f32x2){0.f, 0.f};
#pragma unroll 16
        for (int kk = 0; kk < 256; ++kk) { const f32x2 wv = __builtin_nontemporal_load((const f32x2*)(wp + (size_t)kk * NMOD));   const f32x4 cv = cact[256 * wave + kk];
#pragma unroll
            for (int b = 0; b < 4; ++b) acc[b] += wv * cv[b]; }
#pragma unroll
        for (int b = 0; b < 4; ++b) *(LAS f32x2*)(red + (wave * 4 + b) * 128 + 2 * lane) = acc[b];
        __syncthreads();
        { const int b = tid >> 7, col = tid & 127; float s = ada_b[l * NMOD + n0 + col];
#pragma unroll
          for (int w = 0; w < 8; ++w) s += red[(w * 4 + b) * 128 + col];
          mod[(size_t)(l * 4 + b) * NMOD + n0 + col] = s; }
        __syncthreads();
    }
}
__device__ __forceinline__ void p0_transpose_item(const float* W, int ld, int K, int nblk, bf16* WT, LAS float* scr, int item, int lane, bool cumap = false) {
    const int kb = item / nblk, nb = item % nblk, k0 = 64 * kb, n0 = 32 * nb;
    const int d0 = !cumap || n0 < DM ? n0 : (n0 < 2 * DM ? DM + 256 * ((n0 - DM) >> 7) + ((n0 - DM) & 127) : DM + 256 * ((n0 - 2 * DM) >> 7) + 128 + ((n0 - 2 * DM) & 127));
#pragma unroll 8
    for (int i = 0; i < 32; ++i) { const int kk = 2 * i + (lane >> 5); scr[kk * 33 + (lane & 31)] = __builtin_nontemporal_load(W + (size_t)(k0 + kk) * ld + n0 + (lane & 31)); }
    LDS_WAIT(); asm volatile("" ::: "memory");
    const int c = lane & 7;
#pragma unroll
    for (int j = 0; j < 4; ++j) { const int n = (lane >> 3) + 8 * j; const LAS float* s = scr + (8 * c) * 33 + n;
        v4u o; o.x = pk2(s[0 * 33], s[1 * 33]); o.y = pk2(s[2 * 33], s[3 * 33]); o.z = pk2(s[4 * 33], s[5 * 33]); o.w = pk2(s[6 * 33], s[7 * 33]);
        *(v4u*)(WT + (size_t)(d0 + n) * K + k0 + 8 * c) = o; }
    LDS_WAIT(); asm volatile("" ::: "memory");
}
struct Args { const float* in[15]; float* out; unsigned char* ws; int ph_lo, ph_hi; };
typedef const __attribute__((address_space(4))) unsigned char* kargp_t;
#define KARG_IN(kq, i) (*(const float* const __attribute__((address_space(4)))*)((kq) + 8 * (i)))
#define KARG_OUT(kq) (*(float* const __attribute__((address_space(4)))*)((kq) + 120))
#define KARG_WS(kq) (*(unsigned char* const __attribute__((address_space(4)))*)((kq) + 128))
static_assert(sizeof(Args) == 144, "Args layout");
__device__ __forceinline__ void p0_transposes(kargp_t kq, LAS unsigned char* lds, int wave, int lane, int gw, int ngw) {
    LAS float* scr = (LAS float*)(lds + wave * 16384);
    unsigned char* ws = KARG_WS(kq);
    constexpr int I_IN = 32 * 192, I_SQ = 32 * 64, I_UP = 32 * 256, I_DN = 128 * 64;
    constexpr int NITEMS = 2 * I_IN + 2 * I_SQ + 2 * I_UP + 2 * I_DN;
    const bool deal = (ngw == 2048); static_assert(NITEMS == 1536 * 22 + 512 * 30, "prologue item deal");
    const int lo_wave = gw < 1536, first = deal ? (lo_wave ? gw : 33792 + (gw - 1536)) : gw, step = deal ? (lo_wave ? 1536 : 512) : ngw, stop = deal ? (lo_wave ? 33792 : NITEMS) : NITEMS;
    for (int it = first; it < stop; it += step) {
        int r = it;
        if (r < I_IN) { p0_transpose_item(KARG_IN(kq, 6), NIN, DM, 192, (bf16*)(ws + WS_WQKV), scr, r, lane); continue; } r -= I_IN;
        if (r < I_SQ) { p0_transpose_item(KARG_IN(kq, 8), DM, DM, 64, (bf16*)(ws + WS_WO), scr, r, lane); continue; } r -= I_SQ;
        if (r < I_IN) { p0_transpose_item(KARG_IN(kq, 9), 3 * DM, DM, 192, (bf16*)(ws + WS_WCIN), scr, r, lane, true); continue; } r -= I_IN;
        if (r < I_SQ) { p0_transpose_item(KARG_IN(kq, 11), DM, DM, 64, (bf16*)(ws + WS_WCOUT), scr, r, lane); continue; } r -= I_SQ;
        if (r < I_UP) { p0_transpose_item(KARG_IN(kq, 12), FF, DM, 256, (bf16*)(ws + WS_WUP0), scr, r, lane); continue; } r -= I_UP;
        if (r < I_UP) { p0_transpose_item(KARG_IN(kq, 12) + (size_t)DM * FF, FF, DM, 256, (bf16*)(ws + WS_WUP1), scr, r, lane); continue; } r -= I_UP;
        if (r < I_DN) { p0_transpose_item(KARG_IN(kq, 13), DM, FF, 64, (bf16*)(ws + WS_WDN0), scr, r, lane); continue; } r -= I_DN;
        p0_transpose_item(KARG_IN(kq, 13) + (size_t)FF * DM, DM, FF, 64, (bf16*)(ws + WS_WDN1), scr, r, lane);
    }
}
__device__ __forceinline__ void ld8(const bf16* p, float (&f)[8]) { const v4u w = *(const v4u*)p; f[0] = bf_lo(w.x); f[1] = bf_hi(w.x); f[2] = bf_lo(w.y); f[3] = bf_hi(w.y); f[4] = bf_lo(w.z); f[5] = bf_hi(w.z); f[6] = bf_lo(w.w); f[7] = bf_hi(w.w); }
__device__ __forceinline__ void shiftw_mfma(const float* mod, unsigned char* ws, float* SW, LAS unsigned char* lds, int tid, int lane, int gw, int ngw) {
    LAS bf16* S = (LAS bf16*)lds;
#pragma unroll
    for (int it = 0; it < 3 * 4 * DM / 4 / NTHREADS; ++it) { const int idx = tid + it * NTHREADS, mat = idx / DM, b = (idx / (DM / 4)) & 3, k = (idx & (DM / 4 - 1)) * 4;
        const float* shp = mat == 0 ? mod + 3 * DM : (mat == 1 ? mod + (size_t)4 * NMOD : mod + (size_t)4 * NMOD + 3 * DM);
        const f32x4 v = *(const f32x4*)(shp + (size_t)b * NMOD + k); unsigned hb[4], lb[4];
#pragma unroll
        for (int i = 0; i < 4; ++i) { hb[i] = pk2(v[i], 0.f) & 0xffffu; lb[i] = pk2(v[i] - __uint_as_float(hb[i] << 16), 0.f) & 0xffffu; }
        v2u h2, l2; h2.x = hb[0] | (hb[1] << 16); h2.y = hb[2] | (hb[3] << 16); l2.x = lb[0] | (lb[1] << 16); l2.y = lb[2] | (lb[3] << 16);
        *(LAS v2u*)(S + (mat * 8 + b) * DM + k) = h2; *(LAS v2u*)(S + (mat * 8 + 4 + b) * DM + k) = l2; }
    __syncthreads();
    const int fr = lane & 15, fq = lane >> 4;
    for (int g = gw; g < 1408; g += ngw) {
        const int mat = g < 512 ? 0 : (g < 896 ? 1 : 2), g0 = g - (mat == 0 ? 0 : (mat == 1 ? 512 : 896)), N = mat == 1 ? 3 * DM : FF;
        const bf16* Wt = (const bf16*)(ws + (mat == 0 ? WS_WUP0 : (mat == 1 ? WS_WCIN : WS_WUP1)));
        float* sw = SW + (mat == 0 ? SW_UP0 : (mat == 1 ? SW_CIN : SW_UP1));
        const bf16* wp = Wt + (size_t)(g0 * 16 + fr) * DM + 8 * fq;
        const LAS bf16* sp = S + (mat * 8 + (fr & 7)) * DM + 8 * fq;
        pg8::f32x4 acc = {0.f, 0.f, 0.f, 0.f};
#pragma unroll 8
        for (int kk = 0; kk < DM / 32; ++kk) { const pg8::bf16x8 wf = *(const pg8::bf16x8*)(wp + 32 * kk); pg8::bf16x8 sf = *(const LAS pg8::bf16x8*)(sp + 32 * kk);
            if (fr >= 8) sf = (pg8::bf16x8){0, 0, 0, 0, 0, 0, 0, 0};
            acc = __builtin_amdgcn_mfma_f32_16x16x32_bf16(wf, sf, acc, 0, 0, 0); }
        pg8::f32x4 r;
#pragma unroll
        for (int i = 0; i < 4; ++i) r[i] = acc[i] + __shfl_xor(acc[i], 4);
        if (fr < 4) *(pg8::f32x4*)(sw + (size_t)fr * N + g0 * 16 + 4 * fq) = r;
    }
}
constexpr int WFT_LD = DM + 8;
__device__ __forceinline__ void norm_phase(const float* src, const float* gain, const float* shp, const float* scp, bf16* XN,
                                           const float* w_in, const float* b_f, float* LF, LAS unsigned char* lds, int tid, int lane, int wave, int gw, int ngw) {
    LAS bf16* WFT = (LAS bf16*)lds;
#pragma unroll
    for (int idx = tid; idx < 8192; idx += NTHREADS) { const int k = idx >> 2, n4 = idx & 3;
        const f32x4 v = *(const f32x4*)(w_in + (size_t)k * NIN + 3 * DM + 4 * n4);
#pragma unroll
        for (int i = 0; i < 4; ++i) { const unsigned hb = pk2(v[i], 0.f) & 0xffffu; const unsigned lb = pk2(v[i] - __uint_as_float(hb << 16), 0.f) & 0xffffu;
            WFT[(4 * n4 + i) * WFT_LD + k] = (bf16)hb; WFT[(16 + 4 * n4 + i) * WFT_LD + k] = (bf16)lb; } }
    for (int grp = gw; grp < M / 8; grp += ngw) {
        const int row0 = grp * 8, b = row0 / SEQ;
        for (int rq = 0; rq < 2; ++rq) {
            asm volatile("" ::: "memory");
            f32x4 v[4][8]; float inv[4];
#pragma unroll
            for (int r = 0; r < 4; ++r)
#pragma unroll
                for (int j = 0; j < 8; ++j) v[r][j] = __builtin_nontemporal_load((const f32x4*)(src + (size_t)(row0 + 4 * rq + r) * DM) + lane + 64 * j);
#pragma unroll
            for (int r = 0; r < 4; ++r) { float ss = 0.f;
#pragma unroll
                for (int j = 0; j < 8; ++j) ss += (v[r][j].x * v[r][j].x + v[r][j].y * v[r][j].y) + (v[r][j].z * v[r][j].z + v[r][j].w * v[r][j].w);
                inv[r] = 1.0f / sqrtf(wave_sum(ss) * (1.f / DM) + RMS_EPS); }
#pragma unroll
            for (int j = 0; j < 8; ++j) { const f32x4 g = ((const f32x4*)gain)[lane + 64 * j], sc = ((const f32x4*)(scp + (size_t)b * NMOD))[lane + 64 * j], sh = ((const f32x4*)(shp + (size_t)b * NMOD))[lane + 64 * j];
                const f32x4 ca = g * (sc + 1.f);
#pragma unroll
                for (int r = 0; r < 4; ++r) { const f32x4 h = (v[r][j] * inv[r]) * ca + sh; v2u w; w.x = pk2(h.x, h.y); w.y = pk2(h.z, h.w);
                    ((v2u*)(XN + (size_t)(row0 + 4 * rq + r) * DM))[lane + 64 * j] = w; } }
        }
    }
    __syncthreads();
    if ((wave & 1) == 0) {
        const int fr = lane & 15, fq = lane >> 4;
        for (int grp = gw; grp < M / 8; grp += ngw) {
            const int row0 = grp * 8, b = row0 / SEQ;
            const bf16* xp = XN + (size_t)(row0 + fr) * DM + 8 * fq;
            const LAS bf16* yh = WFT + fr * WFT_LD + 8 * fq; const LAS bf16* yl = yh + 16 * WFT_LD;
            pg8::f32x4 ah = {0.f, 0.f, 0.f, 0.f}, al = {0.f, 0.f, 0.f, 0.f};
#pragma unroll 8
            for (int kk = 0; kk < DM / 32; ++kk) { const pg8::bf16x8 xf = *(const pg8::bf16x8*)(xp + 32 * kk);
                ah = __builtin_amdgcn_mfma_f32_16x16x32_bf16(xf, *(const LAS pg8::bf16x8*)(yh + 32 * kk), ah, 0, 0, 0);
                al = __builtin_amdgcn_mfma_f32_16x16x32_bf16(xf, *(const LAS pg8::bf16x8*)(yl + 32 * kk), al, 0, 0, 0); }
            const float bias = b_f[fr]; pg8::f32x4 lf;
#pragma unroll
            for (int i = 0; i < 4; ++i) { const float z = ah[i] + al[i] + bias; lf[i] = fminf(z, 0.f) - log1pf(expf(-fabsf(z))); }
            *(pg8::f32x4*)(LF + (size_t)(b * NH + fr) * SEQ + (row0 % SEQ) + 4 * fq) = lf;
        }
    }
}
__device__ __forceinline__ void cumsum_block(const float* LF, float* FK, int bh, LAS unsigned char* lds, int tid, int wave, int lane) {
    const f32x4 a = *(const f32x4*)(LF + (size_t)bh * SEQ + 8 * tid), b = *(const f32x4*)(LF + (size_t)bh * SEQ + 8 * tid + 4);
    float p[8]; p[0] = a.x; p[1] = p[0] + a.y; p[2] = p[1] + a.z; p[3] = p[2] + a.w; p[4] = p[3] + b.x; p[5] = p[4] + b.y; p[6] = p[5] + b.z; p[7] = p[6] + b.w;
    float incl = p[7];
#pragma unroll
    for (int o = 1; o < 64; o <<= 1) { const float t = __shfl_up(incl, o); if (lane >= o) incl += t; }
    LAS float* wt = (LAS float*)lds;
    if (lane == 63) wt[wave] = incl;
    __syncthreads();
    float off = incl - p[7];
    for (int w = 0; w < wave; ++w) off += wt[w];
    f32x4 o0, o1; o0.x = -(off + p[0]) * LOG2E; o0.y = -(off + p[1]) * LOG2E; o0.z = -(off + p[2]) * LOG2E; o0.w = -(off + p[3]) * LOG2E;
    o1.x = -(off + p[4]) * LOG2E; o1.y = -(off + p[5]) * LOG2E; o1.z = -(off + p[6]) * LOG2E; o1.w = -(off + p[7]) * LOG2E;
    *(f32x4*)(FK + (size_t)bh * SEQ + 8 * tid) = o0; *(f32x4*)(FK + (size_t)bh * SEQ + 8 * tid + 4) = o1;
    __syncthreads();
}
typedef __hip_bfloat16 hbf;
__device__ __forceinline__ void att_item(int L, int pass, int& bh, int& qb) {
    const int xcd = L & 7, k = L >> 3; bh = (k >> 3) * 8 + xcd; const int x0 = k & 7, x = (L >= 256) ? 7 - x0 : x0; qb = pass ? 15 - x : x;
}
__device__ __forceinline__ att::BlockRef<hbf, hbf> att_ref(int L, int pass, int jlo, const hbf* Q, const hbf* K, const hbf* V, hbf* O, const float* FK) {
    int bh, qb; att_item(L, pass, bh, qb);
    const int b = bh >> 4, h = bh & 15; const size_t rowbase = (size_t)b * SEQ;
    att::BlockRef<hbf, hbf> r;
    r.Q = Q + (rowbase + (size_t)qb * 256) * DM + h * HD; r.O = O + (rowbase + (size_t)qb * 256) * DM + h * HD;
    r.K = K + rowbase * DM + h * HD; r.V = V + rowbase * DM + h * HD; r.F = FK + (size_t)bh * SEQ; r.P0 = qb * 256; r.jlo = jlo;
    return r;
}
__device__ __forceinline__ int att_jlo(int L, int pass, const float* NRM, const float* FK, LAS unsigned char* lds, int tid, int lane, int wave) {
    int bh, qb; att_item(L, pass, bh, qb);
    const int b = bh >> 4, h = bh & 15, P0 = qb * 256; const size_t rowbase = (size_t)b * SEQ;
    const float* NQ = NRM + (size_t)bh * SEQ * 4; const float* NK = NRM + ((size_t)(BATCH * NH) + bh) * SEQ * 4;
    float kq = 0.f, kk = 0.f;
    if (tid < 256) { const f32x4 v = *(const f32x4*)(NQ + (size_t)(P0 + tid) * 4); kq = (v[0] + v[1]) + (v[2] + v[3]); }
    for (int s = tid; s < P0 + 256; s += NTHREADS) { const f32x4 v = *(const f32x4*)(NK + (size_t)s * 4); kk = fmaxf(kk, (v[0] + v[1]) + (v[2] + v[3])); }
#pragma unroll
    for (int o = 1; o < 64; o <<= 1) { kq = fmaxf(kq, __shfl_xor(kq, o)); kk = fmaxf(kk, __shfl_xor(kk, o)); }
    LAS float* red = (LAS float*)(lds + 122880);
    if (lane == 0) { red[wave] = kq; red[8 + wave] = kk; }
    __syncthreads();
    float mq = 0.f, mk = 0.f;
#pragma unroll
    for (int w = 0; w < 8; ++w) { mq = fmaxf(mq, red[w]); mk = fmaxf(mk, red[8 + w]); }
    const float B = 1.02f * sqrtf(mq * mk);
    const float* F = FK + (size_t)bh * SEQ;
    const float fend = F[64 * lane + 63], f0 = F[P0];
    const bool skip = (64 * lane + 63 < P0) && (2.f * B + fend - f0 < -60.f);
    const int jlo = __popcll(__ballot(skip));
    __syncthreads();
    return __builtin_amdgcn_readfirstlane(jlo);
}
__device__ __forceinline__ void attn_phase(const hbf* Q, const hbf* K, const hbf* V, hbf* O, const float* FK, const float* NRM, char* lds) {
    constexpr int total = 8 * BATCH * NH, W = 1 << 30;
    const int stride = gridDim.x; int L = blockIdx.x; if (L >= total) return;
    const int L0 = L;
    int jl0, jl1, jl2 = 0, jl3 = 0;
    { const int tid = tidx(), lane = tid & 63, wave = __builtin_amdgcn_readfirstlane(tid >> 6);
      jl0 = att_jlo(L0, 0, NRM, FK, (LAS unsigned char*)lds, tid, lane, wave); jl1 = att_jlo(L0, 1, NRM, FK, (LAS unsigned char*)lds, tid, lane, wave);
      if (L0 + stride < total) { jl2 = att_jlo(L0 + stride, 0, NRM, FK, (LAS unsigned char*)lds, tid, lane, wave); jl3 = att_jlo(L0 + stride, 1, NRM, FK, (LAS unsigned char*)lds, tid, lane, wave); } }
    int pass = 0, fsel = 0;
    att::BlockRef<hbf, hbf> cur = att_ref(L, 0, jl0, Q, K, V, O, FK);
    att::Seam<hbf> S;
    att::causal_swa_prime<hbf, hbf>(cur, W, lds, S, lds + att::ATT_F_OFF);
    for (;;) {
        const bool more_pass = pass == 0, more_item = (L == L0) && (L + stride < total), last = !more_pass && !more_item;
        int passn = pass + 1, Ln = L;
        if (!more_pass) { passn = 0; Ln = more_item ? L + stride : L; }
        const int jn = (Ln == L0) ? (passn ? jl1 : jl0) : (passn ? jl3 : jl2);
        const att::BlockRef<hbf, hbf> nxt = last ? cur : att_ref(Ln, passn, jn, Q, K, V, O, FK);
        att::causal_swa_block<hbf, hbf>(cur, nxt, SEQ, W, lds, S, lds + att::ATT_F_OFF + fsel * 16384, lds + att::ATT_F_OFF + (fsel ^ 1) * 16384);
        if (last) break;
        cur = nxt; pass = passn; L = Ln; fsel ^= 1;
    }
}
__device__ __forceinline__ void conv_phase(const bf16* BG, const bf16* P, const float* cw, bf16* Y, int lane, int gw, int ngw) {
    for (int grp = gw; grp < M / 8; grp += ngw) {
        const int row0 = grp * 8, t0 = row0 % SEQ;
        for (int j = 0; j < 4; ++j) {
            const int ch = (lane + 64 * j) * 8;
            float w0[8], w1[8], w2[8], pm2[8], pm1[8];
#pragma unroll
            for (int i = 0; i < 8; ++i) { w0[i] = cw[ch + i]; w1[i] = cw[DM + ch + i]; w2[i] = cw[2 * DM + ch + i]; pm2[i] = 0.f; pm1[i] = 0.f; }
            if (t0 > 0) { ld8(P + (size_t)(row0 - 2) * DM + ch, pm2); ld8(P + (size_t)(row0 - 1) * DM + ch, pm1); }
#pragma unroll
            for (int r = 0; r < 8; ++r) { float p8[8], b8[8], y[8];
                ld8(P + (size_t)(row0 + r) * DM + ch, p8); ld8(BG + (size_t)(row0 + r) * DM + ch, b8);
#pragma unroll
                for (int i = 0; i < 8; ++i) { y[i] = b8[i] * (w0[i] * pm2[i] + w1[i] * pm1[i] + w2[i] * p8[i]); pm2[i] = pm1[i]; pm1[i] = p8[i]; }
                v4u o; o.x = pk2(y[0], y[1]); o.y = pk2(y[2], y[3]); o.z = pk2(y[4], y[5]); o.w = pk2(y[6], y[7]);
                *(v4u*)(Y + (size_t)(row0 + r) * DM + ch) = o; }
        }
    }
}
__device__ __forceinline__ void final_norm_phase(const bf16* xr, float* out, const float* gain, int lane, int gw, int ngw) {
    for (int r0 = gw * 4; r0 < M; r0 += ngw * 4) {
        v4u raw[4][4];
#pragma unroll
        for (int r = 0; r < 4; ++r)
#pragma unroll
            for (int j = 0; j < 4; ++j) raw[r][j] = *(const v4u*)(xr + (size_t)(r0 + r) * DM + (lane + 64 * j) * 8);
        float inv[4];
#pragma unroll
        for (int r = 0; r < 4; ++r) { float ss = 0.f;
#pragma unroll
            for (int j = 0; j < 4; ++j) { const unsigned w[4] = {raw[r][j].x, raw[r][j].y, raw[r][j].z, raw[r][j].w};
#pragma unroll
                for (int i = 0; i < 4; ++i) { const float a = bf_lo(w[i]), b = bf_hi(w[i]); ss += a * a + b * b; } }
            inv[r] = 1.0f / sqrtf(wave_sum(ss) * (1.f / DM) + RMS_EPS); }
#pragma unroll
        for (int j = 0; j < 4; ++j) { const f32x4 g0 = *(const f32x4*)(gain + (lane + 64 * j) * 8), g1 = *(const f32x4*)(gain + (lane + 64 * j) * 8 + 4);
#pragma unroll
            for (int r = 0; r < 4; ++r) { const v4u w = raw[r][j]; f32x4 o0, o1;
                o0[0] = bf_lo(w.x); o0[1] = bf_hi(w.x); o0[2] = bf_lo(w.y); o0[3] = bf_hi(w.y); o1[0] = bf_lo(w.z); o1[1] = bf_hi(w.z); o1[2] = bf_lo(w.w); o1[3] = bf_hi(w.w);
                o0 = (o0 * inv[r]) * g0; o1 = (o1 * inv[r]) * g1;
                *(f32x4*)(out + (size_t)(r0 + r) * DM + (lane + 64 * j) * 8) = o0; *(f32x4*)(out + (size_t)(r0 + r) * DM + (lane + 64 * j) * 8 + 4) = o1; } }
    }
}

#define XB_TMO      128
#define XB_XCNT(j)  (256  + 64 * (j))
#define XB_XSUB(j)  (1280 + 64 * (j))
#define XB_XGEN(j)  (2304 + 64 * (j))
#define XB_TOP      3328
#define XB_TOPGEN   3392
#define XCD_BAR_WORDS 3456
#define XB_SPIN_CAP (1u << 18)

__device__ __forceinline__ unsigned xb_ld(unsigned* p)              { return __hip_atomic_load(p, __ATOMIC_RELAXED, __HIP_MEMORY_SCOPE_AGENT); }
__device__ __forceinline__ unsigned xb_add(unsigned* p, unsigned v) { return __hip_atomic_fetch_add(p, v, __ATOMIC_RELAXED, __HIP_MEMORY_SCOPE_AGENT); }
__device__ __forceinline__ unsigned xb_xcc_id() { return (unsigned)__builtin_amdgcn_s_getreg((3 << 11) | 20) & 0xFu; }
#define XB_SPIN(cond, bar) do { unsigned _sp = 0; while (cond) { __builtin_amdgcn_s_sleep(1); \
    if ((++_sp & 255u) == 0u) { if (xb_ld(&(bar)[XB_TMO])) break; if (_sp > XB_SPIN_CAP) { atomicAdd(&(bar)[XB_TMO], 1u); break; } } } } while (0)

struct XcdBarrier {
    unsigned* bar; unsigned x;
    volatile LAS unsigned* st;
};

__device__ __forceinline__ XcdBarrier xcd_barrier_post(unsigned* bar, volatile LAS unsigned* st) {
    XcdBarrier b; b.bar = bar; b.x = xb_xcc_id(); b.st = st;
    if (threadIdx.x == 0) (void)xb_add(&bar[XB_XCNT(b.x)], 1u);
    return b;
}
__device__ __forceinline__ void xcd_barrier_complete(unsigned* bar, unsigned x, unsigned& nloc, unsigned& nx) {
    const unsigned G = gridDim.x * gridDim.y * gridDim.z;
    unsigned sum, cnt, mine, sp = 0u;
    for (;;) {
        sum = 0u; cnt = 0u; mine = 0u;
#pragma unroll
        for (unsigned j = 0; j < 16; ++j) { const unsigned c = xb_ld(&bar[XB_XCNT(j)]); sum += c; cnt += (c > 0u) ? 1u : 0u; mine = (j == x) ? c : mine; }
        if (sum == G) break;
        __builtin_amdgcn_s_sleep(1);
        if ((++sp & 255u) == 0u) { if (xb_ld(&bar[XB_TMO])) break; if (sp > XB_SPIN_CAP) { atomicAdd(&bar[XB_TMO], 1u); break; } }
    }
    nloc = mine > 0u ? mine : 1u; nx = cnt > 0u ? cnt : 1u;
}

__device__ __forceinline__ void xcd_barrier(const XcdBarrier& b) {
    asm volatile("s_waitcnt vmcnt(0)" ::: "memory");
    __syncthreads();
    if (threadIdx.x == 0) {
        unsigned* bar = b.bar;
        __builtin_amdgcn_s_waitcnt(0);
        unsigned nloc = b.st[0], nx = b.st[1];
        if (nloc == 0u) { xcd_barrier_complete(bar, b.x, nloc, nx); b.st[0] = nloc; b.st[1] = nx; }
        const unsigned old = xb_add(&bar[XB_XSUB(b.x)], 1u);
        const unsigned gen = old / nloc;
        if (old + 1u == (gen + 1u) * nloc) {
            __builtin_amdgcn_fence(__ATOMIC_RELEASE, "agent");
            asm volatile("s_waitcnt vmcnt(0)" ::: "memory");
            const unsigned og = xb_add(&bar[XB_TOP], 1u);
            const unsigned tg = og / nx;
            if (og + 1u == (tg + 1u) * nx) xb_add(&bar[XB_TOPGEN], 1u);
            else XB_SPIN(xb_ld(&bar[XB_TOPGEN]) == tg, bar);
            __builtin_amdgcn_fence(__ATOMIC_ACQUIRE, "agent");
            xb_add(&bar[XB_XGEN(b.x)], 1u);
            asm volatile("s_waitcnt vmcnt(0)" ::: "memory");
        } else {
            XB_SPIN(xb_ld(&bar[XB_XGEN(b.x)]) == gen, bar);
            __builtin_amdgcn_fence(__ATOMIC_ACQUIRE, "agent");
            asm volatile("s_waitcnt vmcnt(0)" ::: "memory");
        }
    }
    __syncthreads();
}

enum { K_PRO = 0, K_NORM, K_GEMM_BF16, K_ATTN, K_GEMM_RES, K_GEMM_SQ, K_CONV, K_FINAL };
__global__ void __launch_bounds__(NTHREADS, 2) fwd_mega(Args a) {
    extern __shared__ __attribute__((aligned(16))) unsigned char lds[];
    LAS unsigned char* L = (LAS unsigned char*)lds;
    const int G = gridDim.x, ngw = G * NWAVES;
    const kargp_t kp = (kargp_t)__builtin_amdgcn_kernarg_segment_ptr();
    const int ph_lo = a.ph_lo, ph_hi = a.ph_hi;
    volatile LAS unsigned* MISC = (volatile LAS unsigned*)(L + LDS_TOTAL - 256);
    if (tidx() < 32) MISC[tidx()] = 0u;
    __syncthreads();
    XcdBarrier xbar; xbar.bar = (unsigned*)a.ws; xbar.x = 0; xbar.st = nullptr;
    if (ph_hi - ph_lo > 1) xbar = xcd_barrier_post((unsigned*)a.ws, MISC + 8);
#if defined(PROBE_REP_KIND)
    int rep_left = PROBE_REP_N;
#endif
    for (int ph = ph_lo; ph < ph_hi; ++ph) {
        kargp_t kq = kp; asm volatile("" : "+s"(kq));
        unsigned char* ws = KARG_WS(kq);
        const float* x = KARG_IN(kq, 0);
        float* mod = (float*)(ws + WS_MOD); float* LF = (float*)(ws + WS_LF); float* FK = (float*)(ws + WS_FK);
        bf16* XN = (bf16*)(ws + WS_XN); bf16* Qb = (bf16*)(ws + WS_Q); bf16* Kb = (bf16*)(ws + WS_K); bf16* Vb = (bf16*)(ws + WS_V); bf16* Ob = (bf16*)(ws + WS_O); bf16* Ub = (bf16*)(ws + WS_U);
        float* XR = KARG_OUT(kq);
        const int layer = ph >= 7 ? 1 : 0;
        int kind;
        switch (ph) {
            case 0: kind = K_PRO; break;
            case 1: kind = K_NORM; break;
            case 2: case 7: kind = K_GEMM_BF16; break;
            case 3: kind = K_ATTN; break;
            case 4: case 6: case 9: case 11: kind = K_GEMM_RES; break;
            case 5: case 10: kind = K_GEMM_SQ; break;
            case 8: kind = K_CONV; break;
            default: kind = K_FINAL; break;
        }
        const bool mlp_half = (ph == 5 || ph == 6 || ph == 10 || ph == 11);
        const float* modl = mod + (size_t)layer * 4 * NMOD;
        float* SS = (float*)(ws + WS_SS); float* SW = (float*)(ws + WS_SW);
        if (KEN(K_PRO) && kind == K_PRO) {
            const int tid = tidx(), lane = tid & 63, wave = __builtin_amdgcn_readfirstlane(tid >> 6), gw = blockIdx.x * NWAVES + wave; (void)tid; (void)lane; (void)wave; (void)gw;
            p0_gemv(KARG_IN(kq, 1), KARG_IN(kq, 2), KARG_IN(kq, 3), mod, L, tid, wave, lane);
            p0_transposes(kq, L, wave, lane, gw, ngw);
            __syncthreads();
        } else if (KEN(K_NORM) && kind == K_NORM) {
            const int tid = tidx(), lane = tid & 63, wave = __builtin_amdgcn_readfirstlane(tid >> 6), gw = blockIdx.x * NWAVES + wave; (void)tid; (void)lane; (void)wave; (void)gw;
            norm_phase(x, KARG_IN(kq, 4), modl, modl + DM, XN, KARG_IN(kq, 6), KARG_IN(kq, 7), LF, L, tid, lane, wave, gw, ngw);
            __syncthreads();
            shiftw_mfma(mod, ws, SW, L, tid, lane, gw, ngw);
            __syncthreads();
        } else if (KEN(K_GEMM_BF16) && kind == K_GEMM_BF16) {
            const int tid = tidx(), lane = tid & 63, wave = __builtin_amdgcn_readfirstlane(tid >> 6), gw = blockIdx.x * NWAVES + wave; (void)tid; (void)lane; (void)wave; (void)gw;
            if (ph == 2) { for (int bh = blockIdx.x; bh < BATCH * NH; bh += G) cumsum_block(LF, FK, bh, L, tid, wave, lane); }
            pg8::Gemm g{XN, (const bf16*)(ws + (ph == 2 ? WS_WQKV : WS_WCIN)), M, 3 * DM, DM}; pg8::StaticOrder S; S.init(M, 3 * DM, G, (int)blockIdx.x);
            pg8::EpiBf16<0> E{Qb, DM, DM, (size_t)(WS_K - WS_Q) / 2, ph == 2 ? QSCALE : 1.0f, ph == 2 ? (const float*)nullptr : (const float*)SS, SW + SW_CIN, 3 * DM, SEQ, ph == 2 ? (bf16*)nullptr : Kb, 8, ph == 2 ? (float*)(ws + WS_NRM) : (float*)nullptr};
            pg8::gemm_phase<pg8::EpiBf16<0>, pg8::StaticOrder, true, true>(L, g, S, E);
        } else if (KEN(K_ATTN) && kind == K_ATTN) {
            attn_phase((const hbf*)Qb, (const hbf*)Kb, (const hbf*)Vb, (hbf*)Ob, FK, (const float*)(ws + WS_NRM), (char*)lds);
        } else if (KEN(K_GEMM_RES) && kind == K_GEMM_RES) {
            const bf16* A = mlp_half ? Ub : Ob; const int Kd = mlp_half ? FF : DM;
            const size_t wo = mlp_half ? (layer ? WS_WDN1 : WS_WDN0) : (layer ? WS_WCOUT : WS_WO);
            pg8::Gemm g{A, (const bf16*)(ws + wo), M, DM, Kd}; pg8::StaticOrder S; S.init(M, DM, G, (int)blockIdx.x, 4);
            const float* n_gain = mlp_half ? KARG_IN(kq, 4) + DM : KARG_IN(kq, 5) + (size_t)layer * DM;
            const float* n_scale = mlp_half ? mod + (size_t)4 * NMOD + DM : modl + 4 * DM;
            bf16* XRB = (bf16*)(ws + WS_XRB);
            pg8::EpiRes E{ph == 4 ? x : (const float*)nullptr, ph == 4 ? (const bf16*)nullptr : (const bf16*)XRB, (float*)nullptr, XRB, DM, modl + (mlp_half ? 5 * DM : 2 * DM), SEQ, NMOD, ph == 11 ? (bf16*)nullptr : XN, n_gain, n_scale, SS};
            pg8::gemm_phase<pg8::EpiRes, pg8::StaticOrder, true, true>(L, g, S, E);
        } else if (KEN(K_GEMM_SQ) && kind == K_GEMM_SQ) {
            pg8::Gemm g{XN, (const bf16*)(ws + (layer ? WS_WUP1 : WS_WUP0)), M, FF, DM}; pg8::StaticOrder S; S.init(M, FF, G, (int)blockIdx.x);
#if defined(PROBE_NULL_EPI)
            if (rep_left < PROBE_REP_N) { pg8::EpiNull E0{Ub}; pg8::gemm_phase<pg8::EpiNull, pg8::StaticOrder, true, true>(L, g, S, E0); } else
#endif
            { pg8::EpiBf16<2> E{Ub, FF, 0, 0, 1.0f, SS, SW + (layer ? SW_UP1 : SW_UP0), FF, SEQ, (bf16*)nullptr, 0, (float*)nullptr};
            pg8::gemm_phase<pg8::EpiBf16<2>, pg8::StaticOrder, true, true>(L, g, S, E); }
        } else if (KEN(K_CONV) && kind == K_CONV) {
            const int tid = tidx(), lane = tid & 63, wave = __builtin_amdgcn_readfirstlane(tid >> 6), gw = blockIdx.x * NWAVES + wave; (void)tid; (void)lane; (void)wave; (void)gw;
            conv_phase(Qb, Kb, KARG_IN(kq, 10), Ob, lane, gw, ngw);
        } else if (KEN(K_FINAL) && kind == K_FINAL) {
            const int tid = tidx(), lane = tid & 63, wave = __builtin_amdgcn_readfirstlane(tid >> 6), gw = blockIdx.x * NWAVES + wave; (void)tid; (void)lane; (void)wave; (void)gw;
            final_norm_phase((const bf16*)(ws + WS_XRB), XR, KARG_IN(kq, 14), lane, gw, ngw);
        }
#if defined(PROBE_REP_KIND)
        if (kind == PROBE_REP_KIND && !(kind == K_GEMM_RES && ph != 4) && rep_left > 0) { --rep_left; xcd_barrier(xbar); --ph; continue; }
        rep_left = PROBE_REP_N;
#endif
#if defined(PROBE_EXTRA_SYNC)
        for (int es = 0; es < PROBE_EXTRA_SYNC; ++es) xcd_barrier(xbar);
#endif
        if (ph + 1 < ph_hi) { if (ph_hi > NPHASES) cg::this_grid().sync(); else xcd_barrier(xbar); }
    }
}

extern "C" void kernel_launch(void* const* d_in, const int* in_sizes, int n_in, void* d_out, int out_size, void* d_ws, size_t ws_size, hipStream_t stream) {
    static int grid = 0;
    if (grid == 0) {
        if (n_in != 15 || in_sizes[0] != M * DM || out_size != M * DM || ws_size < WS_END) { fprintf(stderr, "kernel_launch: shape/workspace mismatch (n_in %d, in0 %d, out %d, ws %zu)\n", n_in, n_in > 0 ? in_sizes[0] : -1, out_size, ws_size); grid = -1; return; }
        int dev = 0, cus = 0, per_cu = 0;
        (void)hipGetDevice(&dev); (void)hipDeviceGetAttribute(&cus, hipDeviceAttributeMultiprocessorCount, dev);
        if (hipFuncSetAttribute((const void*)fwd_mega, hipFuncAttributeMaxDynamicSharedMemorySize, LDS_TOTAL) != hipSuccess) { fprintf(stderr, "kernel_launch: hipFuncSetAttribute failed\n"); grid = -1; return; }
        if (hipOccupancyMaxActiveBlocksPerMultiprocessor(&per_cu, (const void*)fwd_mega, NTHREADS, LDS_TOTAL) != hipSuccess || per_cu < 1) { fprintf(stderr, "kernel_launch: occupancy query says %d blocks per CU\n", per_cu); per_cu = 1; }
        (void)hipGetLastError();
        grid = cus > 0 ? cus : 256;
    }
    if (grid < 0) return;
    Args a{};
    for (int i = 0; i < 15; ++i) a.in[i] = (const float*)d_in[i];
    a.out = (float*)d_out; a.ws = (unsigned char*)d_ws;
#if MK_N_LAUNCHES == 1
    a.ph_lo = 0; a.ph_hi = NPHASES;
    (void)hipMemsetAsync(d_ws, 0, 16384, stream);
    void* args[] = {&a};
    hipError_t e = hipLaunchCooperativeKernel((const void*)fwd_mega, dim3(grid), dim3(NTHREADS), args, LDS_TOTAL, stream);
    if (e != hipSuccess) fprintf(stderr, "kernel_launch: cooperative launch failed: %s (grid %d)\n", hipGetErrorString(e), grid);
#else
    for (int ph = 0; ph < NPHASES; ++ph) { a.ph_lo = ph; a.ph_hi = ph + 1; hipLaunchKernelGGL(fwd_mega, dim3(grid), dim3(NTHREADS), LDS_TOTAL, stream, a); }
#endif
}
```

```cpp
#include <hip/hip_runtime.h>
#include <hip/hip_bf16.h>
#include <hip/hip_cooperative_groups.h>
#include <cstdio>
#include <cstdint>
#include <cmath>
namespace cg = cooperative_groups;
#ifndef MK_N_LAUNCHES
#define MK_N_LAUNCHES 1
#endif
__device__ __forceinline__ int tidx() { int t = threadIdx.x; asm volatile("" : "+v"(t)); return t; }
namespace pg8 {
#define PG8_LAS __attribute__((address_space(3)))
typedef unsigned short bf16_t;
typedef short bf16x8 __attribute__((ext_vector_type(8)));
typedef float f32x4 __attribute__((ext_vector_type(4)));
typedef unsigned u32x4 __attribute__((ext_vector_type(4)));
constexpr int BM = 256, BK = 64, HALF = 128, HTB = HALF * BK * 2  , STAGE_BYTES = 8 * HTB, NXCD = 8, WGM = 8;

__host__ __device__ __forceinline__ int lds_byte(int r, int c) { const int st = (r >> 4) * 2 + (c >> 5), rr = r & 15, cc = c & 31, ob = rr * 64 + cc * 2; return st * 1024 + (ob ^ (((ob >> 9) & 1) << 5)); }
__host__ __device__ __forceinline__ void stage_rc(int b, int& R, int& C) { const int st = b / 1024, sb = b % 1024, swz = sb ^ (((sb >> 9) & 1) << 5); R = (st >> 1) * 16 + swz / 64; C = (st & 1) * 32 + (swz % 64) / 2; }
__host__ __device__ __forceinline__ int perm32(int rho) { const int n = rho >> 4, i = rho & 15; return 8 * (i >> 2) + 4 * n + (i & 3); }

struct Unit { int pm, pn; };
struct Gemm { const bf16_t* A; const bf16_t* Bt; int M, N, K; };

struct StaticOrder {
    int nM, nN, nwg, G, c, wgm;
    __host__ __device__ void init(int M, int N, int G_, int c_, int wgm_ = WGM) { nM = M / BM; nN = N / BM; nwg = nM * nN; G = G_; c = c_; wgm = wgm_; }
    __host__ __device__ bool next(int i, Unit& u) const {
        const long L = (long)i * G + c; if (L >= nwg) return false;
        int wgid = (int)L; { const int q = nwg / NXCD, r = nwg % NXCD, xcd = wgid % NXCD, off = wgid / NXCD; wgid = (xcd < r ? xcd * (q + 1) : r * (q + 1) + (xcd - r) * q) + off; }
        const int nig = wgm * nN, gid = wgid / nig, fm = gid * wgm, gsz = (nM - fm) < wgm ? (nM - fm) : wgm;
        u.pm = fm + ((wgid % nig) % gsz); u.pn = (wgid % nig) / gsz; return true;
    }
    __device__ __forceinline__ void a_ready(const Unit&) const {}
    __device__ __forceinline__ void done(const Unit&) const {}
};

__device__ __forceinline__ unsigned cvt_pk_bf16(float lo, float hi) { unsigned r; asm volatile("v_cvt_pk_bf16_f32 %0, %1, %2" : "=v"(r) : "v"(lo), "v"(hi)); return r; }
template <int ACT> struct EpiBf16 {
    static constexpr bool PERM = true, AFTER_DRAIN = false;
    bf16_t* O; int ldc; int split_cols; size_t split_stride; float scale0;
    const float* ss; const float* sw; int sw_stride; int rows_per_batch;
    bf16_t* cu_out; int cu_from;
    float* nrm;
    __device__ __forceinline__ void operator()(const f32x4 (&acc)[2][2][4][2], const Unit& u, int wr, int wc, int fr, int fq) const {
        const int row0 = u.pm * BM + wr * 64 + fr; int colt = u.pn * BM; bf16_t* base = O;
        const bool do_nrm = nrm != nullptr && u.pn < 16;
        float sc = 1.f; if (split_cols) { const int t = colt / split_cols; base += (size_t)t * split_stride; colt -= t * split_cols; if (t == 0) sc = scale0; }
        const int col0 = colt + wc * 32 + 8 * fq;
        f32x4 swv[2][2];
        if (ss) { const float* swp = sw + (size_t)((u.pm * BM) / rows_per_batch) * sw_stride + u.pn * BM + wc * 32 + 8 * fq;
#pragma unroll
            for (int bj = 0; bj < 2; ++bj)
#pragma unroll
                for (int n = 0; n < 2; ++n) swv[bj][n] = *(const f32x4*)(swp + bj * HALF + 4 * n); }
#pragma unroll
        for (int ai = 0; ai < 2; ++ai)
#pragma unroll
            for (int m = 0; m < 4; ++m) { const int row = row0 + ai * HALF + m * 16; bf16_t* rowp = base + (size_t)row * ldc + col0;
                float inv = 1.f;
                if (ss) { const f32x4* sp = (const f32x4*)(ss + (size_t)row * 32 + fq * 8); const f32x4 p0 = sp[0], p1 = sp[1];
                    float s = ((p0[0] + p0[1]) + (p0[2] + p0[3])) + ((p1[0] + p1[1]) + (p1[2] + p1[3]));
                    s += __shfl_xor(s, 16); s += __shfl_xor(s, 32); inv = 1.0f / sqrtf(s * (1.f / 2048.f) + 1e-6f); }
                f32x4 va[2][2];
#pragma unroll
                for (int bj = 0; bj < 2; ++bj) { f32x4 v0 = acc[ai][bj][m][0], v1 = acc[ai][bj][m][1];
                    if (ss) { v0 = v0 * inv + swv[bj][0]; v1 = v1 * inv + swv[bj][1]; }
                    if (ACT == 2) { v0 = __builtin_elementwise_max(v0, (f32x4){0.f, 0.f, 0.f, 0.f}); v1 = __builtin_elementwise_max(v1, (f32x4){0.f, 0.f, 0.f, 0.f}); v0 = v0 * v0; v1 = v1 * v1; }
                    v0 = v0 * sc; v1 = v1 * sc;
                    if (do_nrm) { float s2 = ((v0[0] * v0[0] + v0[1] * v0[1]) + (v0[2] * v0[2] + v0[3] * v0[3])) + ((v1[0] * v1[0] + v1[1] * v1[1]) + (v1[2] * v1[2] + v1[3] * v1[3]));
                        s2 += __shfl_xor(s2, 16); s2 += __shfl_xor(s2, 32);
                        if (fq == 0) nrm[((size_t)(((u.pn >> 3) * 4 + (row >> 12)) * 16 + (u.pn & 7) * 2 + bj) * 4096 + (row & 4095)) * 4 + wc] = s2; }
                    va[bj][0] = v0; va[bj][1] = v1; }
                if (cu_out != nullptr && u.pn >= cu_from) {
                    const f32x4 p0 = va[0][0] * va[1][0], p1 = va[0][1] * va[1][1];
                    u32x4 w; w.x = cvt_pk_bf16(p0[0], p0[1]); w.y = cvt_pk_bf16(p0[2], p0[3]); w.z = cvt_pk_bf16(p1[0], p1[1]); w.w = cvt_pk_bf16(p1[2], p1[3]);
                    *(u32x4*)(cu_out + (size_t)row * ldc + (u.pn - cu_from) * HALF + wc * 32 + 8 * fq) = w;
                } else {
#pragma unroll
                    for (int bj = 0; bj < 2; ++bj) { const f32x4 v0 = va[bj][0], v1 = va[bj][1];
                        u32x4 w; w.x = cvt_pk_bf16(v0[0], v0[1]); w.y = cvt_pk_bf16(v0[2], v0[3]); w.z = cvt_pk_bf16(v1[0], v1[1]); w.w = cvt_pk_bf16(v1[2], v1[3]);
                        *(u32x4*)(rowp + bj * HALF) = w; } } }
    }
};
struct EpiRes {
    static constexpr bool PERM = true, AFTER_DRAIN = false;
    const float* base32; const bf16_t* base16; float* out32; bf16_t* out16; int ldc; const float* gate; int rows_per_batch; int gate_stride;
    bf16_t* An; const float* n_gain; const float* n_scale; float* ss;
    __device__ __forceinline__ void operator()(const f32x4 (&acc)[2][2][4][2], const Unit& u, int wr, int wc, int fr, int fq) const {
        const int bidx = (u.pm * BM) / rows_per_batch; const float* g = gate + (size_t)bidx * gate_stride;
        const int col0 = u.pn * BM + wc * 32 + 8 * fq;
        f32x4 gv[2][2], cav[2][2];
#pragma unroll
        for (int bj = 0; bj < 2; ++bj)
#pragma unroll
            for (int n = 0; n < 2; ++n) { gv[bj][n] = *(const f32x4*)(g + col0 + bj * HALF + 4 * n);
                if (An) cav[bj][n] = *(const f32x4*)(n_gain + col0 + bj * HALF + 4 * n) * (*(const f32x4*)(n_scale + (size_t)bidx * gate_stride + col0 + bj * HALF + 4 * n) + 1.f); }
#pragma unroll
        for (int h = 0; h < 4; ++h) { const int ai = h >> 1, m0 = (h & 1) * 2;
            f32x4 pre[2][2][2];
            if (base32) {
#pragma unroll
                for (int mm = 0; mm < 2; ++mm) { const size_t off = (size_t)(u.pm * BM + ai * HALF + wr * 64 + (m0 + mm) * 16 + fr) * ldc + col0;
#pragma unroll
                    for (int bj = 0; bj < 2; ++bj)
#pragma unroll
                        for (int n = 0; n < 2; ++n) pre[mm][bj][n] = *(const f32x4*)(base32 + off + bj * HALF + 4 * n); }
            } else { u32x4 raw[2][2];
#pragma unroll
                for (int mm = 0; mm < 2; ++mm) { const size_t off = (size_t)(u.pm * BM + ai * HALF + wr * 64 + (m0 + mm) * 16 + fr) * ldc + col0;
#pragma unroll
                    for (int bj = 0; bj < 2; ++bj) raw[mm][bj] = *(const u32x4*)(base16 + off + bj * HALF); }
#pragma unroll
                for (int mm = 0; mm < 2; ++mm)
#pragma unroll
                    for (int bj = 0; bj < 2; ++bj) { const u32x4 w = raw[mm][bj];
                        pre[mm][bj][0] = (f32x4){__uint_as_float(w.x << 16), __uint_as_float(w.x & 0xffff0000u), __uint_as_float(w.y << 16), __uint_as_float(w.y & 0xffff0000u)};
                        pre[mm][bj][1] = (f32x4){__uint_as_float(w.z << 16), __uint_as_float(w.z & 0xffff0000u), __uint_as_float(w.w << 16), __uint_as_float(w.w & 0xffff0000u)}; } }
#pragma unroll
            for (int mm = 0; mm < 2; ++mm) { const int m = m0 + mm; const int row = u.pm * BM + ai * HALF + wr * 64 + m * 16 + fr; const size_t off = (size_t)row * ldc + col0;
                float ssum = 0.f;
#pragma unroll
                for (int bj = 0; bj < 2; ++bj) { f32x4 o[2];
#pragma unroll
                    for (int n = 0; n < 2; ++n) { o[n] = pre[mm][bj][n] + gv[bj][n] * acc[ai][bj][m][n];
                        ssum += (o[n][0] * o[n][0] + o[n][1] * o[n][1]) + (o[n][2] * o[n][2] + o[n][3] * o[n][3]); }
                    if (out32) { *(f32x4*)(out32 + off + bj * HALF) = o[0]; *(f32x4*)(out32 + off + bj * HALF + 4) = o[1]; }
                    else { u32x4 w; w.x = cvt_pk_bf16(o[0][0], o[0][1]); w.y = cvt_pk_bf16(o[0][2], o[0][3]); w.z = cvt_pk_bf16(o[1][0], o[1][1]); w.w = cvt_pk_bf16(o[1][2], o[1][3]); *(u32x4*)(out16 + off + bj * HALF) = w; }
                    if (An) { const f32x4 a0 = o[0] * cav[bj][0], a1 = o[1] * cav[bj][1]; u32x4 w; w.x = cvt_pk_bf16(a0[0], a0[1]); w.y = cvt_pk_bf16(a0[2], a0[3]); w.z = cvt_pk_bf16(a1[0], a1[1]); w.w = cvt_pk_bf16(a1[2], a1[3]);
                        *(u32x4*)(An + off + bj * HALF) = w; } }
                if (An) { ssum += __shfl_xor(ssum, 16); ssum += __shfl_xor(ssum, 32); if (fq == 0) ss[(size_t)row * 32 + u.pn * 4 + wc] = ssum; } }
            asm volatile("" ::: "memory");
        }
    }
};
struct EpiNull {
    static constexpr bool PERM = true, AFTER_DRAIN = false; bf16_t* O;
    __device__ __forceinline__ void operator()(const f32x4 (&acc)[2][2][4][2], const Unit& u, int wr, int wc, int fr, int fq) const {
        float s = 0.f;
#pragma unroll
        for (int ai = 0; ai < 2; ++ai)
#pragma unroll
            for (int bj = 0; bj < 2; ++bj)
#pragma unroll
                for (int m = 0; m < 4; ++m)
#pragma unroll
                    for (int n = 0; n < 2; ++n) s += acc[ai][bj][m][n][0] + acc[ai][bj][m][n][1] + acc[ai][bj][m][n][2] + acc[ai][bj][m][n][3];
        if (s == 1.2345e-30f) O[0] = 1;
    }
};
struct EpiCoal {
    static constexpr bool PERM = true, AFTER_DRAIN = false; bf16_t* O;
    __device__ __forceinline__ void operator()(const f32x4 (&acc)[2][2][4][2], const Unit& u, int wr, int wc, int fr, int fq) const {
        bf16_t* base = O + ((size_t)((u.pm * 32 + u.pn) & 511) * 65536) + (size_t)(wr * 4 + wc) * 8192 + (size_t)(fq * 16 + fr) * 8;
#pragma unroll
        for (int ai = 0; ai < 2; ++ai)
#pragma unroll
            for (int m = 0; m < 4; ++m)
#pragma unroll
                for (int bj = 0; bj < 2; ++bj) { f32x4 v0 = acc[ai][bj][m][0], v1 = acc[ai][bj][m][1];
                    v0 = __builtin_elementwise_max(v0, (f32x4){0.f, 0.f, 0.f, 0.f}); v1 = __builtin_elementwise_max(v1, (f32x4){0.f, 0.f, 0.f, 0.f}); v0 = v0 * v0; v1 = v1 * v1;
                    u32x4 w; w.x = cvt_pk_bf16(v0[0], v0[1]); w.y = cvt_pk_bf16(v0[2], v0[3]); w.z = cvt_pk_bf16(v1[0], v1[1]); w.w = cvt_pk_bf16(v1[2], v1[3]);
                    *(u32x4*)(base + (size_t)((ai * 4 + m) * 2 + bj) * 512) = w; }
    }
};
template <class Epi, class Sched, bool ALIGN_EPI = false, bool SP2 = false>
__device__ __forceinline__ void gemm_phase(PG8_LAS unsigned char* lds, const Gemm g, const Sched& S, const Epi& E) {
    const int tid = tidx(), wid = __builtin_amdgcn_readfirstlane(tid >> 6), lane = tid & 63, wr = wid >> 2, wc = wid & 3, fr = lane & 15, fq = lane >> 4;
    const int K = g.K, nt = K / BK;
    unsigned voffA[2], voffB[2];
#pragma unroll
    for (int i = 0; i < 2; ++i) { int R, C; stage_rc(tid * 16 + i * 8192, R, C); const int Rb = Epi::PERM ? ((R & ~31) + perm32(R & 31)) : R;
        voffA[i] = (unsigned)(R * K + C) * 2u; voffB[i] = (unsigned)(Rb * K + C) * 2u; }
    const size_t kstep = (size_t)(BK * 2);
    const size_t hstep = (size_t)HALF * K * 2;
    const size_t tstep = 2 * hstep;
    const unsigned ldsw = (unsigned)wid * 1024u;
    const int aoff = lds_byte(wr * 64 + fr, fq * 8), boff = lds_byte(wc * 32 + fr, fq * 8);
#define PG8_SA(b, h) (((b) * 2 + (h)) * HTB)
#define PG8_SB(b, h) ((4 + (b) * 2 + (h)) * HTB)
#define PG8_STAGE(bufoff, gbase, voff) do { _Pragma("unroll") for (int _i = 0; _i < 2; ++_i) \
        __builtin_amdgcn_global_load_lds((const unsigned*)((const char*)(gbase) + (voff)[_i]), (PG8_LAS unsigned*)(lds + (bufoff) + ldsw + _i * 8192), 16, 0, 0); } while (0)
#define PG8_LDA(dst, b, h) do { _Pragma("unroll") for (int m = 0; m < 4; ++m) _Pragma("unroll") for (int k = 0; k < 2; ++k) dst[m][k] = *(const PG8_LAS bf16x8*)(lds + PG8_SA(b, h) + aoff + m * 2048 + k * 1024); } while (0)
#define PG8_LDB(dst, b, h) do { _Pragma("unroll") for (int n = 0; n < 2; ++n) _Pragma("unroll") for (int k = 0; k < 2; ++k) dst[n][k] = *(const PG8_LAS bf16x8*)(lds + PG8_SB(b, h) + boff + n * 2048 + k * 1024); } while (0)
#define PG8_MMA(ai, bj, At, Bt) do { __builtin_amdgcn_s_setprio(1); _Pragma("unroll") for (int m = 0; m < 4; ++m) _Pragma("unroll") for (int n = 0; n < 2; ++n) _Pragma("unroll") for (int k = 0; k < 2; ++k) \
        acc[ai][bj][m][n] = __builtin_amdgcn_mfma_f32_16x16x32_bf16(Bt[n][k], At[m][k], acc[ai][bj][m][n], 0, 0, 0); __builtin_amdgcn_s_setprio(0); } while (0)
#define PG8_WAIT_V(n) asm volatile("s_waitcnt vmcnt(" #n ")" ::: "memory")
#define PG8_WAIT_L(n) asm volatile("s_waitcnt lgkmcnt(" #n ")" ::: "memory")
#define PG8_BAR __builtin_amdgcn_s_barrier()
#define PG8_SCHED __builtin_amdgcn_sched_barrier(0)
    Unit cur, nxt; int ui = 0;
    if (!S.next(0, cur)) return;
    f32x4 acc[2][2][4][2];
#pragma unroll
    for (int a = 0; a < 2; ++a)
#pragma unroll
        for (int b = 0; b < 2; ++b)
#pragma unroll
            for (int m = 0; m < 4; ++m)
#pragma unroll
                for (int n = 0; n < 2; ++n) acc[a][b][m][n] = (f32x4){0.f, 0.f, 0.f, 0.f};
    bf16x8 At[4][2], B0[2][2], B1[2][2];
    const char* cA = (const char*)g.A + (size_t)cur.pm * tstep; const char* cB = (const char*)g.Bt + (size_t)cur.pn * tstep;
    S.a_ready(cur);
    if constexpr (SP2) {
        PG8_STAGE(PG8_SB(0, 0), cB, voffB); PG8_STAGE(PG8_SB(0, 1), cB + hstep, voffB); PG8_STAGE(PG8_SA(0, 0), cA, voffA); PG8_STAGE(PG8_SA(0, 1), cA + hstep, voffA);
        if (wr == 1) PG8_BAR;
        PG8_WAIT_V(2); PG8_BAR;
        PG8_STAGE(PG8_SB(1, 0), cB + kstep, voffB); PG8_STAGE(PG8_SA(1, 0), cA + kstep, voffA); PG8_STAGE(PG8_SB(1, 1), cB + hstep + kstep, voffB);
        PG8_WAIT_V(6); PG8_BAR;
    } else {
        PG8_STAGE(PG8_SB(0, 0), cB, voffB); PG8_STAGE(PG8_SA(0, 0), cA, voffA); PG8_STAGE(PG8_SB(0, 1), cB + hstep, voffB); PG8_STAGE(PG8_SA(0, 1), cA + hstep, voffA);
        if (wr == 1) PG8_BAR;
        PG8_WAIT_V(4); PG8_BAR;
        PG8_STAGE(PG8_SB(1, 0), cB + kstep, voffB); PG8_STAGE(PG8_SA(1, 0), cA + kstep, voffA); PG8_STAGE(PG8_SB(1, 1), cB + hstep + kstep, voffB);
        PG8_WAIT_V(6); PG8_BAR;
    }
    for (;;) {
        const bool has_next = S.next(ui + 1, nxt);
        const char* nA = has_next ? (const char*)g.A + (size_t)nxt.pm * tstep : cA; const char* nB = has_next ? (const char*)g.Bt + (size_t)nxt.pn * tstep : cB;
        for (int t = 0; t < nt; t += 2) {
            const bool last = (t == nt - 2);
            const char* a1 = cA + (size_t)(t + 1) * kstep;
            const char* a2 = last ? nA : cA + (size_t)(t + 2) * kstep; const char* b2 = last ? nB : cB + (size_t)(t + 2) * kstep;
            const char* a3 = a2 + kstep; const char* b3 = b2 + kstep;
            if (last && has_next) S.a_ready(nxt);
            if constexpr (SP2) {
            PG8_LDB(B0, 0, 0); PG8_LDB(B1, 0, 1); PG8_SCHED; PG8_LDA(At, 0, 0); PG8_STAGE(PG8_SA(1, 1), a1 + hstep, voffA);
            PG8_WAIT_V(8); PG8_WAIT_L(0); PG8_BAR; PG8_MMA(0, 0, At, B0); PG8_MMA(0, 1, At, B1); PG8_BAR; PG8_SCHED;
            PG8_LDA(At, 0, 1); PG8_STAGE(PG8_SB(0, 0), b2, voffB); PG8_STAGE(PG8_SB(0, 1), b2 + hstep, voffB); PG8_STAGE(PG8_SA(0, 0), a2, voffA);
            PG8_WAIT_V(8); PG8_WAIT_L(0); PG8_BAR; PG8_MMA(1, 0, At, B0); PG8_MMA(1, 1, At, B1); PG8_BAR; PG8_SCHED;
            PG8_LDB(B0, 1, 0); PG8_LDB(B1, 1, 1); PG8_SCHED; PG8_LDA(At, 1, 0); PG8_STAGE(PG8_SA(0, 1), a2 + hstep, voffA);
            PG8_WAIT_V(8); PG8_WAIT_L(0); PG8_BAR; PG8_MMA(0, 0, At, B0); PG8_MMA(0, 1, At, B1); PG8_BAR; PG8_SCHED;
            PG8_LDA(At, 1, 1); PG8_STAGE(PG8_SB(1, 0), b3, voffB); PG8_STAGE(PG8_SB(1, 1), b3 + hstep, voffB); PG8_STAGE(PG8_SA(1, 0), a3, voffA);
            PG8_WAIT_V(8); PG8_WAIT_L(0); PG8_BAR; PG8_MMA(1, 0, At, B0); PG8_MMA(1, 1, At, B1); PG8_BAR; PG8_SCHED;
            } else {
            PG8_LDB(B0, 0, 0); PG8_SCHED; PG8_LDA(At, 0, 0); PG8_STAGE(PG8_SA(1, 1), a1 + hstep, voffA);
            PG8_WAIT_L(8); PG8_BAR; PG8_WAIT_L(0); PG8_MMA(0, 0, At, B0); PG8_BAR; PG8_SCHED;
            PG8_LDB(B1, 0, 1); PG8_STAGE(PG8_SB(0, 0), b2, voffB);
            PG8_BAR; PG8_WAIT_L(0); PG8_MMA(0, 1, At, B1); PG8_BAR;
            PG8_LDA(At, 0, 1); PG8_STAGE(PG8_SA(0, 0), a2, voffA);
            PG8_BAR; PG8_WAIT_L(0); PG8_MMA(1, 0, At, B0); PG8_BAR; PG8_SCHED;
            PG8_STAGE(PG8_SB(0, 1), b2 + hstep, voffB);
            PG8_WAIT_V(6); PG8_BAR; PG8_MMA(1, 1, At, B1); PG8_BAR;
            PG8_LDB(B0, 1, 0); PG8_SCHED; PG8_LDA(At, 1, 0); PG8_STAGE(PG8_SA(0, 1), a2 + hstep, voffA);
            PG8_WAIT_L(8); PG8_BAR; PG8_WAIT_L(0); PG8_MMA(0, 0, At, B0); PG8_BAR; PG8_SCHED;
            PG8_LDB(B1, 1, 1); PG8_STAGE(PG8_SB(1, 0), b3, voffB);
            PG8_BAR; PG8_WAIT_L(0); PG8_MMA(0, 1, At, B1); PG8_BAR;
            PG8_LDA(At, 1, 1); PG8_STAGE(PG8_SA(1, 0), a3, voffA);
            PG8_BAR; PG8_WAIT_L(0); PG8_MMA(1, 0, At, B0); PG8_BAR; PG8_SCHED;
            PG8_STAGE(PG8_SB(1, 1), b3 + hstep, voffB);
            PG8_WAIT_V(6); PG8_BAR; PG8_MMA(1, 1, At, B1); PG8_BAR;
            }
        }
        if constexpr (ALIGN_EPI) { if (wr == 0) PG8_BAR; }
        if constexpr (!Epi::AFTER_DRAIN) { E(acc, cur, wr, wc, fr, fq); S.done(cur); }
        if (!has_next) break;
#pragma unroll
        for (int a = 0; a < 2; ++a)
#pragma unroll
            for (int b = 0; b < 2; ++b)
#pragma unroll
                for (int m = 0; m < 4; ++m)
#pragma unroll
                    for (int n = 0; n < 2; ++n) acc[a][b][m][n] = (f32x4){0.f, 0.f, 0.f, 0.f};
        cur = nxt; cA = nA; cB = nB; ++ui;
        if constexpr (ALIGN_EPI) { if (wr == 1) PG8_BAR; }
    }
    PG8_WAIT_V(0);
    if constexpr (!ALIGN_EPI) { if (wr == 0) PG8_BAR; }
    PG8_BAR;
    if constexpr (Epi::AFTER_DRAIN) { E.fused(acc, cur, wr, wc, fr, fq, lds, wid, lane); S.done(cur); }
#undef PG8_SA
#undef PG8_SB
#undef PG8_STAGE
#undef PG8_LDA
#undef PG8_LDB
#undef PG8_MMA
#undef PG8_WAIT_V
#undef PG8_WAIT_L
#undef PG8_BAR
#undef PG8_SCHED
}
}
namespace att {
enum { ORDER_NATURAL = 0, ORDER_REVERSED = 1, ORDER_PAIRED = 2, ORDER_XCD = 4 };
constexpr int D = 128, PITCH = 2048;
constexpr float THR = 8.f;
constexpr bool WSKIP = false;
constexpr int NW = 8, QBLK = 32, KVBLK = 64, QB = NW * QBLK;
constexpr int SHM_V = KVBLK * D * 2, SHM_K = KVBLK * D * 2;
constexpr int LDS_BYTES = 2 * SHM_V + 2 * SHM_K + NW * 64 * 4;


using bf16 = __hip_bfloat16;
typedef short bf16x8 __attribute__((ext_vector_type(8)));
typedef short s16x4 __attribute__((ext_vector_type(4)));
typedef float f32x16 __attribute__((ext_vector_type(16)));
typedef float f32x4 __attribute__((ext_vector_type(4)));
typedef unsigned u32x4 __attribute__((ext_vector_type(4)));
template <class A, class Bt> struct same_t { static constexpr bool v = false; };
template <class A> struct same_t<A, A> { static constexpr bool v = true; };

#define KSWZ(row, colB) ((row) * 256 + ((colB) ^ (((row) & 7) << 4)))
#define SBAR() __builtin_amdgcn_sched_barrier(0)
__device__ __forceinline__ int v_st(int k, int c) { const int kk = (k & ~0xC) | ((k & 4) << 1) | ((k & 8) >> 1); return ((kk >> 3) * 4 + (c >> 5)) * 512 + ((kk & 7) * 32 + (c & 31)) * 2; }
__device__ __forceinline__ int v_rd_base(int lane) { return ((lane & 3) << 3) | (((lane >> 2) & 3) << 6) | (((lane >> 4) & 1) << 5) | (((lane >> 5) & 1) << 8); }
constexpr int v_rd_off(int d0, int ks, int half) { return d0 * 512 + ks * 4096 + half * 2048; }
__device__ __forceinline__ int crow(int r, int hi) { return (r & 3) + 8 * (r >> 2) + 4 * hi; }
__device__ __forceinline__ unsigned cvtpk(float lo, float hi) {
    unsigned r; asm volatile("v_cvt_pk_bf16_f32 %0, %1, %2" : "=v"(r) : "v"(lo), "v"(hi)); return r;
}
__device__ __forceinline__ bf16x8 pack8(f32x4 a, f32x4 b) {
    u32x4 w = {cvtpk(a[0], a[1]), cvtpk(a[2], a[3]), cvtpk(b[0], b[1]), cvtpk(b[2], b[3])};
    return *reinterpret_cast<bf16x8*>(&w);
}
template <class T> __device__ __forceinline__ bf16x8 load8(const T* p) {
    if constexpr (same_t<T, float>::v) { return pack8(*(const f32x4*)p, *(const f32x4*)(p + 4)); }
    else { return *reinterpret_cast<const bf16x8*>(p); }
}
__device__ __forceinline__ void mask_tile(f32x16& p0, f32x16& p1, int dq, unsigned W) {
    const float NEG = -__builtin_inff();
#pragma unroll
    for (int r = 0; r < 16; ++r) {
        const int c = (r & 3) + 8 * (r >> 2);
        if ((unsigned)(dq - c) >= W) p0[r] = NEG;
        if ((unsigned)(dq - c - 32) >= W) p1[r] = NEG;
    }
}
__device__ __forceinline__ void partialSM(f32x16& p0, f32x16& p1, float& m_reg, float& mn, float& alpha) {
    float pmax = p0[0]; for (int r = 1; r < 16; ++r) pmax = fmaxf(pmax, p0[r]); for (int r = 0; r < 16; ++r) pmax = fmaxf(pmax, p1[r]);
    { auto rr = __builtin_amdgcn_permlane32_swap(__float_as_uint(pmax), __float_as_uint(pmax), false, false);
      pmax = fmaxf(__uint_as_float(rr[0]), __uint_as_float(rr[1])); }
    if (__builtin_expect(__all((pmax - m_reg) <= THR), 1)) { mn = m_reg; alpha = 1.f; }
    else { mn = fmaxf(m_reg, pmax); alpha = __builtin_amdgcn_exp2f(m_reg - mn); m_reg = mn; }
    for (int r = 0; r < 16; ++r) p0[r] = p0[r] - mn; for (int r = 0; r < 16; ++r) p1[r] = p1[r] - mn;
    for (int r = 0; r < 16; ++r) p0[r] = __builtin_amdgcn_exp2f(p0[r]);
}
__device__ __forceinline__ void finishSM(f32x16& p0, f32x16& p1, float alpha, float& l_reg, bf16x8& pa0, bf16x8& pa1, bf16x8& pa2, bf16x8& pa3) {
    for (int r = 0; r < 16; ++r) p1[r] = __builtin_amdgcn_exp2f(p1[r]);
    float ps = 0; for (int r = 0; r < 16; ++r) ps += p0[r]; for (int r = 0; r < 16; ++r) ps += p1[r];
    { auto rr = __builtin_amdgcn_permlane32_swap(__float_as_uint(ps), __float_as_uint(ps), false, false);
      ps = __uint_as_float(rr[0]) + __uint_as_float(rr[1]); }
    l_reg = l_reg * alpha + ps;
#define PK4(P, B_, OUT) do { unsigned a0 = cvtpk(P[B_+0], P[B_+1]), a1 = cvtpk(P[B_+2], P[B_+3]);                          \
        unsigned b0 = cvtpk(P[B_+4], P[B_+5]), b1 = cvtpk(P[B_+6], P[B_+7]);                                             \
        auto r0 = __builtin_amdgcn_permlane32_swap(a0, b0, false, false); auto r1 = __builtin_amdgcn_permlane32_swap(a1, b1, false, false); \
        u32x4 w = {r0[0], r1[0], r0[1], r1[1]}; OUT = *reinterpret_cast<bf16x8*>(&w); } while (0)
    PK4(p0, 0, pa0); PK4(p0, 8, pa1); PK4(p1, 0, pa2); PK4(p1, 8, pa3);
#undef PK4
}
template <int KB, bool SK>
__device__ __forceinline__ void qkt(f32x16& p0, f32x16& p1, const char* K_lds, int r32, int hi, const bf16x8* qr, bool act, const char* Ft) {
    if (SK && !act) { const float NEG = -__builtin_inff();
#pragma unroll
        for (int r = 0; r < 16; ++r) { p0[r] = NEG; p1[r] = NEG; } return; }
    { const f32x4* fp = (const f32x4*)Ft;
      const f32x4 a0 = fp[0], a1 = fp[2], a2 = fp[4], a3 = fp[6], b0_ = fp[8], b1_ = fp[10], b2_ = fp[12], b3_ = fp[14];
      p0 = (f32x16){a0[0], a0[1], a0[2], a0[3], a1[0], a1[1], a1[2], a1[3], a2[0], a2[1], a2[2], a2[3], a3[0], a3[1], a3[2], a3[3]};
      p1 = (f32x16){b0_[0], b0_[1], b0_[2], b0_[3], b1_[0], b1_[1], b1_[2], b1_[3], b2_[0], b2_[1], b2_[2], b2_[3], b3_[0], b3_[1], b3_[2], b3_[3]}; }
    const char* kb[4];
#pragma unroll
    for (int dd = 0; dd < 4; ++dd) kb[dd] = K_lds + KB * SHM_K + KSWZ(r32, (dd * 16 + hi * 8) * 2);
#pragma unroll
    for (int d0 = 0; d0 < 8; ++d0) { const char* a = kb[d0 & 3] + (d0 >> 2) * 128;
        bf16x8 b0 = *reinterpret_cast<const bf16x8*>(a);
        bf16x8 b1 = *reinterpret_cast<const bf16x8*>(a + 32 * 256);
        p0 = __builtin_amdgcn_mfma_f32_32x32x16_bf16(b0, qr[d0], p0, 0, 0, 0);
        p1 = __builtin_amdgcn_mfma_f32_32x32x16_bf16(b1, qr[d0], p1, 0, 0, 0); }
}
template <int VB, bool SK>
__device__ __forceinline__ void pv_tile(f32x16* o, int vb0, bf16x8 pa0, bf16x8 pa1, bf16x8 pa2, bf16x8 pa3, bool act) {
    if (SK && !act) return;
#define TRRD(dst, off) asm volatile("ds_read_b64_tr_b16 %0, %1 offset:%2" : "=&v"(dst) : "v"(vb0), "i"(off) : "memory")
#define PV_D0(d0) do { s16x4 l0, l1, l2, l3, h0, h1, h2, h3; constexpr int b_ = VB * SHM_V + v_rd_off(d0, 0, 0);     \
        TRRD(l0, b_); TRRD(h0, b_ + 2048); TRRD(l1, b_ + 4096); TRRD(h1, b_ + 6144); TRRD(l2, b_ + 8192); TRRD(h2, b_ + 10240); TRRD(l3, b_ + 12288); TRRD(h3, b_ + 14336); \
        asm volatile("s_waitcnt lgkmcnt(0)" ::: "memory"); SBAR();                 \
        o[d0] = __builtin_amdgcn_mfma_f32_32x32x16_bf16(pa0, (bf16x8){l0[0], l0[1], l0[2], l0[3], h0[0], h0[1], h0[2], h0[3]}, o[d0], 0, 0, 0);   \
        o[d0] = __builtin_amdgcn_mfma_f32_32x32x16_bf16(pa1, (bf16x8){l1[0], l1[1], l1[2], l1[3], h1[0], h1[1], h1[2], h1[3]}, o[d0], 0, 0, 0);   \
        o[d0] = __builtin_amdgcn_mfma_f32_32x32x16_bf16(pa2, (bf16x8){l2[0], l2[1], l2[2], l2[3], h2[0], h2[1], h2[2], h2[3]}, o[d0], 0, 0, 0);   \
        o[d0] = __builtin_amdgcn_mfma_f32_32x32x16_bf16(pa3, (bf16x8){l3[0], l3[1], l3[2], l3[3], h3[0], h3[1], h3[2], h3[3]}, o[d0], 0, 0, 0); } while (0)
    PV_D0(0); PV_D0(1); PV_D0(2); PV_D0(3);
#undef PV_D0
#undef TRRD
}

template <class TIn, class TOut> struct BlockRef { const TIn* Q; const TIn* K; const TIn* V; TOut* O; const float* F; int P0; int jlo; };
template <class TIn> struct Seam {
    bf16x8 qr[8];
    bf16x8 st_v0, st_v1, st_k0, st_k1; f32x4 sf0, sf1, sf2, sf3;
    f32x4 tq[16];
};
__device__ __forceinline__ int swa_jlo(int P0, int W) { const int lowk = P0 - W + 1; return lowk > 0 ? lowk / KVBLK : 0; }
#define ROW(p, k0, rr) ((p) + (size_t)((k0) + (rr)) * PITCH + sc)
#define VMW() asm volatile("s_waitcnt vmcnt(0)" ::: "memory")
#define VMWN(n) asm volatile("s_waitcnt vmcnt(%0)" :: "i"(n) : "memory")
#define GROW(p, k0, vo) ((const char*)((p) + (size_t)(k0) * PITCH) + (vo))
#define SLOAD_H(Kp, Vp, k0) do { S.st_v0 = *(const bf16x8*)GROW(Vp, k0, vo0); S.st_v1 = *(const bf16x8*)GROW(Vp, k0, vo1);              \
                         S.st_k0 = *(const bf16x8*)GROW(Kp, k0, vo0); S.st_k1 = *(const bf16x8*)GROW(Kp, k0, vo1); } while (0)
#define SWRITE_HK(bf) do { *(bf16x8*)(K_lds + (bf) * SHM_K + kws) = S.st_k0; *(bf16x8*)(K_lds + (bf) * SHM_K + kws + 32 * 256) = S.st_k1; } while (0)
#define SWRITE_HV(bf) do { *(bf16x8*)(V_lds + (bf) * SHM_V + vst0) = S.st_v0; *(bf16x8*)(V_lds + (bf) * SHM_V + vst1) = S.st_v1; } while (0)
#define SWRITE_H(bf) do { SWRITE_HV(bf); SWRITE_HK(bf); } while (0)
#define SLOAD_F(p, k0) do { S.sf0 = *(const f32x4*)ROW(p, k0, sr); S.sf1 = *(const f32x4*)(ROW(p, k0, sr) + 4);                \
                            S.sf2 = *(const f32x4*)ROW(p, k0, 32 + sr); S.sf3 = *(const f32x4*)(ROW(p, k0, 32 + sr) + 4); } while (0)
#define SWRITE_KF(bf) do { *(bf16x8*)(K_lds + (bf) * SHM_K + kws) = pack8(S.sf0, S.sf1); *(bf16x8*)(K_lds + (bf) * SHM_K + kws + 32 * 256) = pack8(S.sf2, S.sf3); } while (0)
#define SWRITE_VF(bf) do { *(bf16x8*)(V_lds + (bf) * SHM_V + vst0) = pack8(S.sf0, S.sf1); *(bf16x8*)(V_lds + (bf) * SHM_V + vst1) = pack8(S.sf2, S.sf3); } while (0)
template <class TIn, class TOut>
__device__ __forceinline__ void causal_swa_prime(const BlockRef<TIn, TOut>& cur, int W, char* lds, Seam<TIn>& S, char* Fdst) {
    constexpr bool F32 = same_t<TIn, float>::v;
    const int tid = tidx(), wid = __builtin_amdgcn_readfirstlane(tid >> 6), lane = tid & 63, r32 = lane & 31, hi = lane >> 5;
    const int sr = tid >> 4, sc = (tid & 15) * 8, kws = KSWZ(sr, sc * 2); char* K_lds = lds + 2 * SHM_V;
    const unsigned vo0 = (unsigned)(sr * PITCH + sc) * 2u, vo1 = vo0 + 32u * PITCH * 2u, qvo = (unsigned)(r32 * PITCH + hi * 8) * 2u;
    const int kb0 = cur.jlo * KVBLK;
    for (int d0 = 0; d0 < 8; ++d0) S.qr[d0] = *(const bf16x8*)((const char*)(cur.Q + (size_t)(wid * QBLK) * PITCH) + qvo + d0 * 32);
    if constexpr (F32) { SLOAD_F((const float*)cur.K, kb0); VMW(); SWRITE_KF(0); SBAR(); SLOAD_F((const float*)cur.V, kb0); }
    else { const f32x4 fa = *(const f32x4*)(cur.F + tid * 4), fb = *(const f32x4*)(cur.F + 2048 + tid * 4);
           SLOAD_H(cur.K, cur.V, kb0); VMW(); SWRITE_HK(0);
           *(f32x4*)(Fdst + tid * 16) = fa; *(f32x4*)(Fdst + 8192 + tid * 16) = fb; }
    __syncthreads();
}
template <class TIn, class TOut>
__device__ __forceinline__ void causal_swa_block(const BlockRef<TIn, TOut>& cur, const BlockRef<TIn, TOut>& nxt, int skv, int W, char* lds, Seam<TIn>& S, const char* Fcur, char* Fnext) {
    constexpr bool F32 = same_t<TIn, float>::v;
    const int tid = tidx(), wid = __builtin_amdgcn_readfirstlane(tid >> 6), lane = tid & 63, r32 = lane & 31, hi = lane >> 5;
    const int j_lo = cur.jlo;
    int j_hi = (cur.P0 + QB - 1) / KVBLK + 1; if (j_hi > skv / KVBLK) j_hi = skv / KVBLK;
    const int NT = j_hi - j_lo;
    const int kbn = nxt.jlo * KVBLK;
    const int qlo = cur.P0 + wid * QBLK, qm = qlo + r32 - 4 * hi;
    char* V_lds = lds; char* K_lds = lds + 2 * SHM_V;
    float* ws = (float*)(lds + 2 * SHM_V + 2 * SHM_K) + wid * 64; float* li_l = ws, * al_l = ws + 32;
    float m_reg = *(const float*)(Fcur + (size_t)(cur.P0 + wid * QBLK + r32) * 4), l_reg = 0; f32x16 o[4] = {};
    const unsigned vo0 = (unsigned)((tid >> 4) * PITCH + (tid & 15) * 8) * 2u, vo1 = vo0 + 32u * PITCH * 2u, qvo = (unsigned)(r32 * PITCH + hi * 8) * 2u;
    const int sr = tid >> 4, sc = (tid & 15) * 8, vst0 = v_st(sr, sc), vst1 = v_st(32 + sr, sc), kws = KSWZ(sr, sc * 2);
    const int vb0 = (int)(uintptr_t)V_lds + v_rd_base(lane);
    const TIn* Kh = cur.K; const TIn* Vh = cur.V;
#define RESC(a) do { if (__any((a) < 1.f)) { if (hi == 0) al_l[r32] = (a); asm volatile("s_waitcnt lgkmcnt(0)" ::: "memory");              \
                     for (int d_ = 0; d_ < 4; ++d_) for (int r = 0; r < 16; ++r) o[d_][r] *= al_l[crow(r, hi)]; } } while (0)
#define KBASE(t) ((j_lo + (t)) * KVBLK)
#define ACT(t) (KBASE(t) <= qlo + QBLK - 1 && KBASE(t) + KVBLK - 1 >= qlo - W + 1)
#define MASKT(P0_, P1_, t) do { const int kb_ = KBASE(t); if ((!SK || ACT(t)) && (kb_ + KVBLK - 1 > qlo || kb_ <= qlo + QBLK - 1 - W)) mask_tile(P0_, P1_, qm - kb_, (unsigned)W); } while (0)
    constexpr int NQL = F32 ? 16 : 8;
    constexpr bool SK = WSKIP && !F32;
#define SEAM_K0() do { VMWN(NQL); if constexpr (F32) { SWRITE_KF(0); SBAR(); SLOAD_F((const float*)nxt.V, kbn); } else { SWRITE_HK(0); } SBAR(); } while (0)
    f32x16 pA0, pA1, pB0, pB1; float mnA, mnB, alA, alB; bf16x8 pa0, pa1, pa2, pa3;
    if constexpr (F32) { VMW(); SWRITE_VF(0); SBAR(); } else { SWRITE_HV(0); SBAR(); }
    if (NT > 1) { if constexpr (F32) SLOAD_F((const float*)Kh, KBASE(1)); else SLOAD_H(Kh, Vh, KBASE(1)); }
    SBAR(); qkt<0, SK>(pA0, pA1, K_lds, r32, hi, S.qr, ACT(0), Fcur + KBASE(0) * 4 + hi * 16);
    if constexpr (F32) { if (NT > 1) { VMW(); SWRITE_KF(1); SBAR(); SLOAD_F((const float*)Vh, KBASE(1)); } }
    MASKT(pA0, pA1, 0); partialSM(pA0, pA1, m_reg, mnA, alA);
    if (NT > 1) { VMW(); if constexpr (F32) { SWRITE_VF(1); SBAR(); if (NT > 2) SLOAD_F((const float*)Kh, KBASE(2)); } else SWRITE_H(1); }
    __syncthreads();
#define HALF_STEP(PX0, PX1, mnX, alX, PY0, PY1, alY, t, KB, VB, SB) do {                                                      \
        SBAR(); qkt<KB, SK>(PX0, PX1, K_lds, r32, hi, S.qr, ACT(t), Fcur + KBASE(t) * 4 + hi * 16);                                             \
        finishSM(PY0, PY1, alY, l_reg, pa0, pa1, pa2, pa3); SBAR();                                                           \
        if ((t) + 1 < NT) { if constexpr (F32) { VMW(); SWRITE_KF(SB); SBAR(); SLOAD_F((const float*)Vh, KBASE((t) + 1)); }  \
                            else { SLOAD_H(Kh, Vh, KBASE((t) + 1)); } SBAR(); }                                               \
        pv_tile<VB, SK>(o, vb0, pa0, pa1, pa2, pa3, ACT((t) - 1)); MASKT(PX0, PX1, (t)); partialSM(PX0, PX1, m_reg, mnX, alX);                                        \
        __syncthreads();                                                                                                      \
        if ((t) + 1 < NT) { VMW(); if constexpr (F32) { SWRITE_VF(SB); SBAR(); if ((t) + 2 < NT) SLOAD_F((const float*)Kh, KBASE((t) + 2)); } \
                            else { SWRITE_H(SB); } }                                                                          \
        RESC(alX); __syncthreads(); } while (0)
    for (int t = 1; t + 1 < NT; t += 2) {
        HALF_STEP(pB0, pB1, mnB, alB, pA0, pA1, alA, t, 1, 0, 0);
        HALF_STEP(pA0, pA1, mnA, alA, pB0, pB1, alB, t + 1, 0, 1, 1);
    }
    const bool even = (NT & 1) == 0;
    if (even) { SBAR(); qkt<1, SK>(pB0, pB1, K_lds, r32, hi, S.qr, ACT(NT - 1), Fcur + KBASE(NT - 1) * 4 + hi * 16); SBAR(); }
#define QROW(e) (nxt.Q + (size_t)(wid * QBLK + r32) * PITCH + ((e) >> 1) * 16 + hi * 8 + ((e) & 1) * 4)
    if constexpr (F32) { SLOAD_F((const float*)nxt.K, kbn); SBAR();
#pragma unroll
        for (int e = 0; e < 8; ++e) S.tq[e] = *(const f32x4*)QROW(e); }
    if constexpr (!F32) { SLOAD_H(nxt.K, nxt.V, kbn); SBAR();
#pragma unroll
        for (int d0 = 0; d0 < 8; ++d0) S.qr[d0] = *(const bf16x8*)((const char*)(nxt.Q + (size_t)(wid * QBLK) * PITCH) + qvo + d0 * 32); }
    SBAR();
    finishSM(pA0, pA1, alA, l_reg, pa0, pa1, pa2, pa3); SBAR();
    if constexpr (F32) {
#pragma unroll
        for (int e = 8; e < 16; ++e) S.tq[e] = *(const f32x4*)QROW(e); SBAR(); }
#undef QROW
    pv_tile<0, SK>(o, vb0, pa0, pa1, pa2, pa3, ACT(even ? NT - 2 : NT - 1));
    if (even) { MASKT(pB0, pB1, NT - 1); partialSM(pB0, pB1, m_reg, mnB, alB); __syncthreads(); RESC(alB);
        finishSM(pB0, pB1, alB, l_reg, pa0, pa1, pa2, pa3); SBAR(); pv_tile<1, SK>(o, vb0, pa0, pa1, pa2, pa3, ACT(NT - 1)); }
    SBAR(); SEAM_K0();
    { const f32x4 nfa = *(const f32x4*)(nxt.F + tid * 4), nfb = *(const f32x4*)(nxt.F + 2048 + tid * 4); VMW();
      *(f32x4*)(Fnext + tid * 16) = nfa; *(f32x4*)(Fnext + 8192 + tid * 16) = nfb; SBAR(); }
    if (hi == 0) li_l[r32] = l_reg; asm volatile("s_waitcnt lgkmcnt(0)" ::: "memory");
    float rli[16];
#pragma unroll
    for (int r = 0; r < 16; ++r) rli[r] = __builtin_amdgcn_rcpf(li_l[crow(r, hi)]);
    TOut* Ow = cur.O + (size_t)(wid * QBLK) * PITCH; const unsigned ovo = (unsigned)(4 * hi * PITCH + r32) * 2u;
#pragma unroll
    for (int r = 0; r < 16; ++r) { const int orow = crow(r, hi);
#pragma unroll
        for (int d0 = 0; d0 < 4; ++d0) { const float v = o[d0][r] * rli[r];
            if constexpr (same_t<TOut, float>::v) { Ow[(size_t)orow * PITCH + d0 * 32 + r32] = v; }
            else { const float vn = __shfl_xor(v, 1);
                   if ((r32 & 1) == 0) *(unsigned*)((char*)(Ow + (size_t)((r & 3) + 8 * (r >> 2)) * PITCH + d0 * 32) + ovo) = cvtpk(v, vn); } } }
    if constexpr (F32) {
#pragma unroll
        for (int d0 = 0; d0 < 8; ++d0) S.qr[d0] = pack8(S.tq[2 * d0], S.tq[2 * d0 + 1]); }
    __syncthreads();
#undef RESC
#undef KBASE
#undef ACT
#undef MASKT
#undef SEAM_K0
#undef HALF_STEP
}
#undef ROW
#undef VMW
#undef VMWN
#undef SLOAD_H
#undef GROW
#undef SWRITE_HK
#undef SWRITE_HV
#undef SWRITE_H
#undef SLOAD_F
#undef SWRITE_KF
#undef SWRITE_VF

constexpr int ATT_F_OFF = LDS_BYTES;
constexpr int ATT_LDS_TOTAL = LDS_BYTES + 2 * 16384;
}
constexpr int BATCH = 4, SEQ = 4096, DM = 2048, NH = 16, HD = 128, FF = 8192, M = BATCH * SEQ;
constexpr int NIN = 3 * DM + NH;
constexpr int NMOD = 6 * DM;
constexpr float RMS_EPS = 1e-6f;
constexpr float LOG2E = 1.4426950408889634f;
constexpr float QSCALE = 0.08838834764831845f * LOG2E;
constexpr int NWAVES = 8, NTHREADS = 512;
constexpr int LDS_TOTAL = 147456;
constexpr int NPHASES = 13;
#ifndef PH_MASK
#define PH_MASK 0xff
#endif
#define KEN(k) ((PH_MASK >> (k)) & 1)
constexpr size_t MiB = 1u << 20;
constexpr size_t WS_MOD = 1 * MiB, WS_SW = 1 * MiB + 512 * 1024, WS_LF = 2 * MiB, WS_FK = 3 * MiB;
constexpr size_t WS_SS = 516 * MiB;
constexpr int SW_UP0 = 0, SW_CIN = 4 * 8192, SW_UP1 = 4 * 8192 + 4 * 6144;
constexpr size_t WS_WQKV = 4 * MiB, WS_WO = 28 * MiB, WS_WCIN = 36 * MiB, WS_WCOUT = 60 * MiB, WS_WUP0 = 68 * MiB, WS_WUP1 = 100 * MiB, WS_WDN0 = 132 * MiB, WS_WDN1 = 164 * MiB;
constexpr size_t WS_XN = 196 * MiB, WS_Q = 260 * MiB, WS_K = 324 * MiB, WS_V = 388 * MiB, WS_O = 452 * MiB, WS_U = 260 * MiB, WS_XRB = 518 * MiB, WS_NRM = 582 * MiB, WS_END = 590 * MiB;
static_assert(WS_U + (size_t)M * FF * 2 == WS_SS && WS_O + (size_t)M * DM * 2 == WS_SS && WS_SS + (size_t)M * 32 * 4 == WS_XRB && WS_XRB + (size_t)M * DM * 2 == WS_NRM && WS_NRM + (size_t)2 * M * 64 * 4 == WS_END && WS_XN + (size_t)M * DM * 2 == WS_Q, "d_ws map");

#define LAS __attribute__((address_space(3)))
typedef unsigned short bf16;
typedef unsigned v4u __attribute__((ext_vector_type(4)));
typedef unsigned v2u __attribute__((ext_vector_type(2)));
typedef float f32x4 __attribute__((ext_vector_type(4)));
typedef float f32x2 __attribute__((ext_vector_type(2)));
#define LDS_WAIT() asm volatile("s_waitcnt lgkmcnt(0)" ::: "memory")
__device__ __forceinline__ unsigned pk2(float lo, float hi) { unsigned r; asm volatile("v_cvt_pk_bf16_f32 %0, %1, %2" : "=v"(r) : "v"(lo), "v"(hi)); return r; }
__device__ __forceinline__ float bf_lo(unsigned w) { return __uint_as_float(w << 16); }
__device__ __forceinline__ float bf_hi(unsigned w) { return __uint_as_float(w & 0xffff0000u); }
__device__ __forceinline__ float wave_sum(float v) {
#pragma unroll
    for (int o = 1; o < 64; o <<= 1) v += __shfl_xor(v, o);
    return v;
}

__device__ __forceinline__ void p0_gemv(const float* c, const float* ada_w, const float* ada_b, float* mod, LAS unsigned char* lds, int tid, int wave, int lane) {
    LAS f32x4* cact = (LAS f32x4*)lds;
    LAS float* red = (LAS float*)(lds + 32768);
    for (int k = tid; k < DM; k += NTHREADS) { f32x4 v;
#pragma unroll
        for (int b = 0; b < 4; ++b) { const float cv = c[b * DM + k]; v[b] = cv / (1.f + expf(-cv)); }
        cact[k] = v; }
    __syncthreads();
    for (int it = blockIdx.x; it < 192; it += gridDim.x) {
        const int l = it / 96, n0 = (it % 96) * 128;
        const float* wp = ada_w + ((size_t)l * DM + 256 * wave) * NMOD + n0 + 2 * lane;
        f32x2 acc[4];
#pragma unroll
        for (int b = 0; b < 4; ++b) acc[b] = (f32x2){0.f, 0.f};
#pragma unroll 16
        for (int kk = 0; kk < 256; ++kk) { const f32x2 wv = __builtin_nontemporal_load((const f32x2*)(wp + (size_t)kk * NMOD));   const f32x4 cv = cact[256 * wave + kk];
#pragma unroll
            for (int b = 0; b < 4; ++b) acc[b] += wv * cv[b]; }
#pragma unroll
        for (int b = 0; b < 4; ++b) *(LAS f32x2*)(red + (wave * 4 + b) * 128 + 2 * lane) = acc[b];
        __syncthreads();
        { const int b = tid >> 7, col = tid & 127; float s = ada_b[l * NMOD + n0 + col];
#pragma unroll
          for (int w = 0; w < 8; ++w) s += red[(w * 4 + b) * 128 + col];
          mod[(size_t)(l * 4 + b) * NMOD + n0 + col] = s; }
        __syncthreads();
    }
}
__device__ __forceinline__ void p0_transpose_item(const float* W, int ld, int K, int nblk, bf16* WT, LAS float* scr, int item, int lane, bool cumap = false) {
    const int kb = item / nblk, nb = item % nblk, k0 = 64 * kb, n0 = 32 * nb;
    const int d0 = !cumap || n0 < DM ? n0 : (n0 < 2 * DM ? DM + 256 * ((n0 - DM) >> 7) + ((n0 - DM) & 127) : DM + 256 * ((n0 - 2 * DM) >> 7) + 128 + ((n0 - 2 * DM) & 127));
#pragma unroll 8
    for (int i = 0; i < 32; ++i) { const int kk = 2 * i + (lane >> 5); scr[kk * 33 + (lane & 31)] = __builtin_nontemporal_load(W + (size_t)(k0 + kk) * ld + n0 + (lane & 31)); }
    LDS_WAIT(); asm volatile("" ::: "memory");
    const int c = lane & 7;
#pragma unroll
    for (int j = 0; j < 4; ++j) { const int n = (lane >> 3) + 8 * j; const LAS float* s = scr + (8 * c) * 33 + n;
        v4u o; o.x = pk2(s[0 * 33], s[1 * 33]); o.y = pk2(s[2 * 33], s[3 * 33]); o.z = pk2(s[4 * 33], s[5 * 33]); o.w = pk2(s[6 * 33], s[7 * 33]);
        *(v4u*)(WT + (size_t)(d0 + n) * K + k0 + 8 * c) = o; }
    LDS_WAIT(); asm volatile("" ::: "memory");
}
struct Args { const float* in[15]; float* out; unsigned char* ws; int ph_lo, ph_hi; };
typedef const __attribute__((address_space(4))) unsigned char* kargp_t;
#define KARG_IN(kq, i) (*(const float* const __attribute__((address_space(4)))*)((kq) + 8 * (i)))
#define KARG_OUT(kq) (*(float* const __attribute__((address_space(4)))*)((kq) + 120))
#define KARG_WS(kq) (*(unsigned char* const __attribute__((address_space(4)))*)((kq) + 128))
static_assert(sizeof(Args) == 144, "Args layout");
__device__ __forceinline__ void p0_transposes(kargp_t kq, LAS unsigned char* lds, int wave, int lane, int gw, int ngw) {
    LAS float* scr = (LAS float*)(lds + wave * 16384);
    unsigned char* ws = KARG_WS(kq);
    constexpr int I_IN = 32 * 192, I_SQ = 32 * 64, I_UP = 32 * 256, I_DN = 128 * 64;
    constexpr int NITEMS = 2 * I_IN + 2 * I_SQ + 2 * I_UP + 2 * I_DN;
    const bool deal = (ngw == 2048); static_assert(NITEMS == 1536 * 22 + 512 * 30, "prologue item deal");
    const int lo_wave = gw < 1536, first = deal ? (lo_wave ? gw : 33792 + (gw - 1536)) : gw, step = deal ? (lo_wave ? 1536 : 512) : ngw, stop = deal ? (lo_wave ? 33792 : NITEMS) : NITEMS;
    for (int it = first; it < stop; it += step) {
        int r = it;
        if (r < I_IN) { p0_transpose_item(KARG_IN(kq, 6), NIN, DM, 192, (bf16*)(ws + WS_WQKV), scr, r, lane); continue; } r -= I_IN;
        if (r < I_SQ) { p0_transpose_item(KARG_IN(kq, 8), DM, DM, 64, (bf16*)(ws + WS_WO), scr, r, lane); continue; } r -= I_SQ;
        if (r < I_IN) { p0_transpose_item(KARG_IN(kq, 9), 3 * DM, DM, 192, (bf16*)(ws + WS_WCIN), scr, r, lane, true); continue; } r -= I_IN;
        if (r < I_SQ) { p0_transpose_item(KARG_IN(kq, 11), DM, DM, 64, (bf16*)(ws + WS_WCOUT), scr, r, lane); continue; } r -= I_SQ;
        if (r < I_UP) { p0_transpose_item(KARG_IN(kq, 12), FF, DM, 256, (bf16*)(ws + WS_WUP0), scr, r, lane); continue; } r -= I_UP;
        if (r < I_UP) { p0_transpose_item(KARG_IN(kq, 12) + (size_t)DM * FF, FF, DM, 256, (bf16*)(ws + WS_WUP1), scr, r, lane); continue; } r -= I_UP;
        if (r < I_DN) { p0_transpose_item(KARG_IN(kq, 13), DM, FF, 64, (bf16*)(ws + WS_WDN0), scr, r, lane); continue; } r -= I_DN;
        p0_transpose_item(KARG_IN(kq, 13) + (size_t)FF * DM, DM, FF, 64, (bf16*)(ws + WS_WDN1), scr, r, lane);
    }
}
__device__ __forceinline__ void ld8(const bf16* p, float (&f)[8]) { const v4u w = *(const v4u*)p; f[0] = bf_lo(w.x); f[1] = bf_hi(w.x); f[2] = bf_lo(w.y); f[3] = bf_hi(w.y); f[4] = bf_lo(w.z); f[5] = bf_hi(w.z); f[6] = bf_lo(w.w); f[7] = bf_hi(w.w); }
__device__ __forceinline__ void shiftw_mfma(const float* mod, unsigned char* ws, float* SW, LAS unsigned char* lds, int tid, int lane, int gw, int ngw) {
    LAS bf16* S = (LAS bf16*)lds;
#pragma unroll
    for (int it = 0; it < 3 * 4 * DM / 4 / NTHREADS; ++it) { const int idx = tid + it * NTHREADS, mat = idx / DM, b = (idx / (DM / 4)) & 3, k = (idx & (DM / 4 - 1)) * 4;
        const float* shp = mat == 0 ? mod + 3 * DM : (mat == 1 ? mod + (size_t)4 * NMOD : mod + (size_t)4 * NMOD + 3 * DM);
        const f32x4 v = *(const f32x4*)(shp + (size_t)b * NMOD + k); unsigned hb[4], lb[4];
#pragma unroll
        for (int i = 0; i < 4; ++i) { hb[i] = pk2(v[i], 0.f) & 0xffffu; lb[i] = pk2(v[i] - __uint_as_float(hb[i] << 16), 0.f) & 0xffffu; }
        v2u h2, l2; h2.x = hb[0] | (hb[1] << 16); h2.y = hb[2] | (hb[3] << 16); l2.x = lb[0] | (lb[1] << 16); l2.y = lb[2] | (lb[3] << 16);
        *(LAS v2u*)(S + (mat * 8 + b) * DM + k) = h2; *(LAS v2u*)(S + (mat * 8 + 4 + b) * DM + k) = l2; }
    __syncthreads();
    const int fr = lane & 15, fq = lane >> 4;
    for (int g = gw; g < 1408; g += ngw) {
        const int mat = g < 512 ? 0 : (g < 896 ? 1 : 2), g0 = g - (mat == 0 ? 0 : (mat == 1 ? 512 : 896)), N = mat == 1 ? 3 * DM : FF;
        const bf16* Wt = (const bf16*)(ws + (mat == 0 ? WS_WUP0 : (mat == 1 ? WS_WCIN : WS_WUP1)));
        float* sw = SW + (mat == 0 ? SW_UP0 : (mat == 1 ? SW_CIN : SW_UP1));
        const bf16* wp = Wt + (size_t)(g0 * 16 + fr) * DM + 8 * fq;
        const LAS bf16* sp = S + (mat * 8 + (fr & 7)) * DM + 8 * fq;
        pg8::f32x4 acc = {0.f, 0.f, 0.f, 0.f};
#pragma unroll 8
        for (int kk = 0; kk < DM / 32; ++kk) { const pg8::bf16x8 wf = *(const pg8::bf16x8*)(wp + 32 * kk); pg8::bf16x8 sf = *(const LAS pg8::bf16x8*)(sp + 32 * kk);
            if (fr >= 8) sf = (pg8::bf16x8){0, 0, 0, 0, 0, 0, 0, 0};
            acc = __builtin_amdgcn_mfma_f32_16x16x32_bf16(wf, sf, acc, 0, 0, 0); }
        pg8::f32x4 r;
#pragma unroll
        for (int i = 0; i < 4; ++i) r[i] = acc[i] + __shfl_xor(acc[i], 4);
        if (fr < 4) *(pg8::f32x4*)(sw + (size_t)fr * N + g0 * 16 + 4 * fq) = r;
    }
}
constexpr int WFT_LD = DM + 8;
__device__ __forceinline__ void norm_phase(const float* src, const float* gain, const float* shp, const float* scp, bf16* XN,
                                           const float* w_in, const float* b_f, float* LF, LAS unsigned char* lds, int tid, int lane, int wave, int gw, int ngw) {
    LAS bf16* WFT = (LAS bf16*)lds;
#pragma unroll
    for (int idx = tid; idx < 8192; idx += NTHREADS) { const int k = idx >> 2, n4 = idx & 3;
        const f32x4 v = *(const f32x4*)(w_in + (size_t)k * NIN + 3 * DM + 4 * n4);
#pragma unroll
        for (int i = 0; i < 4; ++i) { const unsigned hb = pk2(v[i], 0.f) & 0xffffu; const unsigned lb = pk2(v[i] - __uint_as_float(hb << 16), 0.f) & 0xffffu;
            WFT[(4 * n4 + i) * WFT_LD + k] = (bf16)hb; WFT[(16 + 4 * n4 + i) * WFT_LD + k] = (bf16)lb; } }
    for (int grp = gw; grp < M / 8; grp += ngw) {
        const int row0 = grp * 8, b = row0 / SEQ;
        for (int rq = 0; rq < 2; ++rq) {
            asm volatile("" ::: "memory");
            f32x4 v[4][8]; float inv[4];
#pragma unroll
            for (int r = 0; r < 4; ++r)
#pragma unroll
                for (int j = 0; j < 8; ++j) v[r][j] = __builtin_nontemporal_load((const f32x4*)(src + (size_t)(row0 + 4 * rq + r) * DM) + lane + 64 * j);
#pragma unroll
            for (int r = 0; r < 4; ++r) { float ss = 0.f;
#pragma unroll
                for (int j = 0; j < 8; ++j) ss += (v[r][j].x * v[r][j].x + v[r][j].y * v[r][j].y) + (v[r][j].z * v[r][j].z + v[r][j].w * v[r][j].w);
                inv[r] = 1.0f / sqrtf(wave_sum(ss) * (1.f / DM) + RMS_EPS); }
#pragma unroll
            for (int j = 0; j < 8; ++j) { const f32x4 g = ((const f32x4*)gain)[lane + 64 * j], sc = ((const f32x4*)(scp + (size_t)b * NMOD))[lane + 64 * j], sh = ((const f32x4*)(shp + (size_t)b * NMOD))[lane + 64 * j];
                const f32x4 ca = g * (sc + 1.f);
#pragma unroll
                for (int r = 0; r < 4; ++r) { const f32x4 h = (v[r][j] * inv[r]) * ca + sh; v2u w; w.x = pk2(h.x, h.y); w.y = pk2(h.z, h.w);
                    ((v2u*)(XN + (size_t)(row0 + 4 * rq + r) * DM))[lane + 64 * j] = w; } }
        }
    }
    __syncthreads();
    if ((wave & 1) == 0) {
        const int fr = lane & 15, fq = lane >> 4;
        for (int grp = gw; grp < M / 8; grp += ngw) {
            const int row0 = grp * 8, b = row0 / SEQ;
            const bf16* xp = XN + (size_t)(row0 + fr) * DM + 8 * fq;
            const LAS bf16* yh = WFT + fr * WFT_LD + 8 * fq; const LAS bf16* yl = yh + 16 * WFT_LD;
            pg8::f32x4 ah = {0.f, 0.f, 0.f, 0.f}, al = {0.f, 0.f, 0.f, 0.f};
#pragma unroll 8
            for (int kk = 0; kk < DM / 32; ++kk) { const pg8::bf16x8 xf = *(const pg8::bf16x8*)(xp + 32 * kk);
                ah = __builtin_amdgcn_mfma_f32_16x16x32_bf16(xf, *(const LAS pg8::bf16x8*)(yh + 32 * kk), ah, 0, 0, 0);
                al = __builtin_amdgcn_mfma_f32_16x16x32_bf16(xf, *(const LAS pg8::bf16x8*)(yl + 32 * kk), al, 0, 0, 0); }
            const float bias = b_f[fr]; pg8::f32x4 lf;
#pragma unroll
            for (int i = 0; i < 4; ++i) { const float z = ah[i] + al[i] + bias; lf[i] = fminf(z, 0.f) - log1pf(expf(-fabsf(z))); }
            *(pg8::f32x4*)(LF + (size_t)(b * NH + fr) * SEQ + (row0 % SEQ) + 4 * fq) = lf;
        }
    }
}
__device__ __forceinline__ void cumsum_block(const float* LF, float* FK, int bh, LAS unsigned char* lds, int tid, int wave, int lane) {
    const f32x4 a = *(const f32x4*)(LF + (size_t)bh * SEQ + 8 * tid), b = *(const f32x4*)(LF + (size_t)bh * SEQ + 8 * tid + 4);
    float p[8]; p[0] = a.x; p[1] = p[0] + a.y; p[2] = p[1] + a.z; p[3] = p[2] + a.w; p[4] = p[3] + b.x; p[5] = p[4] + b.y; p[6] = p[5] + b.z; p[7] = p[6] + b.w;
    float incl = p[7];
#pragma unroll
    for (int o = 1; o < 64; o <<= 1) { const float t = __shfl_up(incl, o); if (lane >= o) incl += t; }
    LAS float* wt = (LAS float*)lds;
    if (lane == 63) wt[wave] = incl;
    __syncthreads();
    float off = incl - p[7];
    for (int w = 0; w < wave; ++w) off += wt[w];
    f32x4 o0, o1; o0.x = -(off + p[0]) * LOG2E; o0.y = -(off + p[1]) * LOG2E; o0.z = -(off + p[2]) * LOG2E; o0.w = -(off + p[3]) * LOG2E;
    o1.x = -(off + p[4]) * LOG2E; o1.y = -(off + p[5]) * LOG2E; o1.z = -(off + p[6]) * LOG2E; o1.w = -(off + p[7]) * LOG2E;
    *(f32x4*)(FK + (size_t)bh * SEQ + 8 * tid) = o0; *(f32x4*)(FK + (size_t)bh * SEQ + 8 * tid + 4) = o1;
    __syncthreads();
}
typedef __hip_bfloat16 hbf;
__device__ __forceinline__ void att_item(int L, int pass, int& bh, int& qb) {
    const int xcd = L & 7, k = L >> 3; bh = (k >> 3) * 8 + xcd; const int x0 = k & 7, x = (L >= 256) ? 7 - x0 : x0; qb = pass ? 15 - x : x;
}
__device__ __forceinline__ att::BlockRef<hbf, hbf> att_ref(int L, int pass, int jlo, const hbf* Q, const hbf* K, const hbf* V, hbf* O, const float* FK) {
    int bh, qb; att_item(L, pass, bh, qb);
    const int b = bh >> 4, h = bh & 15; const size_t rowbase = (size_t)b * SEQ;
    att::BlockRef<hbf, hbf> r;
    r.Q = Q + (rowbase + (size_t)qb * 256) * DM + h * HD; r.O = O + (rowbase + (size_t)qb * 256) * DM + h * HD;
    r.K = K + rowbase * DM + h * HD; r.V = V + rowbase * DM + h * HD; r.F = FK + (size_t)bh * SEQ; r.P0 = qb * 256; r.jlo = jlo;
    return r;
}
__device__ __forceinline__ int att_jlo(int L, int pass, const float* NRM, const float* FK, LAS unsigned char* lds, int tid, int lane, int wave) {
    int bh, qb; att_item(L, pass, bh, qb);
    const int b = bh >> 4, h = bh & 15, P0 = qb * 256; const size_t rowbase = (size_t)b * SEQ;
    const float* NQ = NRM + (size_t)bh * SEQ * 4; const float* NK = NRM + ((size_t)(BATCH * NH) + bh) * SEQ * 4;
    float kq = 0.f, kk = 0.f;
    if (tid < 256) { const f32x4 v = *(const f32x4*)(NQ + (size_t)(P0 + tid) * 4); kq = (v[0] + v[1]) + (v[2] + v[3]); }
    for (int s = tid; s < P0 + 256; s += NTHREADS) { const f32x4 v = *(const f32x4*)(NK + (size_t)s * 4); kk = fmaxf(kk, (v[0] + v[1]) + (v[2] + v[3])); }
#pragma unroll
    for (int o = 1; o < 64; o <<= 1) { kq = fmaxf(kq, __shfl_xor(kq, o)); kk = fmaxf(kk, __shfl_xor(kk, o)); }
    LAS float* red = (LAS float*)(lds + 122880);
    if (lane == 0) { red[wave] = kq; red[8 + wave] = kk; }
    __syncthreads();
    float mq = 0.f, mk = 0.f;
#pragma unroll
    for (int w = 0; w < 8; ++w) { mq = fmaxf(mq, red[w]); mk = fmaxf(mk, red[8 + w]); }
    const float B = 1.02f * sqrtf(mq * mk);
    const float* F = FK + (size_t)bh * SEQ;
    const float fend = F[64 * lane + 63], f0 = F[P0];
    const bool skip = (64 * lane + 63 < P0) && (2.f * B + fend - f0 < -60.f);
    const int jlo = __popcll(__ballot(skip));
    __syncthreads();
    return __builtin_amdgcn_readfirstlane(jlo);
}
__device__ __forceinline__ void attn_phase(const hbf* Q, const hbf* K, const hbf* V, hbf* O, const float* FK, const float* NRM, char* lds) {
    constexpr int total = 8 * BATCH * NH, W = 1 << 30;
    const int stride = gridDim.x; int L = blockIdx.x; if (L >= total) return;
    const int L0 = L;
    int jl0, jl1, jl2 = 0, jl3 = 0;
    { const int tid = tidx(), lane = tid & 63, wave = __builtin_amdgcn_readfirstlane(tid >> 6);
      jl0 = att_jlo(L0, 0, NRM, FK, (LAS unsigned char*)lds, tid, lane, wave); jl1 = att_jlo(L0, 1, NRM, FK, (LAS unsigned char*)lds, tid, lane, wave);
      if (L0 + stride < total) { jl2 = att_jlo(L0 + stride, 0, NRM, FK, (LAS unsigned char*)lds, tid, lane, wave); jl3 = att_jlo(L0 + stride, 1, NRM, FK, (LAS unsigned char*)lds, tid, lane, wave); } }
    int pass = 0, fsel = 0;
    att::BlockRef<hbf, hbf> cur = att_ref(L, 0, jl0, Q, K, V, O, FK);
    att::Seam<hbf> S;
    att::causal_swa_prime<hbf, hbf>(cur, W, lds, S, lds + att::ATT_F_OFF);
    for (;;) {
        const bool more_pass = pass == 0, more_item = (L == L0) && (L + stride < total), last = !more_pass && !more_item;
        int passn = pass + 1, Ln = L;
        if (!more_pass) { passn = 0; Ln = more_item ? L + stride : L; }
        const int jn = (Ln == L0) ? (passn ? jl1 : jl0) : (passn ? jl3 : jl2);
        const att::BlockRef<hbf, hbf> nxt = last ? cur : att_ref(Ln, passn, jn, Q, K, V, O, FK);
        att::causal_swa_block<hbf, hbf>(cur, nxt, SEQ, W, lds, S, lds + att::ATT_F_OFF + fsel * 16384, lds + att::ATT_F_OFF + (fsel ^ 1) * 16384);
        if (last) break;
        cur = nxt; pass = passn; L = Ln; fsel ^= 1;
    }
}
__device__ __forceinline__ void conv_phase(const bf16* BG, const bf16* P, const float* cw, bf16* Y, int lane, int gw, int ngw) {
    for (int grp = gw; grp < M / 8; grp += ngw) {
        const int row0 = grp * 8, t0 = row0 % SEQ;
        for (int j = 0; j < 4; ++j) {
            const int ch = (lane + 64 * j) * 8;
            float w0[8], w1[8], w2[8], pm2[8], pm1[8];
#pragma unroll
            for (int i = 0; i < 8; ++i) { w0[i] = cw[ch + i]; w1[i] = cw[DM + ch + i]; w2[i] = cw[2 * DM + ch + i]; pm2[i] = 0.f; pm1[i] = 0.f; }
            if (t0 > 0) { ld8(P + (size_t)(row0 - 2) * DM + ch, pm2); ld8(P + (size_t)(row0 - 1) * DM + ch, pm1); }
#pragma unroll
            for (int r = 0; r < 8; ++r) { float p8[8], b8[8], y[8];
                ld8(P + (size_t)(row0 + r) * DM + ch, p8); ld8(BG + (size_t)(row0 + r) * DM + ch, b8);
#pragma unroll
                for (int i = 0; i < 8; ++i) { y[i] = b8[i] * (w0[i] * pm2[i] + w1[i] * pm1[i] + w2[i] * p8[i]); pm2[i] = pm1[i]; pm1[i] = p8[i]; }
                v4u o; o.x = pk2(y[0], y[1]); o.y = pk2(y[2], y[3]); o.z = pk2(y[4], y[5]); o.w = pk2(y[6], y[7]);
                *(v4u*)(Y + (size_t)(row0 + r) * DM + ch) = o; }
        }
    }
}
__device__ __forceinline__ void final_norm_phase(const bf16* xr, float* out, const float* gain, int lane, int gw, int ngw) {
    for (int r0 = gw * 4; r0 < M; r0 += ngw * 4) {
        v4u raw[4][4];
#pragma unroll
        for (int r = 0; r < 4; ++r)
#pragma unroll
            for (int j = 0; j < 4; ++j) raw[r][j] = *(const v4u*)(xr + (size_t)(r0 + r) * DM + (lane + 64 * j) * 8);
        float inv[4];
#pragma unroll
        for (int r = 0; r < 4; ++r) { float ss = 0.f;
#pragma unroll
            for (int j = 0; j < 4; ++j) { const unsigned w[4] = {raw[r][j].x, raw[r][j].y, raw[r][j].z, raw[r][j].w};
#pragma unroll
                for (int i = 0; i < 4; ++i) { const float a = bf_lo(w[i]), b = bf_hi(w[i]); ss += a * a + b * b; } }
            inv[r] = 1.0f / sqrtf(wave_sum(ss) * (1.f / DM) + RMS_EPS); }
#pragma unroll
        for (int j = 0; j < 4; ++j) { const f32x4 g0 = *(const f32x4*)(gain + (lane + 64 * j) * 8), g1 = *(const f32x4*)(gain + (lane + 64 * j) * 8 + 4);
#pragma unroll
            for (int r = 0; r < 4; ++r) { const v4u w = raw[r][j]; f32x4 o0, o1;
                o0[0] = bf_lo(w.x); o0[1] = bf_hi(w.x); o0[2] = bf_lo(w.y); o0[3] = bf_hi(w.y); o1[0] = bf_lo(w.z); o1[1] = bf_hi(w.z); o1[2] = bf_lo(w.w); o1[3] = bf_hi(w.w);
                o0 = (o0 * inv[r]) * g0; o1 = (o1 * inv[r]) * g1;
                *(f32x4*)(out + (size_t)(r0 + r) * DM + (lane + 64 * j) * 8) = o0; *(f32x4*)(out + (size_t)(r0 + r) * DM + (lane + 64 * j) * 8 + 4) = o1; } }
    }
}

#define XB_TMO      128
#define XB_XCNT(j)  (256  + 64 * (j))
#define XB_XSUB(j)  (1280 + 64 * (j))
#define XB_XGEN(j)  (2304 + 64 * (j))
#define XB_TOP      3328
#define XB_TOPGEN   3392
#define XCD_BAR_WORDS 3456
#define XB_SPIN_CAP (1u << 18)

__device__ __forceinline__ unsigned xb_ld(unsigned* p)              { return __hip_atomic_load(p, __ATOMIC_RELAXED, __HIP_MEMORY_SCOPE_AGENT); }
__device__ __forceinline__ unsigned xb_add(unsigned* p, unsigned v) { return __hip_atomic_fetch_add(p, v, __ATOMIC_RELAXED, __HIP_MEMORY_SCOPE_AGENT); }
__device__ __forceinline__ unsigned xb_xcc_id() { return (unsigned)__builtin_amdgcn_s_getreg((3 << 11) | 20) & 0xFu; }
#define XB_SPIN(cond, bar) do { unsigned _sp = 0; while (cond) { __builtin_amdgcn_s_sleep(1); \
    if ((++_sp & 255u) == 0u) { if (xb_ld(&(bar)[XB_TMO])) break; if (_sp > XB_SPIN_CAP) { atomicAdd(&(bar)[XB_TMO], 1u); break; } } } } while (0)

struct XcdBarrier {
    unsigned* bar; unsigned x;
    volatile LAS unsigned* st;
};

__device__ __forceinline__ XcdBarrier xcd_barrier_post(unsigned* bar, volatile LAS unsigned* st) {
    XcdBarrier b; b.bar = bar; b.x = xb_xcc_id(); b.st = st;
    if (threadIdx.x == 0) (void)xb_add(&bar[XB_XCNT(b.x)], 1u);
    return b;
}
__device__ __forceinline__ void xcd_barrier_complete(unsigned* bar, unsigned x, unsigned& nloc, unsigned& nx) {
    const unsigned G = gridDim.x * gridDim.y * gridDim.z;
    unsigned sum, cnt, mine, sp = 0u;
    for (;;) {
        sum = 0u; cnt = 0u; mine = 0u;
#pragma unroll
        for (unsigned j = 0; j < 16; ++j) { const unsigned c = xb_ld(&bar[XB_XCNT(j)]); sum += c; cnt += (c > 0u) ? 1u : 0u; mine = (j == x) ? c : mine; }
        if (sum == G) break;
        __builtin_amdgcn_s_sleep(1);
        if ((++sp & 255u) == 0u) { if (xb_ld(&bar[XB_TMO])) break; if (sp > XB_SPIN_CAP) { atomicAdd(&bar[XB_TMO], 1u); break; } }
    }
    nloc = mine > 0u ? mine : 1u; nx = cnt > 0u ? cnt : 1u;
}

__device__ __forceinline__ void xcd_barrier(const XcdBarrier& b) {
    asm volatile("s_waitcnt vmcnt(0)" ::: "memory");
    __syncthreads();
    if (threadIdx.x == 0) {
        unsigned* bar = b.bar;
        __builtin_amdgcn_s_waitcnt(0);
        unsigned nloc = b.st[0], nx = b.st[1];
        if (nloc == 0u) { xcd_barrier_complete(bar, b.x, nloc, nx); b.st[0] = nloc; b.st[1] = nx; }
        const unsigned old = xb_add(&bar[XB_XSUB(b.x)], 1u);
        const unsigned gen = old / nloc;
        if (old + 1u == (gen + 1u) * nloc) {
            __builtin_amdgcn_fence(__ATOMIC_RELEASE, "agent");
            asm volatile("s_waitcnt vmcnt(0)" ::: "memory");
            const unsigned og = xb_add(&bar[XB_TOP], 1u);
            const unsigned tg = og / nx;
            if (og + 1u == (tg + 1u) * nx) xb_add(&bar[XB_TOPGEN], 1u);
            else XB_SPIN(xb_ld(&bar[XB_TOPGEN]) == tg, bar);
            __builtin_amdgcn_fence(__ATOMIC_ACQUIRE, "agent");
            xb_add(&bar[XB_XGEN(b.x)], 1u);
            asm volatile("s_waitcnt vmcnt(0)" ::: "memory");
        } else {
            XB_SPIN(xb_ld(&bar[XB_XGEN(b.x)]) == gen, bar);
            __builtin_amdgcn_fence(__ATOMIC_ACQUIRE, "agent");
            asm volatile("s_waitcnt vmcnt(0)" ::: "memory");
        }
    }
    __syncthreads();
}

enum { K_PRO = 0, K_NORM, K_GEMM_BF16, K_ATTN, K_GEMM_RES, K_GEMM_SQ, K_CONV, K_FINAL };
__global__ void __launch_bounds__(NTHREADS, 2) fwd_mega(Args a) {
    extern __shared__ __attribute__((aligned(16))) unsigned char lds[];
    LAS unsigned char* L = (LAS unsigned char*)lds;
    const int G = gridDim.x, ngw = G * NWAVES;
    const kargp_t kp = (kargp_t)__builtin_amdgcn_kernarg_segment_ptr();
    const int ph_lo = a.ph_lo, ph_hi = a.ph_hi;
    volatile LAS unsigned* MISC = (volatile LAS unsigned*)(L + LDS_TOTAL - 256);
    if (tidx() < 32) MISC[tidx()] = 0u;
    __syncthreads();
    XcdBarrier xbar; xbar.bar = (unsigned*)a.ws; xbar.x = 0; xbar.st = nullptr;
    if (ph_hi - ph_lo > 1) xbar = xcd_barrier_post((unsigned*)a.ws, MISC + 8);
#if defined(PROBE_REP_KIND)
    int rep_left = PROBE_REP_N;
#endif
    for (int ph = ph_lo; ph < ph_hi; ++ph) {
        kargp_t kq = kp; asm volatile("" : "+s"(kq));
        unsigned char* ws = KARG_WS(kq);
        const float* x = KARG_IN(kq, 0);
        float* mod = (float*)(ws + WS_MOD); float* LF = (float*)(ws + WS_LF); float* FK = (float*)(ws + WS_FK);
        bf16* XN = (bf16*)(ws + WS_XN); bf16* Qb = (bf16*)(ws + WS_Q); bf16* Kb = (bf16*)(ws + WS_K); bf16* Vb = (bf16*)(ws + WS_V); bf16* Ob = (bf16*)(ws + WS_O); bf16* Ub = (bf16*)(ws + WS_U);
        float* XR = KARG_OUT(kq);
        const int layer = ph >= 7 ? 1 : 0;
        int kind;
        switch (ph) {
            case 0: kind = K_PRO; break;
            case 1: kind = K_NORM; break;
            case 2: case 7: kind = K_GEMM_BF16; break;
            case 3: kind = K_ATTN; break;
            case 4: case 6: case 9: case 11: kind = K_GEMM_RES; break;
            case 5: case 10: kind = K_GEMM_SQ; break;
            case 8: kind = K_CONV; break;
            default: kind = K_FINAL; break;
        }
        const bool mlp_half = (ph == 5 || ph == 6 || ph == 10 || ph == 11);
        const float* modl = mod + (size_t)layer * 4 * NMOD;
        float* SS = (float*)(ws + WS_SS); float* SW = (float*)(ws + WS_SW);
        if (KEN(K_PRO) && kind == K_PRO) {
            const int tid = tidx(), lane = tid & 63, wave = __builtin_amdgcn_readfirstlane(tid >> 6), gw = blockIdx.x * NWAVES + wave; (void)tid; (void)lane; (void)wave; (void)gw;
            p0_gemv(KARG_IN(kq, 1), KARG_IN(kq, 2), KARG_IN(kq, 3), mod, L, tid, wave, lane);
            p0_transposes(kq, L, wave, lane, gw, ngw);
            __syncthreads();
        } else if (KEN(K_NORM) && kind == K_NORM) {
            const int tid = tidx(), lane = tid & 63, wave = __builtin_amdgcn_readfirstlane(tid >> 6), gw = blockIdx.x * NWAVES + wave; (void)tid; (void)lane; (void)wave; (void)gw;
            norm_phase(x, KARG_IN(kq, 4), modl, modl + DM, XN, KARG_IN(kq, 6), KARG_IN(kq, 7), LF, L, tid, lane, wave, gw, ngw);
            __syncthreads();
            shiftw_mfma(mod, ws, SW, L, tid, lane, gw, ngw);
            __syncthreads();
        } else if (KEN(K_GEMM_BF16) && kind == K_GEMM_BF16) {
            const int tid = tidx(), lane = tid & 63, wave = __builtin_amdgcn_readfirstlane(tid >> 6), gw = blockIdx.x * NWAVES + wave; (void)tid; (void)lane; (void)wave; (void)gw;
            if (ph == 2) { for (int bh = blockIdx.x; bh < BATCH * NH; bh += G) cumsum_block(LF, FK, bh, L, tid, wave, lane); }
            pg8::Gemm g{XN, (const bf16*)(ws + (ph == 2 ? WS_WQKV : WS_WCIN)), M, 3 * DM, DM}; pg8::StaticOrder S; S.init(M, 3 * DM, G, (int)blockIdx.x, 4);
            pg8::EpiBf16<0> E{Qb, DM, DM, (size_t)(WS_K - WS_Q) / 2, ph == 2 ? QSCALE : 1.0f, ph == 2 ? (const float*)nullptr : (const float*)SS, SW + SW_CIN, 3 * DM, SEQ, ph == 2 ? (bf16*)nullptr : Kb, 8, ph == 2 ? (float*)(ws + WS_NRM) : (float*)nullptr};
            pg8::gemm_phase<pg8::EpiBf16<0>, pg8::StaticOrder, true, true>(L, g, S, E);
        } else if (KEN(K_ATTN) && kind == K_ATTN) {
            attn_phase((const hbf*)Qb, (const hbf*)Kb, (const hbf*)Vb, (hbf*)Ob, FK, (const float*)(ws + WS_NRM), (char*)lds);
        } else if (KEN(K_GEMM_RES) && kind == K_GEMM_RES) {
            const bf16* A = mlp_half ? Ub : Ob; const int Kd = mlp_half ? FF : DM;
            const size_t wo = mlp_half ? (layer ? WS_WDN1 : WS_WDN0) : (layer ? WS_WCOUT : WS_WO);
            pg8::Gemm g{A, (const bf16*)(ws + wo), M, DM, Kd}; pg8::StaticOrder S; S.init(M, DM, G, (int)blockIdx.x, 4);
            const float* n_gain = mlp_half ? KARG_IN(kq, 4) + DM : KARG_IN(kq, 5) + (size_t)layer * DM;
            const float* n_scale = mlp_half ? mod + (size_t)4 * NMOD + DM : modl + 4 * DM;
            bf16* XRB = (bf16*)(ws + WS_XRB);
            pg8::EpiRes E{ph == 4 ? x : (const float*)nullptr, ph == 4 ? (const bf16*)nullptr : (const bf16*)XRB, (float*)nullptr, XRB, DM, modl + (mlp_half ? 5 * DM : 2 * DM), SEQ, NMOD, ph == 11 ? (bf16*)nullptr : XN, n_gain, n_scale, SS};
            pg8::gemm_phase<pg8::EpiRes, pg8::StaticOrder, true, true>(L, g, S, E);
        } else if (KEN(K_GEMM_SQ) && kind == K_GEMM_SQ) {
            pg8::Gemm g{XN, (const bf16*)(ws + (layer ? WS_WUP1 : WS_WUP0)), M, FF, DM}; pg8::StaticOrder S; S.init(M, FF, G, (int)blockIdx.x, 4);
#if defined(PROBE_NULL_EPI)
            if (rep_left < PROBE_REP_N) { pg8::EpiNull E0{Ub}; pg8::gemm_phase<pg8::EpiNull, pg8::StaticOrder, true, true>(L, g, S, E0); } else
#endif
            { pg8::EpiBf16<2> E{Ub, FF, 0, 0, 1.0f, SS, SW + (layer ? SW_UP1 : SW_UP0), FF, SEQ, (bf16*)nullptr, 0, (float*)nullptr};
            pg8::gemm_phase<pg8::EpiBf16<2>, pg8::StaticOrder, true, true>(L, g, S, E); }
        } else if (KEN(K_CONV) && kind == K_CONV) {
            const int tid = tidx(), lane = tid & 63, wave = __builtin_amdgcn_readfirstlane(tid >> 6), gw = blockIdx.x * NWAVES + wave; (void)tid; (void)lane; (void)wave; (void)gw;
            conv_phase(Qb, Kb, KARG_IN(kq, 10), Ob, lane, gw, ngw);
        } else if (KEN(K_FINAL) && kind == K_FINAL) {
            const int tid = tidx(), lane = tid & 63, wave = __builtin_amdgcn_readfirstlane(tid >> 6), gw = blockIdx.x * NWAVES + wave; (void)tid; (void)lane; (void)wave; (void)gw;
            final_norm_phase((const bf16*)(ws + WS_XRB), XR, KARG_IN(kq, 14), lane, gw, ngw);
        }
#if defined(PROBE_REP_KIND)
        if (kind == PROBE_REP_KIND && !(kind == K_GEMM_RES && ph != 4) && rep_left > 0) { --rep_left; xcd_barrier(xbar); --ph; continue; }
        rep_left = PROBE_REP_N;
#endif
#if defined(PROBE_EXTRA_SYNC)
        for (int es = 0; es < PROBE_EXTRA_SYNC; ++es) xcd_barrier(xbar);
#endif
        if (ph + 1 < ph_hi) { if (ph_hi > NPHASES) cg::this_grid().sync(); else xcd_barrier(xbar); }
    }
}

extern "C" void kernel_launch(void* const* d_in, const int* in_sizes, int n_in, void* d_out, int out_size, void* d_ws, size_t ws_size, hipStream_t stream) {
    static int grid = 0;
    if (grid == 0) {
        if (n_in != 15 || in_sizes[0] != M * DM || out_size != M * DM || ws_size < WS_END) { fprintf(stderr, "kernel_launch: shape/workspace mismatch (n_in %d, in0 %d, out %d, ws %zu)\n", n_in, n_in > 0 ? in_sizes[0] : -1, out_size, ws_size); grid = -1; return; }
        int dev = 0, cus = 0, per_cu = 0;
        (void)hipGetDevice(&dev); (void)hipDeviceGetAttribute(&cus, hipDeviceAttributeMultiprocessorCount, dev);
        if (hipFuncSetAttribute((const void*)fwd_mega, hipFuncAttributeMaxDynamicSharedMemorySize, LDS_TOTAL) != hipSuccess) { fprintf(stderr, "kernel_launch: hipFuncSetAttribute failed\n"); grid = -1; return; }
        if (hipOccupancyMaxActiveBlocksPerMultiprocessor(&per_cu, (const void*)fwd_mega, NTHREADS, LDS_TOTAL) != hipSuccess || per_cu < 1) { fprintf(stderr, "kernel_launch: occupancy query says %d blocks per CU\n", per_cu); per_cu = 1; }
        (void)hipGetLastError();
        grid = cus > 0 ? cus : 256;
    }
    if (grid < 0) return;
    Args a{};
    for (int i = 0; i < 15; ++i) a.in[i] = (const float*)d_in[i];
    a.out = (float*)d_out; a.ws = (unsigned char*)d_ws;
#if MK_N_LAUNCHES == 1
    a.ph_lo = 0; a.ph_hi = NPHASES;
    (void)hipMemsetAsync(d_ws, 0, 16384, stream);
    void* args[] = {&a};
    hipError_t e = hipLaunchCooperativeKernel((const void*)fwd_mega, dim3(grid), dim3(NTHREADS), args, LDS_TOTAL, stream);
    if (e != hipSuccess) fprintf(stderr, "kernel_launch: cooperative launch failed: %s (grid %d)\n", hipGetErrorString(e), grid);
#else
    for (int ph = 0; ph < NPHASES; ++ph) { a.ph_lo = ph; a.ph_hi = ph + 1; hipLaunchKernelGGL(fwd_mega, dim3(grid), dim3(NTHREADS), LDS_TOTAL, stream, a); }
#endif
}
```
